# Optimizing an MI355X kernel written in HIP

```python
import jax, jax.numpy as jnp
from jax import lax
import numpy as np

D_MODEL = 1024
BATCH = 8
SEQ = 4096
DEPTH = 2

N_META = 16
CHUNK = 128
PAD_FRONT = (-N_META) % CHUNK
RET_HEADS = 4
RET_QK_DIM = D_MODEL // 8
RET_V_DIM = 2 * RET_QK_DIM
RET_QK_W = RET_HEADS * RET_QK_DIM
RET_V_W = RET_HEADS * RET_V_DIM
CONV_CH = D_MODEL
CONV_WIDTH = 31
MIX_IN_EVEN = 2 * RET_QK_W + 2 * RET_V_W + 2 * CONV_CH
MIX_OUT_EVEN = RET_V_W + CONV_CH
RET_DECAY_OFFSET = 5.0
ROPE_BASE = 10000.0
SB_HEADS = 16
SB_HEAD_DIM = D_MODEL // SB_HEADS
D_FF = 4 * D_MODEL
EPS = 1e-6
N_EVEN = (DEPTH + 1) // 2
N_ODD = DEPTH // 2

kernel_name = "hybrid_retention_conformer_stickbreaking_trunk"


def rmsnorm(x, g):
    xf = x.astype(jnp.float32)
    y = xf * lax.rsqrt(jnp.mean(xf * xf, axis=-1, keepdims=True) + EPS) * g.astype(jnp.float32)
    return y.astype(x.dtype)


def layernorm(x, g, b):
    xf = x.astype(jnp.float32)
    mu = jnp.mean(xf, axis=-1, keepdims=True)
    var = jnp.mean(jnp.square(xf - mu), axis=-1, keepdims=True)
    y = (xf - mu) * lax.rsqrt(var + EPS) * g.astype(jnp.float32) + b.astype(jnp.float32)
    return y.astype(x.dtype)


def rotary(x):
    P, d = x.shape[1], x.shape[-1]
    half = d // 2
    inv_freq = ROPE_BASE ** (-jnp.arange(half, dtype=jnp.float32) / half)
    ang = jnp.arange(P, dtype=jnp.float32)[:, None] * inv_freq[None, :]
    cos = jnp.cos(ang)[None, :, None, :]
    sin = jnp.sin(ang)[None, :, None, :]
    x1, x2 = x[..., :half], x[..., half:]
    return jnp.concatenate([x1 * cos - x2 * sin, x1 * sin + x2 * cos], axis=-1)


def retention_chunkwise(q, k, v):
    b, P, H, dk = q.shape
    dv = v.shape[-1]
    n = P // CHUNK
    log_g = jnp.log1p(-jnp.exp2(-RET_DECAY_OFFSET - jnp.arange(H, dtype=jnp.float32)))
    idx = jnp.arange(CHUNK, dtype=jnp.float32)
    diff = idx[:, None] - idx[None, :]
    inner_decay = jnp.where(diff[None] >= 0, jnp.exp(jnp.maximum(diff, 0.0)[None] * log_g[:, None, None]), 0.0)
    qc = q.reshape(b, n, CHUNK, H, dk)
    kc = k.reshape(b, n, CHUNK, H, dk)
    vc = v.reshape(b, n, CHUNK, H, dv)
    scores = jnp.einsum('bnihd,bnjhd->bnhij', qc, kc) * inner_decay
    o_inner = jnp.einsum('bnhij,bnjhe->bnihe', scores, vc)
    k_dec = kc * jnp.exp((CHUNK - 1 - idx)[:, None] * log_g[None, :])[:, :, None]
    kv = jnp.einsum('bnjhd,bnjhe->nbhde', k_dec, vc)
    chunk_decay = jnp.exp(CHUNK * log_g)[None, :, None, None]

    def step(state, kv_n):
        return chunk_decay * state + kv_n, state

    _, prev = lax.scan(step, jnp.zeros((b, H, dk, dv), jnp.float32), kv)
    q_dec = qc * jnp.exp((idx + 1.0)[:, None] * log_g[None, :])[:, :, None]
    o_cross = jnp.einsum('bnihd,nbhde->bnihe', q_dec, prev)
    return (o_inner + o_cross).reshape(b, P, H, dv)


def head_groupnorm(o, g):
    mu = jnp.mean(o, axis=-1, keepdims=True)
    var = jnp.mean(jnp.square(o - mu), axis=-1, keepdims=True)
    return (o - mu) * lax.rsqrt(var + EPS) * g.astype(jnp.float32)


def conformer_conv(u, conv_w, conv_b, ln_g, ln_b):
    a, gate = jnp.split(u, 2, axis=-1)
    hdn = a * jax.nn.sigmoid(gate)
    y = lax.conv_general_dilated(
        hdn, conv_w[:, None, :].astype(hdn.dtype), window_strides=(1,),
        padding=[(CONV_WIDTH - 1, 0)], dimension_numbers=('NWC', 'WIO', 'NWC'),
        feature_group_count=CONV_CH)
    y = y + conv_b.astype(y.dtype)
    return jax.nn.silu(layernorm(y, ln_g, ln_b))


def even_mixer(h, w_in, gn_g, conv_w, conv_b, ln_g, ln_b, w_out):
    b, L, _ = h.shape
    proj = h @ w_in.astype(h.dtype)
    q, k, v, g, u = jnp.split(proj, [RET_QK_W, 2 * RET_QK_W, 2 * RET_QK_W + RET_V_W,
                                     2 * RET_QK_W + 2 * RET_V_W], axis=-1)
    pad = ((0, 0), (PAD_FRONT, 0), (0, 0), (0, 0))
    q = jnp.pad(q.astype(jnp.float32).reshape(b, L, RET_HEADS, RET_QK_DIM), pad)
    k = jnp.pad(k.astype(jnp.float32).reshape(b, L, RET_HEADS, RET_QK_DIM), pad)
    v = jnp.pad(v.astype(jnp.float32).reshape(b, L, RET_HEADS, RET_V_DIM), pad)
    q = rotary(q)
    k = rotary(k) * (RET_QK_DIM ** -0.5)
    o = retention_chunkwise(q, k, v)[:, PAD_FRONT:]
    o = head_groupnorm(o, gn_g).reshape(b, L, RET_V_W).astype(h.dtype)
    o = jax.nn.silu(g) * o
    c = conformer_conv(u, conv_w, conv_b, ln_g, ln_b)
    return jnp.concatenate([o, c], axis=-1) @ w_out.astype(h.dtype)


def stick_breaking(q, k, v, n_pad):
    b, H, P, d = q.shape
    n = P // CHUNK
    scale = d ** -0.5
    key_pos = jnp.arange(P)

    def block(i):
        qb = lax.dynamic_slice_in_dim(q, i * CHUNK, CHUNK, axis=2)
        z = jnp.einsum('bhqd,bhkd->bhqk', qb, k) * scale
        q_pos = i * CHUNK + jnp.arange(CHUNK)
        valid = (key_pos[None, :] < q_pos[:, None]) & (key_pos[None, :] >= n_pad)
        log_keep = jnp.where(valid, jax.nn.log_sigmoid(-z), 0.0)
        after = lax.cumsum(log_keep, axis=3, reverse=True) - log_keep
        w = jnp.where(valid, jnp.exp(jax.nn.log_sigmoid(z) + after), 0.0)
        return jnp.einsum('bhqk,bhkd->bhqd', w, v)

    out = lax.map(block, jnp.arange(n))
    return jnp.transpose(out, (1, 0, 3, 2, 4)).reshape(b, P, H, d)


def odd_mixer(h, w_qkv, qn_g, kn_g, w_o):
    b, L, _ = h.shape
    qkv = h @ w_qkv.astype(h.dtype)
    q, k, v = jnp.split(qkv, 3, axis=-1)
    q = rmsnorm(q.reshape(b, L, SB_HEADS, SB_HEAD_DIM), qn_g)
    k = rmsnorm(k.reshape(b, L, SB_HEADS, SB_HEAD_DIM), kn_g)
    v = v.reshape(b, L, SB_HEADS, SB_HEAD_DIM)
    pad = ((0, 0), (PAD_FRONT, 0), (0, 0), (0, 0))
    to_bhpd = lambda t: jnp.transpose(jnp.pad(t.astype(jnp.float32), pad), (0, 2, 1, 3))
    o = stick_breaking(to_bhpd(q), to_bhpd(k), to_bhpd(v), PAD_FRONT)[:, PAD_FRONT:]
    o = o.reshape(b, L, D_MODEL).astype(h.dtype)
    return o @ w_o.astype(h.dtype)


def sq_relu_mlp(h, w1, w2):
    return jnp.square(jax.nn.relu(h @ w1.astype(h.dtype))) @ w2.astype(h.dtype)


def setup_inputs(seed: int = 0) -> dict:
    key = jax.random.key(seed)
    ks = jax.random.split(key, 17)
    nrm = lambda kk, shape, s: jax.random.normal(kk, shape, jnp.float32) * s
    return {
        "x": nrm(ks[0], (BATCH, SEQ, D_MODEL), 1.0),
        "meta": nrm(ks[1], (N_META, D_MODEL), 1.0),
        "norm_mix_g": 1.0 + nrm(ks[2], (DEPTH, D_MODEL), 0.02),
        "norm_mlp_g": 1.0 + nrm(ks[3], (DEPTH, D_MODEL), 0.02),
        "even_w_in": nrm(ks[4], (N_EVEN, D_MODEL, MIX_IN_EVEN), D_MODEL ** -0.5),
        "even_ret_gn_g": 1.0 + nrm(ks[5], (N_EVEN, RET_HEADS, RET_V_DIM), 0.02),
        "even_conv_w": nrm(ks[6], (N_EVEN, CONV_WIDTH, CONV_CH), CONV_WIDTH ** -0.5),
        "even_conv_b": nrm(ks[7], (N_EVEN, CONV_CH), 0.01),
        "even_conv_ln_g": 1.0 + nrm(ks[8], (N_EVEN, CONV_CH), 0.02),
        "even_conv_ln_b": nrm(ks[9], (N_EVEN, CONV_CH), 0.01),
        "even_w_out": nrm(ks[10], (N_EVEN, MIX_OUT_EVEN, D_MODEL), MIX_OUT_EVEN ** -0.5),
        "odd_w_qkv": nrm(ks[11], (N_ODD, D_MODEL, 3 * D_MODEL), D_MODEL ** -0.5),
        "odd_q_norm_g": 1.0 + nrm(ks[12], (N_ODD, SB_HEAD_DIM), 0.02),
        "odd_k_norm_g": 1.0 + nrm(ks[13], (N_ODD, SB_HEAD_DIM), 0.02),
        "odd_w_o": nrm(ks[14], (N_ODD, D_MODEL, D_MODEL), D_MODEL ** -0.5),
        "mlp_w1": nrm(ks[15], (DEPTH, D_MODEL, D_FF), D_MODEL ** -0.5),
        "mlp_w2": nrm(ks[16], (DEPTH, D_FF, D_MODEL), D_FF ** -0.5),
    }


def reference(x, meta, norm_mix_g, norm_mlp_g, even_w_in, even_ret_gn_g, even_conv_w,
              even_conv_b, even_conv_ln_g, even_conv_ln_b, even_w_out, odd_w_qkv,
              odd_q_norm_g, odd_k_norm_g, odd_w_o, mlp_w1, mlp_w2):
    b = x.shape[0]
    meta_b = jnp.broadcast_to(meta[None].astype(x.dtype), (b, N_META, D_MODEL))
    h = jnp.concatenate([meta_b, x], axis=1)
    for layer in range(DEPTH):
        j = layer // 2
        hn = rmsnorm(h, norm_mix_g[layer])
        if layer % 2 == 0:
            mix = even_mixer(hn, even_w_in[j], even_ret_gn_g[j], even_conv_w[j], even_conv_b[j],
                             even_conv_ln_g[j], even_conv_ln_b[j], even_w_out[j])
        else:
            mix = odd_mixer(hn, odd_w_qkv[j], odd_q_norm_g[j], odd_k_norm_g[j], odd_w_o[j])
        h = h + mix
        h = h + sq_relu_mlp(rmsnorm(h, norm_mlp_g[layer]), mlp_w1[layer], mlp_w2[layer])
    return h[:, N_META:]
```

```cpp
#include <hip/hip_runtime.h>
#include <hip/hip_cooperative_groups.h>
#include <cstdio>
#include <cstdint>
namespace cg = cooperative_groups;
__host__ __device__ __forceinline__ int rowbase(int pm) { return (pm >> 4) * 4224 + 128 + (pm & 15) * 256; }
namespace pg8 {
#define PG8_LAS __attribute__((address_space(3)))
typedef unsigned short bf16_t;
typedef short bf16x8 __attribute__((ext_vector_type(8)));
typedef float f32x4 __attribute__((ext_vector_type(4)));
typedef unsigned u32x4 __attribute__((ext_vector_type(4)));
constexpr int BM = 256, BK = 64, HALF = 128, HTB = HALF * BK * 2  , STAGE_BYTES = 8 * HTB, NXCD = 8, WGM = 8;

__host__ __device__ __forceinline__ int lds_byte(int r, int c) { const int st = (r >> 4) * 2 + (c >> 5), rr = r & 15, cc = c & 31, ob = rr * 64 + cc * 2; return st * 1024 + (ob ^ (((ob >> 9) & 1) << 5)); }
__host__ __device__ __forceinline__ void stage_rc(int b, int& R, int& C) { const int st = b / 1024, sb = b % 1024, swz = sb ^ (((sb >> 9) & 1) << 5); R = (st >> 1) * 16 + swz / 64; C = (st & 1) * 32 + (swz % 64) / 2; }
__host__ __device__ __forceinline__ int perm32(int rho) { const int n = rho >> 4, i = rho & 15; return 8 * (i >> 2) + 4 * n + (i & 3); }

struct Unit { int pm, pn; };
struct Gemm { const bf16_t* A; const bf16_t* Bt; int M, N, K; };

struct StaticOrder {
    int nM, nN, nwg, G, c;
    __host__ __device__ void init(int M, int N, int G_, int c_) { nM = M / BM; nN = N / BM; nwg = nM * nN; G = G_; c = c_; }
    __host__ __device__ bool next(int i, Unit& u) const {
        const long L = (long)i * G + c; if (L >= nwg) return false;
        int wgid = (int)L; { const int q = nwg / NXCD, r = nwg % NXCD, xcd = wgid % NXCD, off = wgid / NXCD; wgid = (xcd < r ? xcd * (q + 1) : r * (q + 1) + (xcd - r) * q) + off; }
        const int nig = WGM * nN, gid = wgid / nig, fm = gid * WGM, gsz = (nM - fm) < WGM ? (nM - fm) : WGM;
        u.pm = fm + ((wgid % nig) % gsz); u.pn = (wgid % nig) / gsz; return true;
    }
    __device__ __forceinline__ void a_ready(const Unit&) const {}
    __device__ __forceinline__ void done(const Unit&) const {}
};

template <class Epi, class Sched, bool ALIGN_EPI = false, bool SP2 = false>
__device__ __forceinline__ void gemm_phase(PG8_LAS unsigned char* lds, const Gemm g, const Sched& S, const Epi& E) {
    int tid_l = threadIdx.x; asm volatile("" : "+v"(tid_l));
    const int tid = tid_l, wid = __builtin_amdgcn_readfirstlane(tid >> 6), lane = tid & 63, wr = wid >> 2, wc = wid & 3, fr = lane & 15, fq = lane >> 4;
    const int K = g.K, nt = K / BK;
    unsigned voffA[2], voffB[2];
#pragma unroll
    for (int i = 0; i < 2; ++i) { int R, C; stage_rc(tid * 16 + i * 8192, R, C); const int Rb = Epi::PERM ? ((R & ~31) + perm32(R & 31)) : R;
        voffA[i] = (unsigned)(R * K + C) * 2u; voffB[i] = (unsigned)(Rb * K + C) * 2u; }
    const size_t kstep = (size_t)(BK * 2);
    const size_t hstep = (size_t)HALF * K * 2;
    const size_t tstep = 2 * hstep;
    const unsigned ldsw = (unsigned)wid * 1024u;
    const int aoff = lds_byte(wr * 64 + fr, fq * 8), boff = lds_byte(wc * 32 + fr, fq * 8);
#define PG8_SA(b, h) (((b) * 2 + (h)) * HTB)
#define PG8_SB(b, h) ((4 + (b) * 2 + (h)) * HTB)
#define PG8_STAGE(bufoff, gbase, voff) do { _Pragma("unroll") for (int _i = 0; _i < 2; ++_i) \
        __builtin_amdgcn_global_load_lds((const unsigned*)((const char*)(gbase) + (voff)[_i]), (PG8_LAS unsigned*)(lds + (bufoff) + ldsw + _i * 8192), 16, 0, 0); } while (0)
#define PG8_LDA(dst, b, h) do { _Pragma("unroll") for (int m = 0; m < 4; ++m) _Pragma("unroll") for (int k = 0; k < 2; ++k) dst[m][k] = *(const PG8_LAS bf16x8*)(lds + PG8_SA(b, h) + aoff + m * 2048 + k * 1024); } while (0)
#define PG8_LDB(dst, b, h) do { _Pragma("unroll") for (int n = 0; n < 2; ++n) _Pragma("unroll") for (int k = 0; k < 2; ++k) dst[n][k] = *(const PG8_LAS bf16x8*)(lds + PG8_SB(b, h) + boff + n * 2048 + k * 1024); } while (0)
#define PG8_MMA(ai, bj, At, Bt) do { __builtin_amdgcn_s_setprio(1); _Pragma("unroll") for (int m = 0; m < 4; ++m) _Pragma("unroll") for (int n = 0; n < 2; ++n) _Pragma("unroll") for (int k = 0; k < 2; ++k) \
        acc[ai][bj][m][n] = __builtin_amdgcn_mfma_f32_16x16x32_bf16(Bt[n][k], At[m][k], acc[ai][bj][m][n], 0, 0, 0); __builtin_amdgcn_s_setprio(0); } while (0)
#define PG8_WAIT_V(n) asm volatile("s_waitcnt vmcnt(" #n ")" ::: "memory")
#define PG8_WAIT_L(n) asm volatile("s_waitcnt lgkmcnt(" #n ")" ::: "memory")
#define PG8_BAR __builtin_amdgcn_s_barrier()
#define PG8_SCHED __builtin_amdgcn_sched_barrier(0)
    Unit cur, nxt; int ui = 0;
    if (!S.next(0, cur)) return;
    f32x4 acc[2][2][4][2];
#pragma unroll
    for (int a = 0; a < 2; ++a)
#pragma unroll
        for (int b = 0; b < 2; ++b)
#pragma unroll
            for (int m = 0; m < 4; ++m)
#pragma unroll
                for (int n = 0; n < 2; ++n) acc[a][b][m][n] = (f32x4){0.f, 0.f, 0.f, 0.f};
    bf16x8 At[4][2], B0[2][2], B1[2][2];
    const char* cA = (const char*)g.A + (size_t)rowbase(cur.pm) * (size_t)(K * 2); const char* cB = (const char*)g.Bt + (size_t)cur.pn * tstep;
    S.a_ready(cur);
    if constexpr (SP2) {
        PG8_STAGE(PG8_SB(0, 0), cB, voffB); PG8_STAGE(PG8_SB(0, 1), cB + hstep, voffB); PG8_STAGE(PG8_SA(0, 0), cA, voffA); PG8_STAGE(PG8_SA(0, 1), cA + hstep, voffA);
        if (wr == 1) PG8_BAR;
        PG8_WAIT_V(2); PG8_BAR;
        PG8_STAGE(PG8_SB(1, 0), cB + kstep, voffB); PG8_STAGE(PG8_SA(1, 0), cA + kstep, voffA); PG8_STAGE(PG8_SB(1, 1), cB + hstep + kstep, voffB);
        PG8_WAIT_V(6); PG8_BAR;
    } else {
        PG8_STAGE(PG8_SB(0, 0), cB, voffB); PG8_STAGE(PG8_SA(0, 0), cA, voffA); PG8_STAGE(PG8_SB(0, 1), cB + hstep, voffB); PG8_STAGE(PG8_SA(0, 1), cA + hstep, voffA);
        if (wr == 1) PG8_BAR;
        PG8_WAIT_V(4); PG8_BAR;
        PG8_STAGE(PG8_SB(1, 0), cB + kstep, voffB); PG8_STAGE(PG8_SA(1, 0), cA + kstep, voffA); PG8_STAGE(PG8_SB(1, 1), cB + hstep + kstep, voffB);
        PG8_WAIT_V(6); PG8_BAR;
    }
    for (;;) {
        const bool has_next = S.next(ui + 1, nxt);
        const char* nA = has_next ? (const char*)g.A + (size_t)rowbase(nxt.pm) * (size_t)(K * 2) : cA; const char* nB = has_next ? (const char*)g.Bt + (size_t)nxt.pn * tstep : cB;
        for (int t = 0; t < nt; t += 2) {
            const bool last = (t == nt - 2);
            const char* a1 = cA + (size_t)(t + 1) * kstep;
            const char* a2 = last ? nA : cA + (size_t)(t + 2) * kstep; const char* b2 = last ? nB : cB + (size_t)(t + 2) * kstep;
            const char* a3 = a2 + kstep; const char* b3 = b2 + kstep;
            if (last && has_next) S.a_ready(nxt);
            if constexpr (SP2) {
            PG8_LDB(B0, 0, 0); PG8_LDB(B1, 0, 1); PG8_SCHED; PG8_LDA(At, 0, 0); PG8_STAGE(PG8_SA(1, 1), a1 + hstep, voffA);
            PG8_WAIT_V(8); PG8_WAIT_L(0); PG8_BAR; PG8_MMA(0, 0, At, B0); PG8_MMA(0, 1, At, B1); PG8_BAR; PG8_SCHED;
            PG8_LDA(At, 0, 1); PG8_STAGE(PG8_SB(0, 0), b2, voffB); PG8_STAGE(PG8_SB(0, 1), b2 + hstep, voffB); PG8_STAGE(PG8_SA(0, 0), a2, voffA);
            PG8_WAIT_V(8); PG8_WAIT_L(0); PG8_BAR; PG8_MMA(1, 0, At, B0); PG8_MMA(1, 1, At, B1); PG8_BAR; PG8_SCHED;
            PG8_LDB(B0, 1, 0); PG8_LDB(B1, 1, 1); PG8_SCHED; PG8_LDA(At, 1, 0); PG8_STAGE(PG8_SA(0, 1), a2 + hstep, voffA);
            PG8_WAIT_V(8); PG8_WAIT_L(0); PG8_BAR; PG8_MMA(0, 0, At, B0); PG8_MMA(0, 1, At, B1); PG8_BAR; PG8_SCHED;
            PG8_LDA(At, 1, 1); PG8_STAGE(PG8_SB(1, 0), b3, voffB); PG8_STAGE(PG8_SB(1, 1), b3 + hstep, voffB); PG8_STAGE(PG8_SA(1, 0), a3, voffA);
            PG8_WAIT_V(8); PG8_WAIT_L(0); PG8_BAR; PG8_MMA(1, 0, At, B0); PG8_MMA(1, 1, At, B1); PG8_BAR; PG8_SCHED;
            } else {
            PG8_LDB(B0, 0, 0); PG8_SCHED; PG8_LDA(At, 0, 0); PG8_STAGE(PG8_SA(1, 1), a1 + hstep, voffA);
            PG8_WAIT_L(8); PG8_BAR; PG8_WAIT_L(0); PG8_MMA(0, 0, At, B0); PG8_BAR; PG8_SCHED;
            PG8_LDB(B1, 0, 1); PG8_STAGE(PG8_SB(0, 0), b2, voffB);
            PG8_BAR; PG8_WAIT_L(0); PG8_MMA(0, 1, At, B1); PG8_BAR;
            PG8_LDA(At, 0, 1); PG8_STAGE(PG8_SA(0, 0), a2, voffA);
            PG8_BAR; PG8_WAIT_L(0); PG8_MMA(1, 0, At, B0); PG8_BAR; PG8_SCHED;
            PG8_STAGE(PG8_SB(0, 1), b2 + hstep, voffB);
            PG8_WAIT_V(6); PG8_BAR; PG8_MMA(1, 1, At, B1); PG8_BAR;
            PG8_LDB(B0, 1, 0); PG8_SCHED; PG8_LDA(At, 1, 0); PG8_STAGE(PG8_SA(0, 1), a2 + hstep, voffA);
            PG8_WAIT_L(8); PG8_BAR; PG8_WAIT_L(0); PG8_MMA(0, 0, At, B0); PG8_BAR; PG8_SCHED;
            PG8_LDB(B1, 1, 1); PG8_STAGE(PG8_SB(1, 0), b3, voffB);
            PG8_BAR; PG8_WAIT_L(0); PG8_MMA(0, 1, At, B1); PG8_BAR;
            PG8_LDA(At, 1, 1); PG8_STAGE(PG8_SA(1, 0), a3, voffA);
            PG8_BAR; PG8_WAIT_L(0); PG8_MMA(1, 0, At, B0); PG8_BAR; PG8_SCHED;
            PG8_STAGE(PG8_SB(1, 1), b3 + hstep, voffB);
            PG8_WAIT_V(6); PG8_BAR; PG8_MMA(1, 1, At, B1); PG8_BAR;
            }
        }
        if constexpr (ALIGN_EPI) { if (wr == 0) PG8_BAR; }
        if constexpr (!Epi::AFTER_DRAIN) { E(acc, cur, wr, wc, fr, fq); S.done(cur); }
        if (!has_next) break;
#pragma unroll
        for (int a = 0; a < 2; ++a)
#pragma unroll
            for (int b = 0; b < 2; ++b)
#pragma unroll
                for (int m = 0; m < 4; ++m)
#pragma unroll
                    for (int n = 0; n < 2; ++n) acc[a][b][m][n] = (f32x4){0.f, 0.f, 0.f, 0.f};
        cur = nxt; cA = nA; cB = nB; ++ui;
        if constexpr (ALIGN_EPI) { if (wr == 1) PG8_BAR; }
    }
    PG8_WAIT_V(0);
    if constexpr (!ALIGN_EPI) { if (wr == 0) PG8_BAR; }
    PG8_BAR;
    if constexpr (Epi::AFTER_DRAIN) { E.fused(acc, cur, wr, wc, fr, fq, lds, wid, lane); S.done(cur); }
#undef PG8_SA
#undef PG8_SB
#undef PG8_STAGE
#undef PG8_LDA
#undef PG8_LDB
#undef PG8_MMA
#undef PG8_WAIT_V
#undef PG8_WAIT_L
#undef PG8_BAR
#undef PG8_SCHED
}
}

#define LAS __attribute__((address_space(3)))
typedef unsigned short bf16_t;
typedef short bf16x8 __attribute__((ext_vector_type(8)));
typedef short s16x4 __attribute__((ext_vector_type(4)));
typedef float f32x2 __attribute__((ext_vector_type(2)));
typedef float f32x4 __attribute__((ext_vector_type(4)));
typedef float f32x16 __attribute__((ext_vector_type(16)));
typedef unsigned u32x2 __attribute__((ext_vector_type(2)));
typedef unsigned u32x4 __attribute__((ext_vector_type(4)));
typedef __bf16 bf16x2v __attribute__((ext_vector_type(2)));

constexpr int DM = 1024, NB = 8, SEQ = 4096, NMETA = 16, PADF = 112, PP = 4224, RP = NB * PP, DFF = 4096;
constexpr int NTHR = 512;
constexpr int LDS_BYTES = 147456;
constexpr size_t UNIT = (size_t)RP * 1024 * 2;
constexpr size_t WS_R0 = 0, WS_R1 = 2 * UNIT, WS_R2 = 3 * UNIT, WS_R3 = 4 * UNIT, WS_R4 = 5 * UNIT;
constexpr size_t WS_WIN = 6 * UNIT;
constexpr size_t WS_WOUT = WS_WIN + (size_t)5120 * 1024 * 2;
constexpr size_t WS_W1 = WS_WOUT + (size_t)1024 * 2048 * 2;
constexpr size_t WS_W2 = WS_W1 + 2 * (size_t)4096 * 1024 * 2;
constexpr size_t WS_WQKV = WS_W2 + 2 * (size_t)4096 * 1024 * 2;
constexpr size_t WS_WO = WS_WQKV + (size_t)3072 * 1024 * 2;
constexpr size_t WS_ROPE = WS_WO + (size_t)1024 * 1024 * 2;
constexpr size_t WS_SS = WS_ROPE + (size_t)PP * 64 * 8;
constexpr size_t SS_BYTES = (size_t)RP * 16 * 4;
constexpr size_t WS_METAH = WS_SS + 4 * SS_BYTES;
constexpr size_t WS_HM1 = WS_METAH;
constexpr size_t WS_HIDM = WS_HM1 + (size_t)16 * 1024 * 4;
constexpr size_t WS_HM2P = WS_HIDM + (size_t)16 * 4096 * 4;
constexpr size_t WS_END = WS_HM2P + (size_t)4 * 16 * 1024 * 4 + 16384;

__device__ __forceinline__ unsigned pk2(float a, float b) { f32x2 v = {a, b}; bf16x2v r = __builtin_convertvector(v, bf16x2v); return __builtin_bit_cast(unsigned, r); }
__device__ __forceinline__ float bf_lo(unsigned u) { return __uint_as_float(u << 16); }
__device__ __forceinline__ float bf_hi(unsigned u) { return __uint_as_float(u & 0xffff0000u); }
__device__ __forceinline__ float wave_sum(float v) {
#pragma unroll
    for (int o = 1; o < 64; o <<= 1) v += __shfl_xor(v, o);
    return v;
}
__device__ __forceinline__ float rs_of(const float* ssp, int row) {
    const f32x4* s = (const f32x4*)(ssp + (size_t)row * 16);
    const f32x4 a = (s[0] + s[1]) + (s[2] + s[3]);
    return rsqrtf(((a.x + a.y) + (a.z + a.w)) * (1.0f / 1024.0f) + 1e-6f);
}
__device__ __forceinline__ float lg2gamma(int h) { return h == 0 ? -0.04580368961312479f : h == 1 ? -0.02272007650008353f : h == 2 ? -0.011315313227834146f : -0.005646563141142063f; }
__device__ __forceinline__ float fexp2(float x) { return __builtin_amdgcn_exp2f(x); }
__device__ __forceinline__ float frcp(float x) { return __builtin_amdgcn_rcpf(x); }
__device__ __forceinline__ float sigmoidf_(float x) { return frcp(1.0f + fexp2(-1.4426950408889634f * x)); }
__device__ __forceinline__ int crow(int r, int h) { return (r & 3) + 8 * (r >> 2) + 4 * h; }
#define MFMA32(a, b, c) __builtin_amdgcn_mfma_f32_32x32x16_bf16((a), (b), (c), 0, 0, 0)
#define LDS_WAIT() asm volatile("s_waitcnt lgkmcnt(0)" ::: "memory")

__device__ __forceinline__ int l2p_in(int c) {
    if (c < 1024) { const int blk = c >> 9, cc = c & 511, head = cc >> 7, dd = cc & 127, n = dd >> 6, rem = dd & 63, wc = rem >> 4, fq = (rem >> 2) & 3, i = rem & 3;
        return blk * 512 + (head >> 1) * 256 + (head & 1) * 128 + wc * 32 + fq * 8 + n * 4 + i; }
    if (c < 3072) return c;
    const int cu = c - 3072, n = cu >> 10, ch = cu & 1023, pu = ch >> 7, r = ch & 127, bj = r >> 6, r2 = r & 63, wc = r2 >> 4, fq = (r2 >> 2) & 3, i = r2 & 3;
    return 3072 + pu * 256 + bj * 128 + wc * 32 + fq * 8 + n * 4 + i;
}
__device__ __forceinline__ int l2p_qkv(int c) {
    const int blk = c >> 10, cc = c & 1023, head = cc >> 6, d = cc & 63, pnp = head >> 2, wc = head & 3, bj = d >> 5, fq = (d >> 3) & 3, n = (d >> 2) & 1, i = d & 3;
    return blk * 1024 + pnp * 256 + bj * 128 + wc * 32 + fq * 8 + n * 4 + i;
}

typedef f32x4 AccT[2][2][4][2];

constexpr int RS_TAB_OFF = 140288;
__device__ __forceinline__ void build_rs_tab(const float* ssp, LAS float* tab, int rb, int wr, int wc, int fr, int fq) {
    const int t = (wr * 4 + wc) * 64 + fq * 16 + fr, row = t >> 1, half = t & 1;
    const f32x4* sp = (const f32x4*)(ssp + (size_t)(rb + row) * 16 + half * 8);
    const f32x4 a = sp[0] + sp[1];
    float sum = (a.x + a.y) + (a.z + a.w);
    sum += __shfl_xor(sum, 1);
    if (!half) tab[row] = rsqrtf(sum * (1.0f / 1024.0f) + 1e-6f);
    asm volatile("s_waitcnt lgkmcnt(0)" ::: "memory"); __builtin_amdgcn_s_barrier(); asm volatile("" ::: "memory");
}

struct EpiIn {
    static constexpr bool PERM = true, AFTER_DRAIN = false;
    const float* rsv; bf16_t *qk, *v, *gs, *hdn;
    __device__ __forceinline__ void operator()(const AccT& acc, const pg8::Unit& u, int wr, int wc, int fr, int fq) const {
        const int pn = u.pn, rb = rowbase(u.pm), pb = 128 + (u.pm & 15) * 256;
        float rsr[2][4];
#pragma unroll
        for (int ai = 0; ai < 2; ++ai)
#pragma unroll
            for (int m = 0; m < 4; ++m) rsr[ai][m] = rsv[rb + ai * 128 + wr * 64 + m * 16 + fr];
        float invf[4];
#pragma unroll
        for (int i = 0; i < 4; ++i) invf[i] = exp2f(-(float)(16 * wc + 4 * fq + i) * 0.20762050593046014f);
#pragma unroll
        for (int ai = 0; ai < 2; ++ai)
#pragma unroll
            for (int m = 0; m < 4; ++m) {
                const int loc = ai * 128 + wr * 64 + m * 16 + fr;
                const int row = rb + loc, p = pb + loc;
                const float rs = rsr[ai][m];
                if (pn < 4) {
                    float cs[4], sn[4];
#pragma unroll
                    for (int i = 0; i < 4; ++i) {
                        const float ang = (float)p * invf[i];
                        const float nrev = rintf(ang * 0.15915493667125702f);
                        float r = fmaf(ang, 0.15915493667125702f, -nrev); r = fmaf(ang, 6.4206382432985265e-09f, r);
                        cs[i] = __builtin_amdgcn_cosf(r); sn[i] = __builtin_amdgcn_sinf(r);
                    }
                    const float ip1 = (float)((p & 127) + 1);
#pragma unroll
                    for (int bj = 0; bj < 2; ++bj) {
                        const int head = 2 * (pn & 1) + bj;
                        const float lg = lg2gamma(head);
                        const float fac = (pn < 2) ? fexp2(ip1 * lg) : fexp2(-ip1 * lg) * 0.08838834764831845f;
                        const f32x4 x1 = acc[ai][bj][m][0] * rs, x2 = acc[ai][bj][m][1] * rs;
                        float y1[4], y2[4];
#pragma unroll
                        for (int i = 0; i < 4; ++i) { y1[i] = (x1[i] * cs[i] - x2[i] * sn[i]) * fac; y2[i] = (x1[i] * sn[i] + x2[i] * cs[i]) * fac; }
                        u32x4 w; w.x = pk2(y1[0], y1[1]); w.y = pk2(y1[2], y1[3]); w.z = pk2(y2[0], y2[1]); w.w = pk2(y2[2], y2[3]);
                        *(u32x4*)(qk + (size_t)row * 1024 + 256 * pn + 128 * bj + 32 * wc + 8 * fq) = w;
                    }
                } else if (pn < 8) {
#pragma unroll
                    for (int bj = 0; bj < 2; ++bj) {
                        const f32x4 a = acc[ai][bj][m][0] * rs, b = acc[ai][bj][m][1] * rs;
                        u32x4 w; w.x = pk2(a[0], a[1]); w.y = pk2(a[2], a[3]); w.z = pk2(b[0], b[1]); w.w = pk2(b[2], b[3]);
                        *(u32x4*)(v + (size_t)row * 1024 + 256 * (pn - 4) + 128 * bj + 32 * wc + 8 * fq) = w;
                    }
                } else if (pn < 12) {
#pragma unroll
                    for (int bj = 0; bj < 2; ++bj) {
                        f32x4 a = acc[ai][bj][m][0] * rs, b = acc[ai][bj][m][1] * rs;
#pragma unroll
                        for (int i = 0; i < 4; ++i) { a[i] = a[i] * sigmoidf_(a[i]); b[i] = b[i] * sigmoidf_(b[i]); }
                        u32x4 w; w.x = pk2(a[0], a[1]); w.y = pk2(a[2], a[3]); w.z = pk2(b[0], b[1]); w.w = pk2(b[2], b[3]);
                        *(u32x4*)(gs + (size_t)row * 1024 + 256 * (pn - 8) + 128 * bj + 32 * wc + 8 * fq) = w;
                    }
                } else {
#pragma unroll
                    for (int bj = 0; bj < 2; ++bj) {
                        const f32x4 a = acc[ai][bj][m][0] * rs, g = acc[ai][bj][m][1] * rs;
                        float o[4];
#pragma unroll
                        for (int i = 0; i < 4; ++i) o[i] = a[i] * sigmoidf_(g[i]);
                        u32x2 w; w.x = pk2(o[0], o[1]); w.y = pk2(o[2], o[3]);
                        *(u32x2*)(hdn + (size_t)row * 1024 + 128 * (pn - 12) + 64 * bj + 16 * wc + 4 * fq) = w;
                    }
                }
            }
    }
};

struct EpiRes {
    static constexpr bool PERM = true, AFTER_DRAIN = false;
    const float* bx; float* ox; bf16_t* hb; float* ssp; int write_aux;
    __device__ __forceinline__ void operator()(const AccT& acc, const pg8::Unit& u, int wr, int wc, int fr, int fq) const {
        const int col0 = u.pn * 256 + wc * 32 + 8 * fq, rb = rowbase(u.pm);
#pragma unroll
        for (int ai = 0; ai < 2; ++ai) {
            f32x4 base[4][2][2];
#pragma unroll
            for (int m = 0; m < 4; ++m) { const size_t off = (size_t)(u.pm * 256 + ai * 128 + wr * 64 + m * 16 + fr) * DM;
#pragma unroll
                for (int bj = 0; bj < 2; ++bj) { base[m][bj][0] = *(const f32x4*)(bx + off + col0 + 128 * bj); base[m][bj][1] = *(const f32x4*)(bx + off + col0 + 128 * bj + 4); } }
#pragma unroll
            for (int m = 0; m < 4; ++m) {
                const int loc = ai * 128 + wr * 64 + m * 16 + fr;
                const int row = rb + loc;
                const size_t off = (size_t)(u.pm * 256 + loc) * DM;
                float ss = 0.f;
#pragma unroll
                for (int bj = 0; bj < 2; ++bj) {
                    const f32x4 h0 = base[m][bj][0] + acc[ai][bj][m][0];
                    const f32x4 h1 = base[m][bj][1] + acc[ai][bj][m][1];
                    *(f32x4*)(ox + off + col0 + 128 * bj) = h0;
                    *(f32x4*)(ox + off + col0 + 128 * bj + 4) = h1;
                    if (write_aux) {
                        ss += (h0[0] * h0[0] + h0[1] * h0[1]) + (h0[2] * h0[2] + h0[3] * h0[3]) + (h1[0] * h1[0] + h1[1] * h1[1]) + (h1[2] * h1[2] + h1[3] * h1[3]);
                        u32x4 w; w.x = pk2(h0[0], h0[1]); w.y = pk2(h0[2], h0[3]); w.z = pk2(h1[0], h1[1]); w.w = pk2(h1[2], h1[3]);
                        *(u32x4*)(hb + (size_t)row * 1024 + col0 + 128 * bj) = w;
                    }
                }
                if (write_aux) {
                    ss += __shfl_xor(ss, 16); ss += __shfl_xor(ss, 32);
                    if (fq == 0) ssp[(size_t)row * 16 + u.pn * 4 + wc] = ss;
                }
            }
        }
    }
};

struct EpiUp {
    static constexpr bool PERM = true, AFTER_DRAIN = false;
    const float* ssp; bf16_t* hid; LAS float* tab;
    __device__ __forceinline__ void operator()(const AccT& acc, const pg8::Unit& u, int wr, int wc, int fr, int fq) const {
        const int col0 = u.pn * 256 + wc * 32 + 8 * fq, rb = rowbase(u.pm);
        build_rs_tab(ssp, tab, rb, wr, wc, fr, fq);
#pragma unroll
        for (int ai = 0; ai < 2; ++ai)
#pragma unroll
            for (int m = 0; m < 4; ++m) {
                const int loc = ai * 128 + wr * 64 + m * 16 + fr, row = rb + loc;
                const float rs = tab[loc];
#pragma unroll
                for (int bj = 0; bj < 2; ++bj) {
                    f32x4 a = acc[ai][bj][m][0] * rs, b = acc[ai][bj][m][1] * rs;
#pragma unroll
                    for (int i = 0; i < 4; ++i) { const float x = fmaxf(a[i], 0.f), y = fmaxf(b[i], 0.f); a[i] = x * x; b[i] = y * y; }
                    u32x4 w; w.x = pk2(a[0], a[1]); w.y = pk2(a[2], a[3]); w.z = pk2(b[0], b[1]); w.w = pk2(b[2], b[3]);
                    *(u32x4*)(hid + (size_t)row * DFF + col0 + 128 * bj) = w;
                }
            }
    }
};

struct EpiQkv {
    static constexpr bool PERM = true, AFTER_DRAIN = false;
    const float* ssp; const float* qg; const float* kg; bf16_t* qkv; LAS float* tab;
    __device__ __forceinline__ void operator()(const AccT& acc, const pg8::Unit& u, int wr, int wc, int fr, int fq) const {
        const int blk = u.pn >> 2, head = 4 * (u.pn & 3) + wc, rb = rowbase(u.pm);
        bf16_t* dst = qkv + (size_t)blk * (UNIT / 2);
        const float* gg = blk == 0 ? qg : kg;
        const f32x4 g00 = *(const f32x4*)(gg + 8 * fq), g01 = *(const f32x4*)(gg + 8 * fq + 4), g10 = *(const f32x4*)(gg + 32 + 8 * fq), g11 = *(const f32x4*)(gg + 32 + 8 * fq + 4);
        build_rs_tab(ssp, tab, rb, wr, wc, fr, fq);
        const float post = blk == 0 ? 0.18033688011112042f : 1.0f;
#pragma unroll
        for (int ai = 0; ai < 2; ++ai)
#pragma unroll
            for (int m = 0; m < 4; ++m) {
                const int loc = ai * 128 + wr * 64 + m * 16 + fr, row = rb + loc;
                const float rs = tab[loc];
                f32x4 v00 = acc[ai][0][m][0] * rs, v01 = acc[ai][0][m][1] * rs, v10 = acc[ai][1][m][0] * rs, v11 = acc[ai][1][m][1] * rs;
                if (blk < 2) {
                    const f32x4 t = v00 * v00 + v01 * v01 + v10 * v10 + v11 * v11;
                    float ss = (t[0] + t[1]) + (t[2] + t[3]);
                    ss += __shfl_xor(ss, 16); ss += __shfl_xor(ss, 32);
                    const float r2 = rsqrtf(ss * (1.0f / 64.0f) + 1e-6f) * post;
                    v00 = v00 * r2 * g00; v01 = v01 * r2 * g01; v10 = v10 * r2 * g10; v11 = v11 * r2 * g11;
                }
                u32x4 w0, w1;
                w0.x = pk2(v00[0], v00[1]); w0.y = pk2(v00[2], v00[3]); w0.z = pk2(v01[0], v01[1]); w0.w = pk2(v01[2], v01[3]);
                w1.x = pk2(v10[0], v10[1]); w1.y = pk2(v10[2], v10[3]); w1.z = pk2(v11[0], v11[1]); w1.w = pk2(v11[2], v11[3]);
                *(u32x4*)(dst + (size_t)row * 1024 + head * 64 + 8 * fq) = w0;
                *(u32x4*)(dst + (size_t)row * 1024 + head * 64 + 32 + 8 * fq) = w1;
            }
    }
};

struct Params {
    const float *x, *meta, *norm_mix_g, *norm_mlp_g, *even_w_in, *even_gn_g, *even_conv_w, *even_conv_b, *even_ln_g, *even_ln_b, *even_w_out,
        *odd_w_qkv, *odd_qn_g, *odd_kn_g, *odd_w_o, *mlp_w1, *mlp_w2;
    float* out; unsigned char* ws;
};
typedef const __attribute__((address_space(4))) Params CParams;
__device__ __forceinline__ CParams* kparams() { CParams* kp = (CParams*)__builtin_amdgcn_kernarg_segment_ptr(); asm volatile("" : "+s"(kp)); return kp; }
#define KP (*kparams())

template <int MODE>
__device__ __forceinline__ void p0_transpose_item(const float* W, int K, int N, bf16_t* WT, const float* gain, LAS float* scr, int item, int lane) {
    const int nblk = N / 32, kb = item / nblk, nb = item % nblk, k0 = 64 * kb, n0 = 32 * nb;
    float wv[32];
#pragma unroll
    for (int i = 0; i < 32; ++i) wv[i] = W[(size_t)(k0 + 2 * i + (lane >> 5)) * N + n0 + (lane & 31)];
#pragma unroll
    for (int i = 0; i < 32; ++i) { const int kk = 2 * i + (lane >> 5); float w = wv[i]; if (gain) w *= gain[k0 + kk]; scr[kk * 33 + (lane & 31)] = w; }
    LDS_WAIT();
    const int c = lane & 7;
#pragma unroll
    for (int j = 0; j < 4; ++j) { const int n = (lane >> 3) + 8 * j; const LAS float* s = scr + (8 * c) * 33 + n;
        const int lc = n0 + n; const int prow = MODE == 1 ? l2p_in(lc) : (MODE == 2 ? l2p_qkv(lc) : lc);
        u32x4 o; o.x = pk2(s[0 * 33], s[1 * 33]); o.y = pk2(s[2 * 33], s[3 * 33]); o.z = pk2(s[4 * 33], s[5 * 33]); o.w = pk2(s[6 * 33], s[7 * 33]);
        *(u32x4*)(WT + (size_t)prow * K + k0 + 8 * c) = o; }
    LDS_WAIT();
}

__device__ __forceinline__ void phase0(CParams& P, LAS unsigned char* lds, int tid) {
    const int lane = tid & 63, wave = tid >> 6;
    const int gw = blockIdx.x * 8 + wave, NGW = gridDim.x * 8;
    LAS float* scr = (LAS float*)(lds + wave * 16384);
    unsigned char* ws = P.ws;
    constexpr int I_IN = 16 * 160, I_OUT = 32 * 32, I_W1 = 16 * 128, I_W2 = 64 * 32, I_QKV = 16 * 96, I_O = 16 * 32;
    constexpr int NITEMS = I_IN + I_OUT + 2 * I_W1 + 2 * I_W2 + I_QKV + I_O;
    for (int it = gw; it < NITEMS; it += NGW) {
        int r = it;
        if (r < I_IN) { p0_transpose_item<1>(P.even_w_in, 1024, 5120, (bf16_t*)(ws + WS_WIN), P.norm_mix_g, scr, r, lane); continue; } r -= I_IN;
        if (r < I_OUT) { p0_transpose_item<0>(P.even_w_out, 2048, 1024, (bf16_t*)(ws + WS_WOUT), nullptr, scr, r, lane); continue; } r -= I_OUT;
        if (r < I_W1) { p0_transpose_item<0>(P.mlp_w1, 1024, 4096, (bf16_t*)(ws + WS_W1), P.norm_mlp_g, scr, r, lane); continue; } r -= I_W1;
        if (r < I_W1) { p0_transpose_item<0>(P.mlp_w1 + (size_t)1024 * 4096, 1024, 4096, (bf16_t*)(ws + WS_W1) + (size_t)4096 * 1024, P.norm_mlp_g + 1024, scr, r, lane); continue; } r -= I_W1;
        if (r < I_W2) { p0_transpose_item<0>(P.mlp_w2, 4096, 1024, (bf16_t*)(ws + WS_W2), nullptr, scr, r, lane); continue; } r -= I_W2;
        if (r < I_W2) { p0_transpose_item<0>(P.mlp_w2 + (size_t)1024 * 4096, 4096, 1024, (bf16_t*)(ws + WS_W2) + (size_t)4096 * 1024, nullptr, scr, r, lane); continue; } r -= I_W2;
        if (r < I_QKV) { p0_transpose_item<2>(P.odd_w_qkv, 1024, 3072, (bf16_t*)(ws + WS_WQKV), P.norm_mix_g + 1024, scr, r, lane); continue; } r -= I_QKV;
        p0_transpose_item<0>(P.odd_w_o, 1024, 1024, (bf16_t*)(ws + WS_WO), nullptr, scr, r, lane);
    }
    float* rope = (float*)(ws + WS_ROPE);
    for (int i = blockIdx.x * NTHR + tid; i < PP * 64; i += gridDim.x * NTHR) {
        const int p = i >> 6, d = i & 63;
        const float inv = exp2f(-(float)d * 0.20762050593046014f);
        const float ang = (float)p * inv;
        double t = (double)ang * 0.15915494309189535; t -= floor(t);
        const float tf = (float)t;
        rope[2 * i] = __builtin_amdgcn_cosf(tf); rope[2 * i + 1] = __builtin_amdgcn_sinf(tf);
    }
    bf16_t* hb = (bf16_t*)(ws + WS_R0);
    float* rs0 = (float*)(ws + WS_SS);
    for (int m0 = 2 * gw; m0 < NB * SEQ; m0 += 2 * NGW) {
        f32x4 v[2][4];
#pragma unroll
        for (int q = 0; q < 2; ++q) { const f32x4* xr = (const f32x4*)(P.x + (size_t)(m0 + q) * DM) + lane;
#pragma unroll
            for (int j = 0; j < 4; ++j) v[q][j] = xr[64 * j]; }
#pragma unroll
        for (int q = 0; q < 2; ++q) {
            const int m = m0 + q, row = rowbase(m >> 8) + (m & 255);
            u32x2* o8 = (u32x2*)(hb + (size_t)row * 1024) + lane;
            float ss = 0.f;
#pragma unroll
            for (int j = 0; j < 4; ++j) { const f32x4 t = v[q][j]; ss += (t.x * t.x + t.y * t.y) + (t.z * t.z + t.w * t.w); u32x2 w; w.x = pk2(t.x, t.y); w.y = pk2(t.z, t.w); o8[64 * j] = w; }
            ss = wave_sum(ss);
            if (lane == 0) rs0[row] = rsqrtf(ss * (1.0f / 1024.0f) + 1e-6f);
        }
    }
    for (int i = gw; i < NB * PADF; i += NGW) {
        const int b = i / PADF, p = i - b * PADF; const size_t row = (size_t)b * PP + p;
        const u32x4 z = (u32x4){0u, 0u, 0u, 0u};
        u32x4* d4 = (u32x4*)(ws + WS_R4 + row * 2048) + lane; d4[0] = z; d4[64] = z;
        u32x4* d1 = (u32x4*)(ws + WS_R1 + row * 2048) + lane; d1[0] = z; d1[64] = z;
        u32x4* d3 = (u32x4*)(ws + WS_R3 + row * 2048) + lane; d3[0] = z; d3[64] = z;
    }
}

template <int NCOL, bool ABF, bool NORM>
__device__ __forceinline__ void meta_wave(const void* Aptr, int K, const bf16_t* Wt, const int (&wrow)[NCOL], int w, int lane, float (&out)[2][NCOL], float (&rs)[2]) {
    float q0 = 0.f, q1 = 0.f;
#pragma unroll
    for (int c = 0; c < NCOL; ++c) { out[0][c] = 0.f; out[1][c] = 0.f; }
#pragma unroll 2
    for (int kc = lane; kc < (K >> 3); kc += 64) {
        float a0[8], a1[8];
        if (ABF) {
            const u32x4 u0 = *(const u32x4*)((const bf16_t*)Aptr + (size_t)(2 * w) * K + 8 * kc), u1 = *(const u32x4*)((const bf16_t*)Aptr + (size_t)(2 * w + 1) * K + 8 * kc);
            a0[0] = bf_lo(u0.x); a0[1] = bf_hi(u0.x); a0[2] = bf_lo(u0.y); a0[3] = bf_hi(u0.y); a0[4] = bf_lo(u0.z); a0[5] = bf_hi(u0.z); a0[6] = bf_lo(u0.w); a0[7] = bf_hi(u0.w);
            a1[0] = bf_lo(u1.x); a1[1] = bf_hi(u1.x); a1[2] = bf_lo(u1.y); a1[3] = bf_hi(u1.y); a1[4] = bf_lo(u1.z); a1[5] = bf_hi(u1.z); a1[6] = bf_lo(u1.w); a1[7] = bf_hi(u1.w);
        } else {
            const f32x4* p0 = (const f32x4*)((const float*)Aptr + (size_t)(2 * w) * K + 8 * kc); const f32x4* p1 = (const f32x4*)((const float*)Aptr + (size_t)(2 * w + 1) * K + 8 * kc);
            const f32x4 x0 = p0[0], x1 = p0[1], y0 = p1[0], y1 = p1[1];
#pragma unroll
            for (int i = 0; i < 4; ++i) { a0[i] = x0[i]; a0[4 + i] = x1[i]; a1[i] = y0[i]; a1[4 + i] = y1[i]; }
        }
        if (NORM) {
#pragma unroll
            for (int i = 0; i < 8; ++i) { q0 += a0[i] * a0[i]; q1 += a1[i] * a1[i]; }
        }
#pragma unroll
        for (int c = 0; c < NCOL; ++c) {
            const u32x4 wv = *(const u32x4*)(Wt + (size_t)wrow[c] * K + 8 * kc);
            const float wf[8] = {bf_lo(wv.x), bf_hi(wv.x), bf_lo(wv.y), bf_hi(wv.y), bf_lo(wv.z), bf_hi(wv.z), bf_lo(wv.w), bf_hi(wv.w)};
#pragma unroll
            for (int i = 0; i < 8; ++i) { out[0][c] += a0[i] * wf[i]; out[1][c] += a1[i] * wf[i]; }
        }
    }
#pragma unroll
    for (int c = 0; c < NCOL; ++c) { out[0][c] = wave_sum(out[0][c]); out[1][c] = wave_sum(out[1][c]); }
    if (NORM) { rs[0] = rsqrtf(wave_sum(q0) / (float)K + 1e-6f); rs[1] = rsqrtf(wave_sum(q1) / (float)K + 1e-6f); } else { rs[0] = 1.f; rs[1] = 1.f; }
}
template <int NN>
__device__ __forceinline__ float pick(LAS float* scr, const float (&a)[NN], int j, int lane) {
    if (lane == 0) {
#pragma unroll
        for (int i = 0; i < NN; ++i) scr[i] = a[i];
    }
    LDS_WAIT();
    const float r = scr[j];
    LDS_WAIT();
    return r;
}
__device__ __forceinline__ bf16_t bf1(float x) { return (bf16_t)(pk2(x, 0.f) & 0xffffu); }
__device__ __forceinline__ void store_meta_rows(bf16_t* buf, int r, int col, float val) {
    const bf16_t bv = bf1(val);
#pragma unroll
    for (int b = 0; b < NB; ++b) buf[((size_t)b * PP + PADF + r) * 1024 + col] = bv;
}
__device__ __forceinline__ void meta_in(CParams& P, LAS unsigned char* lds, int t, int tid) {
    const int lane = tid & 63, w = __builtin_amdgcn_readfirstlane(tid >> 6); int cb1, cb2, kind;
    if (t < 64) { const int pid = t * 8, blk = pid >> 8, head = (pid >> 6) & 3, d = pid & 63; kind = blk; cb1 = blk * 512 + head * 128 + d; cb2 = cb1 + 64; }
    else if (t < 192) { cb1 = 1024 + (t - 64) * 16; cb2 = cb1 + 8; kind = cb1 < 2048 ? 2 : 3; }
    else { kind = 4; cb1 = 3072 + (t - 192) * 8; cb2 = cb1 + 1024; }
    float o[2][16], rsv[2];
    int wrow[16];
#pragma unroll
    for (int c = 0; c < 8; ++c) { wrow[c] = l2p_in(cb1 + c); wrow[8 + c] = l2p_in(cb2 + c); }
    meta_wave<16, false, true>(P.meta, 1024, (const bf16_t*)(P.ws + WS_WIN), wrow, w, lane, o, rsv);
    unsigned char* ws = P.ws;
    const int j = lane & 7;
#pragma unroll
    for (int i = 0; i < 2; ++i) {
        const int r = 2 * w + i, p = PADF + r;
        if (kind <= 1 || kind == 4) {
            float lo8[8], hi8[8];
#pragma unroll
            for (int c = 0; c < 8; ++c) { lo8[c] = o[i][c]; hi8[c] = o[i][8 + c]; }
            const float y1 = pick<8>((LAS float*)(lds + 131072 + w * 1024), lo8, j, lane) * rsv[i], y2 = pick<8>((LAS float*)(lds + 131072 + w * 1024), hi8, j, lane) * rsv[i];
            if (lane < 8) {
                if (kind <= 1) {
                    const int head = (cb1 >> 7) & 3, d = (cb1 & 63) + j;
                    const float* rope = (const float*)(ws + WS_ROPE) + ((size_t)p * 64 + d) * 2;
                    const float c = rope[0], sn = rope[1];
                    const float ip1 = (float)(p + 1), lg = lg2gamma(head);
                    const float fac = kind == 0 ? fexp2(ip1 * lg) : fexp2(-ip1 * lg) * 0.08838834764831845f;
                    store_meta_rows((bf16_t*)(ws + WS_R4), r, l2p_in(cb1 + j), (y1 * c - y2 * sn) * fac);
                    store_meta_rows((bf16_t*)(ws + WS_R4), r, l2p_in(cb2 + j), (y1 * sn + y2 * c) * fac);
                } else {
                    store_meta_rows((bf16_t*)(ws + WS_R3), r, cb1 - 3072 + j, y1 * sigmoidf_(y2));
                }
            }
        } else {
            const float y = pick<16>((LAS float*)(lds + 131072 + w * 1024), o[i], lane & 15, lane) * rsv[i];
            if (lane < 16) {
                if (kind == 2) store_meta_rows((bf16_t*)(ws + WS_R1), r, cb1 - 1024 + lane, y);
                else store_meta_rows((bf16_t*)(ws + WS_R2), r, cb1 - 2048 + lane, y * sigmoidf_(y));
            }
        }
    }
}
__device__ __forceinline__ void meta_out(CParams& P, LAS unsigned char* lds, int t, int tid) {
    const int lane = tid & 63, w = __builtin_amdgcn_readfirstlane(tid >> 6);
    float o[2][4], rsv[2];
    const int wrow[4] = {4 * t, 4 * t + 1, 4 * t + 2, 4 * t + 3};
    meta_wave<4, true, false>((const bf16_t*)(P.ws + WS_R0) + (size_t)PADF * 2048, 2048, (const bf16_t*)(P.ws + WS_WOUT), wrow, w, lane, o, rsv);
    float* hm1 = (float*)(P.ws + WS_HM1);
#pragma unroll
    for (int i = 0; i < 2; ++i) { const int r = 2 * w + i; const float y = pick<4>((LAS float*)(lds + 131072 + w * 1024), o[i], lane & 3, lane); if (lane < 4) hm1[r * 1024 + 4 * t + lane] = P.meta[r * 1024 + 4 * t + lane] + y; }
}
__device__ __forceinline__ void meta_up(CParams& P, LAS unsigned char* lds, int t, int tid) {
    const int lane = tid & 63, w = __builtin_amdgcn_readfirstlane(tid >> 6);
    float o[2][16], rsv[2];
    int wrow[16];
#pragma unroll
    for (int c = 0; c < 16; ++c) wrow[c] = 16 * t + c;
    meta_wave<16, false, true>((const float*)(P.ws + WS_HM1), 1024, (const bf16_t*)(P.ws + WS_W1), wrow, w, lane, o, rsv);
    float* hid = (float*)(P.ws + WS_HIDM);
#pragma unroll
    for (int i = 0; i < 2; ++i) { const int r = 2 * w + i; const float x = fmaxf(pick<16>((LAS float*)(lds + 131072 + w * 1024), o[i], lane & 15, lane) * rsv[i], 0.f); if (lane < 16) hid[r * 4096 + 16 * t + lane] = x * x; }
}
__device__ __forceinline__ void meta_down(CParams& P, LAS unsigned char* lds, int t, int tid) {
    const int lane = tid & 63, w = __builtin_amdgcn_readfirstlane(tid >> 6);
    float o[2][4], rsv[2];
    const int wrow[4] = {4 * t, 4 * t + 1, 4 * t + 2, 4 * t + 3};
    meta_wave<4, false, false>((const float*)(P.ws + WS_HIDM), 4096, (const bf16_t*)(P.ws + WS_W2), wrow, w, lane, o, rsv);
    const float* hm1 = (const float*)(P.ws + WS_HM1);
    float* hm2 = (float*)(P.ws + WS_HM2P);
#pragma unroll
    for (int i = 0; i < 2; ++i) { const int r = 2 * w + i; const float y = pick<4>((LAS float*)(lds + 131072 + w * 1024), o[i], lane & 3, lane); if (lane < 4) hm2[r * 1024 + 4 * t + lane] = hm1[r * 1024 + 4 * t + lane] + y; }
}
constexpr size_t WS_KRAW = WS_HIDM, WS_VRAW = WS_HIDM + 65536, WS_KSS = WS_HIDM + 131072;
__device__ __forceinline__ void meta_kv(CParams& P, LAS unsigned char* lds, int t, int tid) {
    const int lane = tid & 63, w = __builtin_amdgcn_readfirstlane(tid >> 6);
    const int cb = 1024 + 16 * t;
    float o[2][16], rsv[2];
    int wrow[16];
#pragma unroll
    for (int c = 0; c < 16; ++c) wrow[c] = l2p_qkv(cb + c);
    meta_wave<16, false, true>((const float*)(P.ws + WS_HM2P), 1024, (const bf16_t*)(P.ws + WS_WQKV), wrow, w, lane, o, rsv);
    float* raw = (float*)(P.ws + (t < 64 ? WS_KRAW : WS_VRAW));
    float* kss = (float*)(P.ws + WS_KSS);
#pragma unroll
    for (int i = 0; i < 2; ++i) {
        const int r = 2 * w + i; float ss = 0.f;
#pragma unroll
        for (int c = 0; c < 16; ++c) { o[i][c] *= rsv[i]; ss += o[i][c] * o[i][c]; }
        const float y = pick<16>((LAS float*)(lds + 131072 + w * 1024), o[i], lane & 15, lane);
        if (lane < 16) raw[r * 1024 + 16 * (t & 63) + lane] = y;
        if (t < 64 && lane == 0) kss[r * 64 + t] = ss;
    }
}

__device__ __forceinline__ void load_T128(const bf16_t* src, int ld, int ncg, LAS unsigned char* dst, int tid) {
    for (int u = tid; u < 64 * ncg; u += NTHR) {
        const int jp = u & 63, cgi = u >> 6;
        const u32x4 a = *(const u32x4*)(src + (size_t)(2 * jp) * ld + cgi * 8), b = *(const u32x4*)(src + (size_t)(2 * jp + 1) * ld + cgi * 8);
        LAS unsigned* d = (LAS unsigned*)(dst + (cgi * 8) * 272 + jp * 4);
        d[0 * 68] = (a.x & 0xffffu) | (b.x << 16); d[1 * 68] = (a.x >> 16) | (b.x & 0xffff0000u);
        d[2 * 68] = (a.y & 0xffffu) | (b.y << 16); d[3 * 68] = (a.y >> 16) | (b.y & 0xffff0000u);
        d[4 * 68] = (a.z & 0xffffu) | (b.z << 16); d[5 * 68] = (a.z >> 16) | (b.z & 0xffff0000u);
        d[6 * 68] = (a.w & 0xffffu) | (b.w << 16); d[7 * 68] = (a.w >> 16) | (b.w & 0xffff0000u);
    }
}
template <int NU>
__device__ __forceinline__ void tload_issue(u32x4 (&a)[NU], u32x4 (&b)[NU], const bf16_t* src, int ld, int tid) {
#pragma unroll
    for (int i = 0; i < NU; ++i) { const int u = tid + i * NTHR, jp = u & 63, cgi = u >> 6;
        a[i] = *(const u32x4*)(src + (size_t)(2 * jp) * ld + cgi * 8); b[i] = *(const u32x4*)(src + (size_t)(2 * jp + 1) * ld + cgi * 8); }
}
template <int NU>
__device__ __forceinline__ void tload_store(const u32x4 (&a)[NU], const u32x4 (&b)[NU], LAS unsigned char* dst, int tid) {
#pragma unroll
    for (int i = 0; i < NU; ++i) { const int u = tid + i * NTHR, jp = u & 63, cgi = u >> 6;
        LAS unsigned* d = (LAS unsigned*)(dst + (cgi * 8) * 272 + jp * 4);
        d[0 * 68] = (a[i].x & 0xffffu) | (b[i].x << 16); d[1 * 68] = (a[i].x >> 16) | (b[i].x & 0xffff0000u);
        d[2 * 68] = (a[i].y & 0xffffu) | (b[i].y << 16); d[3 * 68] = (a[i].y >> 16) | (b[i].y & 0xffff0000u);
        d[4 * 68] = (a[i].z & 0xffffu) | (b[i].z << 16); d[5 * 68] = (a[i].z >> 16) | (b[i].z & 0xffff0000u);
        d[6 * 68] = (a[i].w & 0xffffu) | (b[i].w << 16); d[7 * 68] = (a[i].w >> 16) | (b[i].w & 0xffff0000u); }
}
constexpr int RET_KS = 0, RET_VT = 34816, RET_RED = 34816 + 69632;

__device__ __forceinline__ void ret_partial_item(CParams& P, LAS unsigned char* lds, int item, int tid) {
    asm volatile("" : "+v"(tid));
    const int lane = tid & 63, w = tid >> 6, l32 = lane & 31, hh = lane >> 5;
    int b, n, h;
    if (item < 128) { b = 0; n = item >> 2; h = item & 3; } else { const int j = item - 128; b = 1 + j / 124; const int r = j - (b - 1) * 124; n = 1 + (r >> 2); h = r & 3; }
    const bf16_t* qk = (const bf16_t*)(P.ws + WS_R4); const bf16_t* v = (const bf16_t*)(P.ws + WS_R1);
    bf16_t* G = (n == 0) ? (bf16_t*)P.out + (size_t)(1024 + h) * 32768 : (bf16_t*)P.out + ((size_t)((b * 4 + h) * 32 + n)) * 32768;
    const size_t R0 = (size_t)b * PP + 128 * n;
    {
        u32x4 ka[2], kb[2], va[4], vb[4];
        tload_issue<2>(ka, kb, qk + R0 * 1024 + 512 + h * 128, 1024, tid);
        tload_issue<4>(va, vb, v + R0 * 1024 + h * 256, 1024, tid);
        tload_store<2>(ka, kb, lds + RET_KS, tid);
        tload_store<4>(va, vb, lds + RET_VT, tid);
    }
    __syncthreads();
    const int dt = w & 3, eh = w >> 2;
    f32x16 acc[4];
#pragma unroll
    for (int et = 0; et < 4; ++et)
#pragma unroll
        for (int r = 0; r < 16; ++r) acc[et][r] = 0.f;
#pragma unroll
    for (int s = 0; s < 8; ++s) {
        const bf16x8 a = *(const LAS bf16x8*)(lds + RET_KS + (32 * dt + l32) * 272 + (16 * s + 8 * hh) * 2);
#pragma unroll
        for (int et = 0; et < 4; ++et) {
            const bf16x8 bb = *(const LAS bf16x8*)(lds + RET_VT + (32 * (4 * eh + et) + l32) * 272 + (16 * s + 8 * hh) * 2);
            acc[et] = MFMA32(a, bb, acc[et]);
        }
    }
    __syncthreads();
#pragma unroll
    for (int et = 0; et < 4; ++et)
#pragma unroll
        for (int g = 0; g < 4; ++g) {
            u32x2 o; o.x = pk2(acc[et][4 * g], acc[et][4 * g + 1]); o.y = pk2(acc[et][4 * g + 2], acc[et][4 * g + 3]);
            *(LAS u32x2*)(lds + RET_VT + (32 * (4 * eh + et) + l32) * 272 + (32 * dt + 8 * g + 4 * hh) * 2) = o;
        }
    __syncthreads();
    for (int c = tid; c < 4096; c += NTHR) { const int e = c >> 4, part = c & 15; *(u32x4*)(G + (size_t)c * 8) = *(const LAS u32x4*)(lds + RET_VT + e * 272 + part * 16); }
    __syncthreads();
}

template <int NT>
__device__ __forceinline__ void conv_item(CParams& P, LAS unsigned char* lds, int b, int p0, int tid) {
    const int lane = tid & 63, w = tid >> 6;
    const bf16_t* hdn = (const bf16_t*)(P.ws + WS_R3);
    bf16_t* mix = (bf16_t*)(P.ws + WS_R0);
    const size_t Rb = (size_t)b * PP;
    const unsigned* hd = (const unsigned*)(hdn + (Rb + p0 - 30) * 1024) + tid;
    unsigned xr[NT + 30];
#pragma unroll
    for (int r = 0; r < NT + 30; ++r) xr[r] = hd[r * 512];
    f32x2 W[31];
#pragma unroll
    for (int k = 0; k < 31; ++k) W[k] = *(const f32x2*)(P.even_conv_w + k * 1024 + 2 * tid);
    const f32x2 bias = *(const f32x2*)(P.even_conv_b + 2 * tid);
    LAS float* ys = (LAS float*)lds;
#pragma unroll
    for (int hf = 0; hf < NT / 16; ++hf) {
        f32x2 acc[16];
#pragma unroll
        for (int t = 0; t < 16; ++t) acc[t] = bias;
#pragma unroll
        for (int r = 0; r < 46; ++r) {
            const f32x2 xf = {bf_lo(xr[16 * hf + r]), bf_hi(xr[16 * hf + r])};
#pragma unroll
            for (int t = 0; t < 16; ++t) { const int k = r - t; if (k >= 0 && k <= 30) acc[t] += xf * W[k]; }
        }
#pragma unroll
        for (int t = 0; t < 16; ++t) *(LAS f32x2*)(ys + (16 * hf + t) * 1024 + 2 * tid) = acc[t];
    }
    f32x4 lg[4], lb[4];
#pragma unroll
    for (int j = 0; j < 4; ++j) { lg[j] = *(const f32x4*)(P.even_ln_g + 4 * lane + 256 * j); lb[j] = *(const f32x4*)(P.even_ln_b + 4 * lane + 256 * j); }
    __syncthreads();
    constexpr int TW = NT / 8;
#pragma unroll
    for (int q0 = 0; q0 < TW; q0 += 2) {
        f32x4 y[2][4]; float s[2] = {0.f, 0.f};
#pragma unroll
        for (int q = 0; q < 2; ++q)
#pragma unroll
            for (int j = 0; j < 4; ++j) { y[q][j] = *(const LAS f32x4*)(ys + (TW * w + q0 + q) * 1024 + 4 * lane + 256 * j); s[q] += (y[q][j].x + y[q][j].y) + (y[q][j].z + y[q][j].w); }
#pragma unroll
        for (int o = 1; o < 64; o <<= 1) { s[0] += __shfl_xor(s[0], o); s[1] += __shfl_xor(s[1], o); }
        float qv[2] = {0.f, 0.f};
#pragma unroll
        for (int q = 0; q < 2; ++q) { const float mean = s[q] * (1.0f / 1024.0f);
#pragma unroll
            for (int j = 0; j < 4; ++j) { y[q][j] = y[q][j] - mean; qv[q] += (y[q][j].x * y[q][j].x + y[q][j].y * y[q][j].y) + (y[q][j].z * y[q][j].z + y[q][j].w * y[q][j].w); } }
#pragma unroll
        for (int o = 1; o < 64; o <<= 1) { qv[0] += __shfl_xor(qv[0], o); qv[1] += __shfl_xor(qv[1], o); }
#pragma unroll
        for (int q = 0; q < 2; ++q) {
            const float rstd = rsqrtf(qv[q] * (1.0f / 1024.0f) + 1e-6f);
            const size_t row = Rb + p0 + TW * w + q0 + q;
#pragma unroll
            for (int j = 0; j < 4; ++j) {
                f32x4 o = y[q][j] * rstd * lg[j] + lb[j];
#pragma unroll
                for (int i = 0; i < 4; ++i) o[i] = o[i] * sigmoidf_(o[i]);
                u32x2 wv; wv.x = pk2(o[0], o[1]); wv.y = pk2(o[2], o[3]);
                *(u32x2*)(mix + row * 2048 + 1024 + 4 * lane + 256 * j) = wv;
            }
        }
    }
    __syncthreads();
}

__device__ __forceinline__ void ret_scan(CParams& P, int tid) {
    bf16_t* G = (bf16_t*)P.out;
    for (int c = blockIdx.x * NTHR + tid; c < 32 * 4096; c += gridDim.x * NTHR) {
        const int bh = c >> 12, off = (c & 4095) * 8, h = bh & 3;
        const float lam = fexp2(128.0f * lg2gamma(h));
        bf16_t* ptr = G + (size_t)bh * 32 * 32768 + off;
        float S[8];
#pragma unroll
        for (int k = 0; k < 8; ++k) S[k] = 0.f;
#pragma unroll 8
        for (int n = 0; n < 32; ++n) {
            const u32x4 g = (n == 0) ? *(const u32x4*)(G + (size_t)(1024 + h) * 32768 + off) : *(const u32x4*)(ptr + (size_t)n * 32768);
            S[0] = lam * (S[0] + bf_lo(g.x)); S[1] = lam * (S[1] + bf_hi(g.x)); S[2] = lam * (S[2] + bf_lo(g.y)); S[3] = lam * (S[3] + bf_hi(g.y));
            S[4] = lam * (S[4] + bf_lo(g.z)); S[5] = lam * (S[5] + bf_hi(g.z)); S[6] = lam * (S[6] + bf_lo(g.w)); S[7] = lam * (S[7] + bf_hi(g.w));
            u32x4 o; o.x = pk2(S[0], S[1]); o.y = pk2(S[2], S[3]); o.z = pk2(S[4], S[5]); o.w = pk2(S[6], S[7]);
            *(u32x4*)(ptr + (size_t)n * 32768) = o;
        }
    }
}

__device__ __forceinline__ void ret_out_item(CParams& P, LAS unsigned char* lds, int item, int tid) {
    asm volatile("" : "+v"(tid));
    const int lane = tid & 63, w = tid >> 6, l32 = lane & 31, hh = lane >> 5;
    const int b = item / 132, rem = item - b * 132, n = rem >> 2, h = rem & 3;
    const bf16_t* qk = (const bf16_t*)(P.ws + WS_R4); const bf16_t* v = (const bf16_t*)(P.ws + WS_R1); const bf16_t* gs = (const bf16_t*)(P.ws + WS_R2);
    bf16_t* mix = (bf16_t*)(P.ws + WS_R0);
    const size_t R0 = (size_t)b * PP + 128 * n;
    const int ib = w & 3, eh = w >> 2;
    bf16x8 qf[8];
    {
        u32x4 kt[4], va[4], vb[4];
#pragma unroll
        for (int i = 0; i < 4; ++i) { const int c = tid + i * NTHR; kt[i] = *(const u32x4*)(qk + (R0 + (c >> 4)) * 1024 + 512 + h * 128 + (c & 15) * 8); }
        tload_issue<4>(va, vb, v + R0 * 1024 + h * 256, 1024, tid);
#pragma unroll
        for (int s = 0; s < 8; ++s) qf[s] = *(const bf16x8*)(qk + (R0 + 32 * ib + l32) * 1024 + h * 128 + 16 * s + 8 * hh);
#pragma unroll
        for (int i = 0; i < 4; ++i) { const int c = tid + i * NTHR; *(LAS u32x4*)(lds + RET_KS + (c >> 4) * 272 + (c & 15) * 16) = kt[i]; }
        tload_store<4>(va, vb, lds + RET_VT, tid);
    }
    const bf16_t* prev = (const bf16_t*)P.out + ((size_t)((b * 4 + h) * 32 + (n > 0 ? n - 1 : 0))) * 32768;
    bf16x8 pf[4][4];
    if (n > 0) {
#pragma unroll
        for (int s = 0; s < 4; ++s)
#pragma unroll
            for (int et = 0; et < 4; ++et) pf[s][et] = *(const bf16x8*)(prev + (size_t)(32 * (4 * eh + et) + l32) * 128 + 16 * s + 8 * hh);
    }
    __syncthreads();
    f32x16 O[4];
#pragma unroll
    for (int et = 0; et < 4; ++et)
#pragma unroll
        for (int r = 0; r < 16; ++r) O[et][r] = 0.f;
    if (n > 0) {
#pragma unroll
        for (int s = 0; s < 4; ++s)
#pragma unroll
            for (int et = 0; et < 4; ++et) O[et] = MFMA32(pf[s][et], qf[s], O[et]);
#pragma unroll
        for (int s = 4; s < 8; ++s)
#pragma unroll
            for (int et = 0; et < 4; ++et) {
                const bf16x8 a = *(const bf16x8*)(prev + (size_t)(32 * (4 * eh + et) + l32) * 128 + 16 * s + 8 * hh);
                O[et] = MFMA32(a, qf[s], O[et]);
            }
    }
#pragma unroll 1
    for (int jt = 0; jt <= ib; ++jt) {
        f32x16 x;
#pragma unroll
        for (int r = 0; r < 16; ++r) x[r] = 0.f;
#pragma unroll
        for (int s = 0; s < 8; ++s) {
            const bf16x8 a = *(const LAS bf16x8*)(lds + RET_KS + (32 * jt + l32) * 272 + (16 * s + 8 * hh) * 2);
            x = MFMA32(a, qf[s], x);
        }
        if (jt == ib) {
#pragma unroll
            for (int r = 0; r < 16; ++r) x[r] = (crow(r, hh) > l32) ? 0.f : x[r];
        }
        u32x4 p0, p1;
        p0.x = pk2(x[0], x[1]); p0.y = pk2(x[2], x[3]); p0.z = pk2(x[4], x[5]); p0.w = pk2(x[6], x[7]);
        p1.x = pk2(x[8], x[9]); p1.y = pk2(x[10], x[11]); p1.z = pk2(x[12], x[13]); p1.w = pk2(x[14], x[15]);
        const bf16x8 pb0 = __builtin_bit_cast(bf16x8, p0), pb1 = __builtin_bit_cast(bf16x8, p1);
#pragma unroll
        for (int et = 0; et < 4; ++et) {
            const LAS unsigned char* vp = lds + RET_VT + (32 * (4 * eh + et) + l32) * 272 + (32 * jt + 4 * hh) * 2;
            const s16x4 lo0 = *(const LAS s16x4*)(vp), hi0 = *(const LAS s16x4*)(vp + 16), lo1 = *(const LAS s16x4*)(vp + 32), hi1 = *(const LAS s16x4*)(vp + 48);
            O[et] = MFMA32(__builtin_shufflevector(lo0, hi0, 0, 1, 2, 3, 4, 5, 6, 7), pb0, O[et]);
            O[et] = MFMA32(__builtin_shufflevector(lo1, hi1, 0, 1, 2, 3, 4, 5, 6, 7), pb1, O[et]);
        }
    }
    float sm = 0.f, sq = 0.f;
#pragma unroll
    for (int et = 0; et < 4; ++et)
#pragma unroll
        for (int r = 0; r < 16; ++r) { const float t = O[et][r]; sm += t; sq += t * t; }
    sm += __shfl_xor(sm, 32); sq += __shfl_xor(sq, 32);
    LAS f32x2* red = (LAS f32x2*)(lds + RET_RED);
    if (hh == 0) red[w * 32 + l32] = (f32x2){sm, sq};
    const f32x4 gn = *(const f32x4*)(P.even_gn_g + h * 256 + 4 * lane);
    u32x2 gvr[16];
#pragma unroll
    for (int it = 0; it < 16; ++it) gvr[it] = *(const u32x2*)(gs + (R0 + w * 16 + it) * 1024 + h * 256 + 4 * lane);
    __syncthreads();
    { const f32x2 o = red[(w ^ 4) * 32 + l32]; sm += o.x; sq += o.y; }
    const float mean = sm * (1.0f / 256.0f);
    const float rstd = rsqrtf(fmaxf(sq * (1.0f / 256.0f) - mean * mean, 0.f) + 1e-6f);
#pragma unroll
    for (int et = 0; et < 4; ++et)
#pragma unroll
        for (int g = 0; g < 4; ++g) {
            u32x2 o; o.x = pk2((O[et][4 * g] - mean) * rstd, (O[et][4 * g + 1] - mean) * rstd); o.y = pk2((O[et][4 * g + 2] - mean) * rstd, (O[et][4 * g + 3] - mean) * rstd);
            *(LAS u32x2*)(lds + RET_VT + (32 * ib + l32) * 520 + (32 * (4 * eh + et) + 8 * g + 4 * hh) * 2) = o;
        }
    __syncthreads();
#pragma unroll
    for (int it = 0; it < 16; ++it) {
        const int i = w * 16 + it;
        const u32x2 val = *(const LAS u32x2*)(lds + RET_VT + i * 520 + lane * 8);
        const u32x2 gv = gvr[it];
        u32x2 o; o.x = pk2(bf_lo(val.x) * gn.x * bf_lo(gv.x), bf_hi(val.x) * gn.y * bf_hi(gv.x)); o.y = pk2(bf_lo(val.y) * gn.z * bf_lo(gv.y), bf_hi(val.y) * gn.w * bf_hi(gv.y));
        *(u32x2*)(mix + (R0 + i) * 2048 + h * 256 + 4 * lane) = o;
    }
    __syncthreads();
}

constexpr int AT_KS = 0, AT_VT = 9216, AT_FLAG = 18432, AT_OST = 18688;
template <bool MASK>
__device__ __forceinline__ void sb_subtile(f32x16& x, float& C, int hh, int key0, int qidx, u32x4& p0, u32x4& p1) {
    f32x2 e2[2][4], d2[2][4];
#pragma unroll
    for (int gp = 0; gp < 2; ++gp)
#pragma unroll
        for (int j = 0; j < 4; ++j) {
            float ev[2];
#pragma unroll
            for (int c = 0; c < 2; ++c) {
                const int r = 4 * (2 * gp + c) + j;
                float t = fexp2(__builtin_amdgcn_fmed3f(x[r], -126.f, 30.f));
                if (MASK) { const int key = key0 + crow(r, hh); t = (key < qidx && key >= PADF) ? t : 0.f; }
                ev[c] = t;
            }
            e2[gp][j] = (f32x2){ev[0], ev[1]};
            d2[gp][j] = e2[gp][j] + 1.0f;
        }
    float pg[4], qg[4], T[4];
#pragma unroll
    for (int gp = 0; gp < 2; ++gp) {
        const f32x2 Q = (d2[gp][3] * d2[gp][2]) * (d2[gp][1] * d2[gp][0]);
        pg[2 * gp] = frcp(Q.x); pg[2 * gp + 1] = frcp(Q.y);
    }
#pragma unroll
    for (int g = 0; g < 4; ++g) qg[g] = __shfl_xor(pg[g], 32);
    T[3] = C; T[2] = T[3] * (pg[3] * qg[3]); T[1] = T[2] * (pg[2] * qg[2]); T[0] = T[1] * (pg[1] * qg[1]);
    C = T[0] * (pg[0] * qg[0]);
    f32x2 w2[2][4];
#pragma unroll
    for (int gp = 0; gp < 2; ++gp) {
        const f32x2 base = hh ? (f32x2){T[2 * gp], T[2 * gp + 1]} : (f32x2){T[2 * gp] * qg[2 * gp], T[2 * gp + 1] * qg[2 * gp + 1]};
        const f32x2 b0 = base * (f32x2){pg[2 * gp], pg[2 * gp + 1]};
        const f32x2 b1 = b0 * d2[gp][0], b2 = b1 * d2[gp][1], b3 = b2 * d2[gp][2];
        w2[gp][0] = e2[gp][0] * b0; w2[gp][1] = e2[gp][1] * b1; w2[gp][2] = e2[gp][2] * b2; w2[gp][3] = e2[gp][3] * b3;
    }
    p0.x = pk2(w2[0][0].x, w2[0][1].x); p0.y = pk2(w2[0][2].x, w2[0][3].x); p0.z = pk2(w2[0][0].y, w2[0][1].y); p0.w = pk2(w2[0][2].y, w2[0][3].y);
    p1.x = pk2(w2[1][0].x, w2[1][1].x); p1.y = pk2(w2[1][2].x, w2[1][3].x); p1.z = pk2(w2[1][0].y, w2[1][1].y); p1.w = pk2(w2[1][2].y, w2[1][3].y);
}

__device__ __forceinline__ void attn_item(CParams& P, LAS unsigned char* lds, int item, int tid) {
    const int lane = tid & 63, w = tid >> 6, l32 = lane & 31, hh = lane >> 5;
    int bh, qb;
    if (item < 1920) { bh = item / 15; qb = 1 + (item - bh * 15); } else if (item < 2048) { bh = item - 1920; qb = 16; } else { bh = item - 2048; qb = 0; }
    const int b = bh >> 4, h = bh & 15;
    const bf16_t* q = (const bf16_t*)(P.ws + WS_R0); const bf16_t* k = (const bf16_t*)(P.ws + WS_R0 + UNIT); const bf16_t* v = (const bf16_t*)(P.ws + WS_R1);
    bf16_t* ao = (bf16_t*)(P.ws + WS_R2);
    const size_t Rb = (size_t)b * PP;
    const int qrow0 = 256 * qb + 32 * w;
    const bool wvalid = qrow0 < PP;
    bf16x8 qf[4];
#pragma unroll
    for (int s = 0; s < 4; ++s) {
        if (wvalid) qf[s] = *(const bf16x8*)(q + (Rb + qrow0 + l32) * 1024 + h * 64 + 16 * s + 8 * hh);
        else qf[s] = (bf16x8){0, 0, 0, 0, 0, 0, 0, 0};
    }
    f32x16 O[2];
#pragma unroll
    for (int dt = 0; dt < 2; ++dt)
#pragma unroll
        for (int r = 0; r < 16; ++r) O[dt][r] = 0.f;
    float C = 1.0f; bool done = !wvalid;
    int T = 4 * qb + 3; if (T > 65) T = 65;
    const bool vrole = tid < 256;
    const int jp = tid & 31, dg = (tid >> 5) & 7;
    const int ku = tid & 255;
    u32x4 ra, rb;
    {
        const size_t kb = Rb + 64 * T;
        if (vrole) { ra = *(const u32x4*)(v + (kb + 2 * jp) * 1024 + h * 64 + dg * 8); rb = *(const u32x4*)(v + (kb + 2 * jp + 1) * 1024 + h * 64 + dg * 8); }
        else { ra = *(const u32x4*)(k + (kb + (ku >> 3)) * 1024 + h * 64 + (ku & 7) * 8); rb = *(const u32x4*)(k + (kb + 32 + (ku >> 3)) * 1024 + h * 64 + (ku & 7) * 8); }
    }
    volatile LAS unsigned* flags = (volatile LAS unsigned*)(lds + AT_FLAG);
#pragma unroll 1
    for (; T >= 1; --T) {
        __syncthreads();
        if (vrole) {
            if (T == 1) {
                if (jp < 24) { ra = (u32x4){0u, 0u, 0u, 0u}; rb = ra; }
                else {
                    const float* vr = (const float*)(P.ws + WS_VRAW) + (size_t)(2 * jp - 48) * 1024 + h * 64 + dg * 8;
                    const f32x4 a0 = *(const f32x4*)vr, a1 = *(const f32x4*)(vr + 4), b0 = *(const f32x4*)(vr + 1024), b1 = *(const f32x4*)(vr + 1028);
                    ra.x = pk2(a0.x, a0.y); ra.y = pk2(a0.z, a0.w); ra.z = pk2(a1.x, a1.y); ra.w = pk2(a1.z, a1.w);
                    rb.x = pk2(b0.x, b0.y); rb.y = pk2(b0.z, b0.w); rb.z = pk2(b1.x, b1.y); rb.w = pk2(b1.z, b1.w);
                }
            }
            LAS unsigned* d = (LAS unsigned*)(lds + AT_VT + (dg * 8) * 144 + jp * 4);
            d[0 * 36] = (ra.x & 0xffffu) | (rb.x << 16); d[1 * 36] = (ra.x >> 16) | (rb.x & 0xffff0000u);
            d[2 * 36] = (ra.y & 0xffffu) | (rb.y << 16); d[3 * 36] = (ra.y >> 16) | (rb.y & 0xffff0000u);
            d[4 * 36] = (ra.z & 0xffffu) | (rb.z << 16); d[5 * 36] = (ra.z >> 16) | (rb.z & 0xffff0000u);
            d[6 * 36] = (ra.w & 0xffffu) | (rb.w << 16); d[7 * 36] = (ra.w >> 16) | (rb.w & 0xffff0000u);
        } else {
            if (T == 1 && (ku >> 3) >= 16) {
                const int r = (ku >> 3) - 16;
                const f32x4 s4 = *(const f32x4*)((const float*)(P.ws + WS_KSS) + r * 64 + 4 * h);
                const float n = rsqrtf(((s4.x + s4.y) + (s4.z + s4.w)) * (1.0f / 64.0f) + 1e-6f);
                const float* kr = (const float*)(P.ws + WS_KRAW) + (size_t)r * 1024 + h * 64 + (ku & 7) * 8;
                const f32x4 a0 = *(const f32x4*)kr * n * *(const f32x4*)(P.odd_kn_g + (ku & 7) * 8), a1 = *(const f32x4*)(kr + 4) * n * *(const f32x4*)(P.odd_kn_g + (ku & 7) * 8 + 4);
                rb.x = pk2(a0.x, a0.y); rb.y = pk2(a0.z, a0.w); rb.z = pk2(a1.x, a1.y); rb.w = pk2(a1.z, a1.w);
            }
            *(LAS u32x4*)(lds + AT_KS + (ku >> 3) * 144 + (ku & 7) * 16) = ra;
            *(LAS u32x4*)(lds + AT_KS + (32 + (ku >> 3)) * 144 + (ku & 7) * 16) = rb;
        }
        if (lane == 0) flags[w] = done ? 1u : 0u;
        __syncthreads();
        const u32x4 f0 = *(const LAS u32x4*)(lds + AT_FLAG), f1 = *(const LAS u32x4*)(lds + AT_FLAG + 16);
        const unsigned alld = (f0.x & f0.y) & (f0.z & f0.w) & (f1.x & f1.y) & (f1.z & f1.w);
        if (alld) break;
        if (T > 1) {
            const size_t kb = Rb + 64 * (T - 1);
            if (vrole) { ra = *(const u32x4*)(v + (kb + 2 * jp) * 1024 + h * 64 + dg * 8); rb = *(const u32x4*)(v + (kb + 2 * jp + 1) * 1024 + h * 64 + dg * 8); }
            else { ra = *(const u32x4*)(k + (kb + (ku >> 3)) * 1024 + h * 64 + (ku & 7) * 8); rb = *(const u32x4*)(k + (kb + 32 + (ku >> 3)) * 1024 + h * 64 + (ku & 7) * 8); }
        }
        if (!done && 64 * T <= qrow0 + 30) {
            const bool needmask = (64 * T + 63 >= qrow0) || (T == 1);
#pragma unroll
            for (int st = 1; st >= 0; --st) {
                if (64 * T + 32 * st >= qrow0 + 31) continue;
                f32x16 x;
#pragma unroll
                for (int r = 0; r < 16; ++r) x[r] = 0.f;
#pragma unroll
                for (int s = 0; s < 4; ++s) {
                    const bf16x8 a = *(const LAS bf16x8*)(lds + AT_KS + (32 * st + l32) * 144 + (16 * s + 8 * hh) * 2);
                    x = MFMA32(a, qf[s], x);
                }
                u32x4 p0, p1;
                if (needmask) sb_subtile<true>(x, C, hh, 64 * T + 32 * st, qrow0 + l32, p0, p1);
                else sb_subtile<false>(x, C, hh, 0, 0, p0, p1);
                const bf16x8 pb0 = __builtin_bit_cast(bf16x8, p0), pb1 = __builtin_bit_cast(bf16x8, p1);
#pragma unroll
                for (int dt = 0; dt < 2; ++dt) {
                    const LAS unsigned char* vp = lds + AT_VT + (32 * dt + l32) * 144 + (32 * st + 4 * hh) * 2;
                    const s16x4 lo0 = *(const LAS s16x4*)(vp), hi0 = *(const LAS s16x4*)(vp + 16), lo1 = *(const LAS s16x4*)(vp + 32), hi1 = *(const LAS s16x4*)(vp + 48);
                    O[dt] = MFMA32(__builtin_shufflevector(lo0, hi0, 0, 1, 2, 3, 4, 5, 6, 7), pb0, O[dt]);
                    O[dt] = MFMA32(__builtin_shufflevector(lo1, hi1, 0, 1, 2, 3, 4, 5, 6, 7), pb1, O[dt]);
                }
            }
            done = (__ballot(C >= 1e-37f) == 0ull);
        }
    }
    LAS unsigned char* ost = lds + AT_OST + w * 4352;
#pragma unroll
    for (int dt = 0; dt < 2; ++dt)
#pragma unroll
        for (int g = 0; g < 4; ++g) {
            u32x2 o; o.x = pk2(O[dt][4 * g], O[dt][4 * g + 1]); o.y = pk2(O[dt][4 * g + 2], O[dt][4 * g + 3]);
            *(LAS u32x2*)(ost + l32 * 136 + (32 * dt + 8 * g + 4 * hh) * 2) = o;
        }
    LDS_WAIT();
    if (wvalid) {
#pragma unroll
        for (int it = 0; it < 8; ++it) {
            const int row = 4 * it + (lane >> 4), part = lane & 15;
            const u32x2 val = *(const LAS u32x2*)(ost + row * 136 + part * 8);
            *(u32x2*)(ao + (Rb + qrow0 + row) * 1024 + h * 64 + part * 4) = val;
        }
    }
    LDS_WAIT();
}

constexpr size_t WS_BAR = WS_HM2P + (size_t)16 * 1024 * 4;
#define XB_TMO      128
#define XB_XCNT(j)  (256  + 64 * (j))
#define XB_XSUB(j)  (1280 + 64 * (j))
#define XB_XGEN(j)  (2304 + 64 * (j))
#define XB_TOP      3328
#define XB_TOPGEN   3392
#define XCD_BAR_WORDS 3456
#define XB_SPIN_CAP (1u << 18)

__device__ __forceinline__ unsigned xb_ld(unsigned* p)              { return __hip_atomic_load(p, __ATOMIC_RELAXED, __HIP_MEMORY_SCOPE_AGENT); }
__device__ __forceinline__ unsigned xb_add(unsigned* p, unsigned v) { return __hip_atomic_fetch_add(p, v, __ATOMIC_RELAXED, __HIP_MEMORY_SCOPE_AGENT); }
__device__ __forceinline__ unsigned xb_xcc_id() { return (unsigned)__builtin_amdgcn_s_getreg((3 << 11) | 20) & 0xFu; }
#define XB_SPIN(cond, bar) do { unsigned _sp = 0; while (cond) { __builtin_amdgcn_s_sleep(1); \
    if ((++_sp & 255u) == 0u) { if (xb_ld(&(bar)[XB_TMO])) break; if (_sp > XB_SPIN_CAP) { atomicAdd(&(bar)[XB_TMO], 1u); break; } } } } while (0)

struct XcdBarrier {
    unsigned* bar; unsigned x;
    volatile LAS unsigned* st;
};

__device__ __forceinline__ XcdBarrier xcd_barrier_post(unsigned* bar, volatile LAS unsigned* st) {
    XcdBarrier b; b.bar = bar; b.x = xb_xcc_id(); b.st = st;
    if (threadIdx.x == 0) (void)xb_add(&bar[XB_XCNT(b.x)], 1u);
    return b;
}
__device__ __forceinline__ void xcd_barrier_complete(unsigned* bar, unsigned x, unsigned& nloc, unsigned& nx) {
    const unsigned G = gridDim.x * gridDim.y * gridDim.z;
    unsigned sum, cnt, mine, sp = 0u;
    for (;;) {
        sum = 0u; cnt = 0u; mine = 0u;
#pragma unroll
        for (unsigned j = 0; j < 16; ++j) { const unsigned c = xb_ld(&bar[XB_XCNT(j)]); sum += c; cnt += (c > 0u) ? 1u : 0u; mine = (j == x) ? c : mine; }
        if (sum == G) break;
        __builtin_amdgcn_s_sleep(1);
        if ((++sp & 255u) == 0u) { if (xb_ld(&bar[XB_TMO])) break; if (sp > XB_SPIN_CAP) { atomicAdd(&bar[XB_TMO], 1u); break; } }
    }
    nloc = mine > 0u ? mine : 1u; nx = cnt > 0u ? cnt : 1u;
}

__device__ __forceinline__ void xcd_barrier(const XcdBarrier& b) {
    asm volatile("s_waitcnt vmcnt(0)" ::: "memory");
    __syncthreads();
    if (threadIdx.x == 0) {
        unsigned* bar = b.bar;
        __builtin_amdgcn_s_waitcnt(0);
        unsigned nloc = b.st[0], nx = b.st[1];
        if (nloc == 0u) { xcd_barrier_complete(bar, b.x, nloc, nx); b.st[0] = nloc; b.st[1] = nx; }
        const unsigned old = xb_add(&bar[XB_XSUB(b.x)], 1u);
        const unsigned gen = old / nloc;
        if (old + 1u == (gen + 1u) * nloc) {
            __builtin_amdgcn_fence(__ATOMIC_RELEASE, "agent");
            asm volatile("s_waitcnt vmcnt(0)" ::: "memory");
            const unsigned og = xb_add(&bar[XB_TOP], 1u);
            const unsigned tg = og / nx;
            if (og + 1u == (tg + 1u) * nx) xb_add(&bar[XB_TOPGEN], 1u);
            else XB_SPIN(xb_ld(&bar[XB_TOPGEN]) == tg, bar);
            __builtin_amdgcn_fence(__ATOMIC_ACQUIRE, "agent");
            xb_add(&bar[XB_XGEN(b.x)], 1u);
            asm volatile("s_waitcnt vmcnt(0)" ::: "memory");
        } else {
            XB_SPIN(xb_ld(&bar[XB_XGEN(b.x)]) == gen, bar);
            __builtin_amdgcn_fence(__ATOMIC_ACQUIRE, "agent");
            asm volatile("s_waitcnt vmcnt(0)" ::: "memory");
        }
    }
    __syncthreads();
}

#define GEMM_PHASE(EPI, Aptr, Bptr, N_, K_, E_) do { pg8::Gemm g_{(const pg8::bf16_t*)(Aptr), (const pg8::bf16_t*)(Bptr), NB * SEQ, (N_), (K_)}; pg8::StaticOrder S_; S_.init(NB * SEQ, (N_), (int)gridDim.x, (int)blockIdx.x); \
    pg8::gemm_phase<EPI, pg8::StaticOrder, true, true>(lds, g_, S_, E_); } while (0)
#define META_TASKS(FN, NT) do { RETID(); for (int t_ = blockIdx.x; t_ < (NT); t_ += gridDim.x) FN(KP, lds, t_, tid); asm volatile("s_waitcnt vmcnt(0)" ::: "memory"); __syncthreads(); } while (0)

__global__ void __launch_bounds__(NTHR) mega_fwd(Params Punused) {
    extern __shared__ __attribute__((aligned(16))) unsigned char lds_raw[];
    LAS unsigned char* lds = (LAS unsigned char*)lds_raw;
    cg::grid_group grid = cg::this_grid();
    int tid = threadIdx.x;
#define RETID() do { tid = threadIdx.x; asm volatile("" : "+v"(tid)); } while (0)
#define ws (KP.ws)
#define ss1 ((float*)(ws + WS_SS) + (size_t)RP * 16)
#define ss2 ((float*)(ws + WS_SS) + (size_t)RP * 32)
#define ss3 ((float*)(ws + WS_SS) + (size_t)RP * 48)
    volatile LAS unsigned* bst = (volatile LAS unsigned*)(lds + 139264);
    if (tid < 2) bst[tid] = 0u;
#define GBAR() xcd_barrier(xbar)
    RETID();
    if (blockIdx.x == 0) for (int i = tid; i < XCD_BAR_WORDS; i += NTHR) ((volatile unsigned*)(ws + WS_BAR))[i] = 0u;
    phase0(KP, lds, tid);
    grid.sync();
    const XcdBarrier xbar = xcd_barrier_post((unsigned*)(ws + WS_BAR), bst);
    META_TASKS(meta_in, 320);
    { EpiIn E{(const float*)(ws + WS_SS), (bf16_t*)(ws + WS_R4), (bf16_t*)(ws + WS_R1), (bf16_t*)(ws + WS_R2), (bf16_t*)(ws + WS_R3)};
      GEMM_PHASE(EpiIn, ws + WS_R0, ws + WS_WIN, 5120, 1024, E); }
    GBAR();
    RETID();
    for (int it = blockIdx.x; it < 996 + 1025 + 4; it += gridDim.x) {
        if (it < 996) ret_partial_item(KP, lds, it, tid);
        else if (it == 996) conv_item<16>(KP, lds, 0, PADF, tid);
        else if (it < 996 + 1025) { const int ci = it - 997; conv_item<32>(KP, lds, ci >> 7, 128 + 32 * (ci & 127), tid); }
        else ret_out_item(KP, lds, it - (996 + 1025), tid);
    }
    GBAR();
    RETID();
    ret_scan(KP, tid);
    GBAR();
    RETID();
    for (int it = blockIdx.x; it < NB * 32 * 4; it += gridDim.x) ret_out_item(KP, lds, (it >> 7) * 132 + 4 + (it & 127), tid);
    GBAR();
    META_TASKS(meta_out, 256);
    { EpiRes E{KP.x, KP.out, (bf16_t*)(ws + WS_R4), ss1, 1};
      GEMM_PHASE(EpiRes, ws + WS_R0, ws + WS_WOUT, 1024, 2048, E); }
    GBAR();
    META_TASKS(meta_up, 256);
    { EpiUp E{ss1, (bf16_t*)(ws + WS_R0), (LAS float*)(lds + RS_TAB_OFF)}; GEMM_PHASE(EpiUp, ws + WS_R4, ws + WS_W1, 4096, 1024, E); }
    GBAR();
    META_TASKS(meta_down, 256);
    { EpiRes E{KP.out, KP.out, (bf16_t*)(ws + WS_R4), ss2, 1};
      GEMM_PHASE(EpiRes, ws + WS_R0, ws + WS_W2, 1024, 4096, E); }
    GBAR();
    META_TASKS(meta_kv, 128);
    { EpiQkv E{ss2, KP.odd_qn_g, KP.odd_kn_g, (bf16_t*)(ws + WS_R0), (LAS float*)(lds + RS_TAB_OFF)};
      GEMM_PHASE(EpiQkv, ws + WS_R4, ws + WS_WQKV, 3072, 1024, E); }
    GBAR();
    RETID();
    for (int it = blockIdx.x; it < NB * 16 * 17; it += gridDim.x) attn_item(KP, lds, it, tid);
    GBAR();
    { EpiRes E{KP.out, KP.out, (bf16_t*)(ws + WS_R4), ss3, 1};
      GEMM_PHASE(EpiRes, ws + WS_R2, ws + WS_WO, 1024, 1024, E); }
    GBAR();
    { EpiUp E{ss3, (bf16_t*)(ws + WS_R0), (LAS float*)(lds + RS_TAB_OFF)}; GEMM_PHASE(EpiUp, ws + WS_R4, ws + WS_W1 + (size_t)4096 * 1024 * 2, 4096, 1024, E); }
    GBAR();
    { EpiRes E{KP.out, KP.out, nullptr, nullptr, 0};
      GEMM_PHASE(EpiRes, ws + WS_R0, ws + WS_W2 + (size_t)4096 * 1024 * 2, 1024, 4096, E); }
#undef ws
#undef ss1
#undef ss2
#undef ss3
}

extern "C" void kernel_launch(void* const* d_in, const int* in_sizes, int n_in, void* d_out, int out_size, void* d_ws, size_t ws_size, hipStream_t stream) {
    static int grid_blocks = 0;
    if (grid_blocks == 0) {
        if (n_in != 17 || ws_size < WS_END) { fprintf(stderr, "kernel_launch: unexpected inputs (n_in %d, ws %zu, need %zu)\n", n_in, ws_size, (size_t)WS_END); grid_blocks = -1; return; }
        int dev = 0, cus = 0, per_cu = 0;
        (void)hipGetDevice(&dev);
        (void)hipDeviceGetAttribute(&cus, hipDeviceAttributeMultiprocessorCount, dev);
        if (hipFuncSetAttribute((const void*)mega_fwd, hipFuncAttributeMaxDynamicSharedMemorySize, LDS_BYTES) != hipSuccess) fprintf(stderr, "kernel_launch: hipFuncSetAttribute failed\n");
        if (hipOccupancyMaxActiveBlocksPerMultiprocessor(&per_cu, (const void*)mega_fwd, NTHR, LDS_BYTES) != hipSuccess || per_cu < 1) { fprintf(stderr, "kernel_launch: occupancy query gave %d; using 1\n", per_cu); per_cu = 1; }
        (void)hipGetLastError();
        if (cus <= 0) cus = 256;
        grid_blocks = cus * per_cu;
    }
    if (grid_blocks < 0) return;
    Params p{};
    const float** pp = (const float**)&p;
    for (int i = 0; i < 17; ++i) pp[i] = (const float*)d_in[i];
    p.out = (float*)d_out; p.ws = (unsigned char*)d_ws;
    void* args[] = {&p};
    hipError_t e = hipLaunchCooperativeKernel((const void*)mega_fwd, dim3(grid_blocks), dim3(NTHR), args, LDS_BYTES, stream);
    if (e != hipSuccess) fprintf(stderr, "cooperative launch failed: %s (grid %d)\n", hipGetErrorString(e), grid_blocks);
}
```

```cpp
#include <hip/hip_runtime.h>
#include <hip/hip_cooperative_groups.h>
#include <cstdio>
#include <cstdint>
namespace cg = cooperative_groups;
__host__ __device__ __forceinline__ int rowbase(int pm) { return (pm >> 4) * 4224 + 128 + (pm & 15) * 256; }
namespace pg8 {
#define PG8_LAS __attribute__((address_space(3)))
typedef unsigned short bf16_t;
typedef short bf16x8 __attribute__((ext_vector_type(8)));
typedef float f32x4 __attribute__((ext_vector_type(4)));
typedef unsigned u32x4 __attribute__((ext_vector_type(4)));
constexpr int BM = 256, BK = 64, HALF = 128, HTB = HALF * BK * 2  , STAGE_BYTES = 8 * HTB, NXCD = 8, WGM = 8;

__host__ __device__ __forceinline__ int lds_byte(int r, int c) { const int st = (r >> 4) * 2 + (c >> 5), rr = r & 15, cc = c & 31, ob = rr * 64 + cc * 2; return st * 1024 + (ob ^ (((ob >> 9) & 1) << 5)); }
__host__ __device__ __forceinline__ void stage_rc(int b, int& R, int& C) { const int st = b / 1024, sb = b % 1024, swz = sb ^ (((sb >> 9) & 1) << 5); R = (st >> 1) * 16 + swz / 64; C = (st & 1) * 32 + (swz % 64) / 2; }
__host__ __device__ __forceinline__ int perm32(int rho) { const int n = rho >> 4, i = rho & 15; return 8 * (i >> 2) + 4 * n + (i & 3); }

struct Unit { int pm, pn; };
struct Gemm { const bf16_t* A; const bf16_t* Bt; int M, N, K; };

struct StaticOrder {
    int nM, nN, nwg, G, c;
    __host__ __device__ void init(int M, int N, int G_, int c_) { nM = M / BM; nN = N / BM; nwg = nM * nN; G = G_; c = c_; }
    __host__ __device__ bool next(int i, Unit& u) const {
        const long L = (long)i * G + c; if (L >= nwg) return false;
        int wgid = (int)L; { const int q = nwg / NXCD, r = nwg % NXCD, xcd = wgid % NXCD, off = wgid / NXCD; wgid = (xcd < r ? xcd * (q + 1) : r * (q + 1) + (xcd - r) * q) + off; }
        const int nig = WGM * nN, gid = wgid / nig, fm = gid * WGM, gsz = (nM - fm) < WGM ? (nM - fm) : WGM;
        u.pm = fm + ((wgid % nig) % gsz); u.pn = (wgid % nig) / gsz; return true;
    }
    __device__ __forceinline__ void a_ready(const Unit&) const {}
    __device__ __forceinline__ void done(const Unit&) const {}
};

template <class Epi, class Sched, bool ALIGN_EPI = false, bool SP2 = false>
__device__ __forceinline__ void gemm_phase(PG8_LAS unsigned char* lds, const Gemm g, const Sched& S, const Epi& E) {
    int tid_l = threadIdx.x; asm volatile("" : "+v"(tid_l));
    const int tid = tid_l, wid = __builtin_amdgcn_readfirstlane(tid >> 6), lane = tid & 63, wr = wid >> 2, wc = wid & 3, fr = lane & 15, fq = lane >> 4;
    const int K = g.K, nt = K / BK;
    unsigned voffA[2], voffB[2];
#pragma unroll
    for (int i = 0; i < 2; ++i) { int R, C; stage_rc(tid * 16 + i * 8192, R, C); const int Rb = Epi::PERM ? ((R & ~31) + perm32(R & 31)) : R;
        voffA[i] = (unsigned)(R * K + C) * 2u; voffB[i] = (unsigned)(Rb * K + C) * 2u; }
    const size_t kstep = (size_t)(BK * 2);
    const size_t hstep = (size_t)HALF * K * 2;
    const size_t tstep = 2 * hstep;
    const unsigned ldsw = (unsigned)wid * 1024u;
    const int aoff = lds_byte(wr * 64 + fr, fq * 8), boff = lds_byte(wc * 32 + fr, fq * 8);
#define PG8_SA(b, h) (((b) * 2 + (h)) * HTB)
#define PG8_SB(b, h) ((4 + (b) * 2 + (h)) * HTB)
#define PG8_STAGE(bufoff, gbase, voff) do { _Pragma("unroll") for (int _i = 0; _i < 2; ++_i) \
        __builtin_amdgcn_global_load_lds((const unsigned*)((const char*)(gbase) + (voff)[_i]), (PG8_LAS unsigned*)(lds + (bufoff) + ldsw + _i * 8192), 16, 0, 0); } while (0)
#define PG8_LDA(dst, b, h) do { _Pragma("unroll") for (int m = 0; m < 4; ++m) _Pragma("unroll") for (int k = 0; k < 2; ++k) dst[m][k] = *(const PG8_LAS bf16x8*)(lds + PG8_SA(b, h) + aoff + m * 2048 + k * 1024); } while (0)
#define PG8_LDB(dst, b, h) do { _Pragma("unroll") for (int n = 0; n < 2; ++n) _Pragma("unroll") for (int k = 0; k < 2; ++k) dst[n][k] = *(const PG8_LAS bf16x8*)(lds + PG8_SB(b, h) + boff + n * 2048 + k * 1024); } while (0)
#define PG8_MMA(ai, bj, At, Bt) do { __builtin_amdgcn_s_setprio(1); _Pragma("unroll") for (int m = 0; m < 4; ++m) _Pragma("unroll") for (int n = 0; n < 2; ++n) _Pragma("unroll") for (int k = 0; k < 2; ++k) \
        acc[ai][bj][m][n] = __builtin_amdgcn_mfma_f32_16x16x32_bf16(Bt[n][k], At[m][k], acc[ai][bj][m][n], 0, 0, 0); __builtin_amdgcn_s_setprio(0); } while (0)
#define PG8_WAIT_V(n) asm volatile("s_waitcnt vmcnt(" #n ")" ::: "memory")
#define PG8_WAIT_L(n) asm volatile("s_waitcnt lgkmcnt(" #n ")" ::: "memory")
#define PG8_BAR __builtin_amdgcn_s_barrier()
#define PG8_SCHED __builtin_amdgcn_sched_barrier(0)
    Unit cur, nxt; int ui = 0;
    if (!S.next(0, cur)) return;
    f32x4 acc[2][2][4][2];
#pragma unroll
    for (int a = 0; a < 2; ++a)
#pragma unroll
        for (int b = 0; b < 2; ++b)
#pragma unroll
            for (int m = 0; m < 4; ++m)
#pragma unroll
                for (int n = 0; n < 2; ++n) acc[a][b][m][n] = (f32x4){0.f, 0.f, 0.f, 0.f};
    bf16x8 At[4][2], B0[2][2], B1[2][2];
    const char* cA = (const char*)g.A + (size_t)rowbase(cur.pm) * (size_t)(K * 2); const char* cB = (const char*)g.Bt + (size_t)cur.pn * tstep;
    S.a_ready(cur);
    if constexpr (SP2) {
        PG8_STAGE(PG8_SB(0, 0), cB, voffB); PG8_STAGE(PG8_SB(0, 1), cB + hstep, voffB); PG8_STAGE(PG8_SA(0, 0), cA, voffA); PG8_STAGE(PG8_SA(0, 1), cA + hstep, voffA);
        if (wr == 1) PG8_BAR;
        PG8_WAIT_V(2); PG8_BAR;
        PG8_STAGE(PG8_SB(1, 0), cB + kstep, voffB); PG8_STAGE(PG8_SA(1, 0), cA + kstep, voffA); PG8_STAGE(PG8_SB(1, 1), cB + hstep + kstep, voffB);
        PG8_WAIT_V(6); PG8_BAR;
    } else {
        PG8_STAGE(PG8_SB(0, 0), cB, voffB); PG8_STAGE(PG8_SA(0, 0), cA, voffA); PG8_STAGE(PG8_SB(0, 1), cB + hstep, voffB); PG8_STAGE(PG8_SA(0, 1), cA + hstep, voffA);
        if (wr == 1) PG8_BAR;
        PG8_WAIT_V(4); PG8_BAR;
        PG8_STAGE(PG8_SB(1, 0), cB + kstep, voffB); PG8_STAGE(PG8_SA(1, 0), cA + kstep, voffA); PG8_STAGE(PG8_SB(1, 1), cB + hstep + kstep, voffB);
        PG8_WAIT_V(6); PG8_BAR;
    }
    for (;;) {
        const bool has_next = S.next(ui + 1, nxt);
        const char* nA = has_next ? (const char*)g.A + (size_t)rowbase(nxt.pm) * (size_t)(K * 2) : cA; const char* nB = has_next ? (const char*)g.Bt + (size_t)nxt.pn * tstep : cB;
        for (int t = 0; t < nt; t += 2) {
            const bool last = (t == nt - 2);
            const char* a1 = cA + (size_t)(t + 1) * kstep;
            const char* a2 = last ? nA : cA + (size_t)(t + 2) * kstep; const char* b2 = last ? nB : cB + (size_t)(t + 2) * kstep;
            const char* a3 = a2 + kstep; const char* b3 = b2 + kstep;
            if (last && has_next) S.a_ready(nxt);
            if constexpr (SP2) {
            PG8_LDB(B0, 0, 0); PG8_LDB(B1, 0, 1); PG8_SCHED; PG8_LDA(At, 0, 0); PG8_STAGE(PG8_SA(1, 1), a1 + hstep, voffA);
            PG8_WAIT_V(8); PG8_WAIT_L(0); PG8_BAR; PG8_MMA(0, 0, At, B0); PG8_MMA(0, 1, At, B1); PG8_BAR; PG8_SCHED;
            PG8_LDA(At, 0, 1); PG8_STAGE(PG8_SB(0, 0), b2, voffB); PG8_STAGE(PG8_SB(0, 1), b2 + hstep, voffB); PG8_STAGE(PG8_SA(0, 0), a2, voffA);
            PG8_WAIT_V(8); PG8_WAIT_L(0); PG8_BAR; PG8_MMA(1, 0, At, B0); PG8_MMA(1, 1, At, B1); PG8_BAR; PG8_SCHED;
            PG8_LDB(B0, 1, 0); PG8_LDB(B1, 1, 1); PG8_SCHED; PG8_LDA(At, 1, 0); PG8_STAGE(PG8_SA(0, 1), a2 + hstep, voffA);
            PG8_WAIT_V(8); PG8_WAIT_L(0); PG8_BAR; PG8_MMA(0, 0, At, B0); PG8_MMA(0, 1, At, B1); PG8_BAR; PG8_SCHED;
            PG8_LDA(At, 1, 1); PG8_STAGE(PG8_SB(1, 0), b3, voffB); PG8_STAGE(PG8_SB(1, 1), b3 + hstep, voffB); PG8_STAGE(PG8_SA(1, 0), a3, voffA);
            PG8_WAIT_V(8); PG8_WAIT_L(0); PG8_BAR; PG8_MMA(1, 0, At, B0); PG8_MMA(1, 1, At, B1); PG8_BAR; PG8_SCHED;
            } else {
            PG8_LDB(B0, 0, 0); PG8_SCHED; PG8_LDA(At, 0, 0); PG8_STAGE(PG8_SA(1, 1), a1 + hstep, voffA);
            PG8_WAIT_L(8); PG8_BAR; PG8_WAIT_L(0); PG8_MMA(0, 0, At, B0); PG8_BAR; PG8_SCHED;
            PG8_LDB(B1, 0, 1); PG8_STAGE(PG8_SB(0, 0), b2, voffB);
            PG8_BAR; PG8_WAIT_L(0); PG8_MMA(0, 1, At, B1); PG8_BAR;
            PG8_LDA(At, 0, 1); PG8_STAGE(PG8_SA(0, 0), a2, voffA);
            PG8_BAR; PG8_WAIT_L(0); PG8_MMA(1, 0, At, B0); PG8_BAR; PG8_SCHED;
            PG8_STAGE(PG8_SB(0, 1), b2 + hstep, voffB);
            PG8_WAIT_V(6); PG8_BAR; PG8_MMA(1, 1, At, B1); PG8_BAR;
            PG8_LDB(B0, 1, 0); PG8_SCHED; PG8_LDA(At, 1, 0); PG8_STAGE(PG8_SA(0, 1), a2 + hstep, voffA);
            PG8_WAIT_L(8); PG8_BAR; PG8_WAIT_L(0); PG8_MMA(0, 0, At, B0); PG8_BAR; PG8_SCHED;
            PG8_LDB(B1, 1, 1); PG8_STAGE(PG8_SB(1, 0), b3, voffB);
            PG8_BAR; PG8_WAIT_L(0); PG8_MMA(0, 1, At, B1); PG8_BAR;
            PG8_LDA(At, 1, 1); PG8_STAGE(PG8_SA(1, 0), a3, voffA);
            PG8_BAR; PG8_WAIT_L(0); PG8_MMA(1, 0, At, B0); PG8_BAR; PG8_SCHED;
            PG8_STAGE(PG8_SB(1, 1), b3 + hstep, voffB);
            PG8_WAIT_V(6); PG8_BAR; PG8_MMA(1, 1, At, B1); PG8_BAR;
            }
        }
        if constexpr (ALIGN_EPI) { if (wr == 0) PG8_BAR; }
        if constexpr (!Epi::AFTER_DRAIN) { E(acc, cur, wr, wc, fr, fq); S.done(cur); }
        if (!has_next) break;
#pragma unroll
        for (int a = 0; a < 2; ++a)
#pragma unroll
            for (int b = 0; b < 2; ++b)
#pragma unroll
                for (int m = 0; m < 4; ++m)
#pragma unroll
                    for (int n = 0; n < 2; ++n) acc[a][b][m][n] = (f32x4){0.f, 0.f, 0.f, 0.f};
        cur = nxt; cA = nA; cB = nB; ++ui;
        if constexpr (ALIGN_EPI) { if (wr == 1) PG8_BAR; }
    }
    PG8_WAIT_V(0);
    if constexpr (!ALIGN_EPI) { if (wr == 0) PG8_BAR; }
    PG8_BAR;
    if constexpr (Epi::AFTER_DRAIN) { E.fused(acc, cur, wr, wc, fr, fq, lds, wid, lane); S.done(cur); }
#undef PG8_SA
#undef PG8_SB
#undef PG8_STAGE
#undef PG8_LDA
#undef PG8_LDB
#undef PG8_MMA
#undef PG8_WAIT_V
#undef PG8_WAIT_L
#undef PG8_BAR
#undef PG8_SCHED
}
}

#define LAS __attribute__((address_space(3)))
typedef unsigned short bf16_t;
typedef short bf16x8 __attribute__((ext_vector_type(8)));
typedef short s16x4 __attribute__((ext_vector_type(4)));
typedef float f32x2 __attribute__((ext_vector_type(2)));
typedef float f32x4 __attribute__((ext_vector_type(4)));
typedef float f32x16 __attribute__((ext_vector_type(16)));
typedef unsigned u32x2 __attribute__((ext_vector_type(2)));
typedef unsigned u32x4 __attribute__((ext_vector_type(4)));
typedef __bf16 bf16x2v __attribute__((ext_vector_type(2)));

constexpr int DM = 1024, NB = 8, SEQ = 4096, NMETA = 16, PADF = 112, PP = 4224, RP = NB * PP, DFF = 4096;
constexpr int NTHR = 512;
constexpr int LDS_BYTES = 147456;
constexpr size_t UNIT = (size_t)RP * 1024 * 2;
constexpr size_t WS_R0 = 0, WS_R1 = 2 * UNIT, WS_R2 = 3 * UNIT, WS_R3 = 4 * UNIT, WS_R4 = 5 * UNIT;
constexpr size_t WS_WIN = 6 * UNIT;
constexpr size_t WS_WOUT = WS_WIN + (size_t)5120 * 1024 * 2;
constexpr size_t WS_W1 = WS_WOUT + (size_t)1024 * 2048 * 2;
constexpr size_t WS_W2 = WS_W1 + 2 * (size_t)4096 * 1024 * 2;
constexpr size_t WS_WQKV = WS_W2 + 2 * (size_t)4096 * 1024 * 2;
constexpr size_t WS_WO = WS_WQKV + (size_t)3072 * 1024 * 2;
constexpr size_t WS_ROPE = WS_WO + (size_t)1024 * 1024 * 2;
constexpr size_t WS_SS = WS_ROPE + (size_t)PP * 64 * 8;
constexpr size_t SS_BYTES = (size_t)RP * 16 * 4;
constexpr size_t WS_METAH = WS_SS + 4 * SS_BYTES;
constexpr size_t WS_HM1 = WS_METAH;
constexpr size_t WS_HIDM = WS_HM1 + (size_t)16 * 1024 * 4;
constexpr size_t WS_HM2P = WS_HIDM + (size_t)16 * 4096 * 4;
constexpr size_t WS_END = WS_HM2P + (size_t)4 * 16 * 1024 * 4 + 16384;

__device__ __forceinline__ unsigned pk2(float a, float b) { f32x2 v = {a, b}; bf16x2v r = __builtin_convertvector(v, bf16x2v); return __builtin_bit_cast(unsigned, r); }
__device__ __forceinline__ float bf_lo(unsigned u) { return __uint_as_float(u << 16); }
__device__ __forceinline__ float bf_hi(unsigned u) { return __uint_as_float(u & 0xffff0000u); }
__device__ __forceinline__ float wave_sum(float v) {
#pragma unroll
    for (int o = 1; o < 64; o <<= 1) v += __shfl_xor(v, o);
    return v;
}
__device__ __forceinline__ float rs_of(const float* ssp, int row) {
    const f32x4* s = (const f32x4*)(ssp + (size_t)row * 16);
    const f32x4 a = (s[0] + s[1]) + (s[2] + s[3]);
    return rsqrtf(((a.x + a.y) + (a.z + a.w)) * (1.0f / 1024.0f) + 1e-6f);
}
__device__ __forceinline__ float lg2gamma(int h) { return h == 0 ? -0.04580368961312479f : h == 1 ? -0.02272007650008353f : h == 2 ? -0.011315313227834146f : -0.005646563141142063f; }
__device__ __forceinline__ float fexp2(float x) { return __builtin_amdgcn_exp2f(x); }
__device__ __forceinline__ float frcp(float x) { return __builtin_amdgcn_rcpf(x); }
__device__ __forceinline__ float sigmoidf_(float x) { return frcp(1.0f + fexp2(-1.4426950408889634f * x)); }
__device__ __forceinline__ int crow(int r, int h) { return (r & 3) + 8 * (r >> 2) + 4 * h; }
#define MFMA32(a, b, c) __builtin_amdgcn_mfma_f32_32x32x16_bf16((a), (b), (c), 0, 0, 0)
#define LDS_WAIT() asm volatile("s_waitcnt lgkmcnt(0)" ::: "memory")

__device__ __forceinline__ int l2p_in(int c) {
    if (c < 1024) { const int blk = c >> 9, cc = c & 511, head = cc >> 7, dd = cc & 127, n = dd >> 6, rem = dd & 63, wc = rem >> 4, fq = (rem >> 2) & 3, i = rem & 3;
        return blk * 512 + (head >> 1) * 256 + (head & 1) * 128 + wc * 32 + fq * 8 + n * 4 + i; }
    if (c < 3072) return c;
    const int cu = c - 3072, n = cu >> 10, ch = cu & 1023, pu = ch >> 7, r = ch & 127, bj = r >> 6, r2 = r & 63, wc = r2 >> 4, fq = (r2 >> 2) & 3, i = r2 & 3;
    return 3072 + pu * 256 + bj * 128 + wc * 32 + fq * 8 + n * 4 + i;
}
__device__ __forceinline__ int l2p_qkv(int c) {
    const int blk = c >> 10, cc = c & 1023, head = cc >> 6, d = cc & 63, pnp = head >> 2, wc = head & 3, bj = d >> 5, fq = (d >> 3) & 3, n = (d >> 2) & 1, i = d & 3;
    return blk * 1024 + pnp * 256 + bj * 128 + wc * 32 + fq * 8 + n * 4 + i;
}

typedef f32x4 AccT[2][2][4][2];

constexpr int RS_TAB_OFF = 140288;
__device__ __forceinline__ void build_rs_tab(const float* ssp, LAS float* tab, int rb, int wr, int wc, int fr, int fq) {
    const int t = (wr * 4 + wc) * 64 + fq * 16 + fr, row = t >> 1, half = t & 1;
    const f32x4* sp = (const f32x4*)(ssp + (size_t)(rb + row) * 16 + half * 8);
    const f32x4 a = sp[0] + sp[1];
    float sum = (a.x + a.y) + (a.z + a.w);
    sum += __shfl_xor(sum, 1);
    if (!half) tab[row] = rsqrtf(sum * (1.0f / 1024.0f) + 1e-6f);
    asm volatile("s_waitcnt lgkmcnt(0)" ::: "memory"); __builtin_amdgcn_s_barrier(); asm volatile("" ::: "memory");
}

struct EpiIn {
    static constexpr bool PERM = true, AFTER_DRAIN = false;
    const float* rsv; bf16_t *qk, *v, *gs, *hdn;
    __device__ __forceinline__ void operator()(const AccT& acc, const pg8::Unit& u, int wr, int wc, int fr, int fq) const {
        const int pn = u.pn, rb = rowbase(u.pm), pb = 128 + (u.pm & 15) * 256;
        float rsr[2][4];
#pragma unroll
        for (int ai = 0; ai < 2; ++ai)
#pragma unroll
            for (int m = 0; m < 4; ++m) rsr[ai][m] = rsv[rb + ai * 128 + wr * 64 + m * 16 + fr];
        float invf[4];
#pragma unroll
        for (int i = 0; i < 4; ++i) invf[i] = exp2f(-(float)(16 * wc + 4 * fq + i) * 0.20762050593046014f);
#pragma unroll
        for (int ai = 0; ai < 2; ++ai)
#pragma unroll
            for (int m = 0; m < 4; ++m) {
                const int loc = ai * 128 + wr * 64 + m * 16 + fr;
                const int row = rb + loc, p = pb + loc;
                const float rs = rsr[ai][m];
                if (pn < 4) {
                    float cs[4], sn[4];
#pragma unroll
                    for (int i = 0; i < 4; ++i) {
                        const float ang = (float)p * invf[i];
                        const float nrev = rintf(ang * 0.15915493667125702f);
                        float r = fmaf(ang, 0.15915493667125702f, -nrev); r = fmaf(ang, 6.4206382432985265e-09f, r);
                        cs[i] = __builtin_amdgcn_cosf(r); sn[i] = __builtin_amdgcn_sinf(r);
                    }
                    const float ip1 = (float)((p & 127) + 1);
#pragma unroll
                    for (int bj = 0; bj < 2; ++bj) {
                        const int head = 2 * (pn & 1) + bj;
                        const float lg = lg2gamma(head);
                        const float fac = (pn < 2) ? fexp2(ip1 * lg) : fexp2(-ip1 * lg) * 0.08838834764831845f;
                        const f32x4 x1 = acc[ai][bj][m][0] * rs, x2 = acc[ai][bj][m][1] * rs;
                        float y1[4], y2[4];
#pragma unroll
                        for (int i = 0; i < 4; ++i) { y1[i] = (x1[i] * cs[i] - x2[i] * sn[i]) * fac; y2[i] = (x1[i] * sn[i] + x2[i] * cs[i]) * fac; }
                        u32x4 w; w.x = pk2(y1[0], y1[1]); w.y = pk2(y1[2], y1[3]); w.z = pk2(y2[0], y2[1]); w.w = pk2(y2[2], y2[3]);
                        *(u32x4*)(qk + (size_t)row * 1024 + 256 * pn + 128 * bj + 32 * wc + 8 * fq) = w;
                    }
                } else if (pn < 8) {
#pragma unroll
                    for (int bj = 0; bj < 2; ++bj) {
                        const f32x4 a = acc[ai][bj][m][0] * rs, b = acc[ai][bj][m][1] * rs;
                        u32x4 w; w.x = pk2(a[0], a[1]); w.y = pk2(a[2], a[3]); w.z = pk2(b[0], b[1]); w.w = pk2(b[2], b[3]);
                        *(u32x4*)(v + (size_t)row * 1024 + 256 * (pn - 4) + 128 * bj + 32 * wc + 8 * fq) = w;
                    }
                } else if (pn < 12) {
#pragma unroll
                    for (int bj = 0; bj < 2; ++bj) {
                        f32x4 a = acc[ai][bj][m][0] * rs, b = acc[ai][bj][m][1] * rs;
#pragma unroll
                        for (int i = 0; i < 4; ++i) { a[i] = a[i] * sigmoidf_(a[i]); b[i] = b[i] * sigmoidf_(b[i]); }
                        u32x4 w; w.x = pk2(a[0], a[1]); w.y = pk2(a[2], a[3]); w.z = pk2(b[0], b[1]); w.w = pk2(b[2], b[3]);
                        *(u32x4*)(gs + (size_t)row * 1024 + 256 * (pn - 8) + 128 * bj + 32 * wc + 8 * fq) = w;
                    }
                } else {
#pragma unroll
                    for (int bj = 0; bj < 2; ++bj) {
                        const f32x4 a = acc[ai][bj][m][0] * rs, g = acc[ai][bj][m][1] * rs;
                        float o[4];
#pragma unroll
                        for (int i = 0; i < 4; ++i) o[i] = a[i] * sigmoidf_(g[i]);
                        u32x2 w; w.x = pk2(o[0], o[1]); w.y = pk2(o[2], o[3]);
                        *(u32x2*)(hdn + (size_t)row * 1024 + 128 * (pn - 12) + 64 * bj + 16 * wc + 4 * fq) = w;
                    }
                }
            }
    }
};

struct EpiRes {
    static constexpr bool PERM = true, AFTER_DRAIN = false;
    const float* bx; float* ox; bf16_t* hb; float* ssp; int write_aux;
    __device__ __forceinline__ void operator()(const AccT& acc, const pg8::Unit& u, int wr, int wc, int fr, int fq) const {
        const int col0 = u.pn * 256 + wc * 32 + 8 * fq, rb = rowbase(u.pm);
#pragma unroll
        for (int ai = 0; ai < 2; ++ai) {
            f32x4 base[4][2][2];
#pragma unroll
            for (int m = 0; m < 4; ++m) { const size_t off = (size_t)(u.pm * 256 + ai * 128 + wr * 64 + m * 16 + fr) * DM;
#pragma unroll
                for (int bj = 0; bj < 2; ++bj) { base[m][bj][0] = *(const f32x4*)(bx + off + col0 + 128 * bj); base[m][bj][1] = *(const f32x4*)(bx + off + col0 + 128 * bj + 4); } }
#pragma unroll
            for (int m = 0; m < 4; ++m) {
                const int loc = ai * 128 + wr * 64 + m * 16 + fr;
                const int row = rb + loc;
                const size_t off = (size_t)(u.pm * 256 + loc) * DM;
                float ss = 0.f;
#pragma unroll
                for (int bj = 0; bj < 2; ++bj) {
                    const f32x4 h0 = base[m][bj][0] + acc[ai][bj][m][0];
                    const f32x4 h1 = base[m][bj][1] + acc[ai][bj][m][1];
                    *(f32x4*)(ox + off + col0 + 128 * bj) = h0;
                    *(f32x4*)(ox + off + col0 + 128 * bj + 4) = h1;
                    if (write_aux) {
                        ss += (h0[0] * h0[0] + h0[1] * h0[1]) + (h0[2] * h0[2] + h0[3] * h0[3]) + (h1[0] * h1[0] + h1[1] * h1[1]) + (h1[2] * h1[2] + h1[3] * h1[3]);
                        u32x4 w; w.x = pk2(h0[0], h0[1]); w.y = pk2(h0[2], h0[3]); w.z = pk2(h1[0], h1[1]); w.w = pk2(h1[2], h1[3]);
                        *(u32x4*)(hb + (size_t)row * 1024 + col0 + 128 * bj) = w;
                    }
                }
                if (write_aux) {
                    ss += __shfl_xor(ss, 16); ss += __shfl_xor(ss, 32);
                    if (fq == 0) ssp[(size_t)row * 16 + u.pn * 4 + wc] = ss;
                }
            }
        }
    }
};

struct EpiUp {
    static constexpr bool PERM = true, AFTER_DRAIN = false;
    const float* ssp; bf16_t* hid; LAS float* tab;
    __device__ __forceinline__ void operator()(const AccT& acc, const pg8::Unit& u, int wr, int wc, int fr, int fq) const {
        const int col0 = u.pn * 256 + wc * 32 + 8 * fq, rb = rowbase(u.pm);
        build_rs_tab(ssp, tab, rb, wr, wc, fr, fq);
#pragma unroll
        for (int ai = 0; ai < 2; ++ai)
#pragma unroll
            for (int m = 0; m < 4; ++m) {
                const int loc = ai * 128 + wr * 64 + m * 16 + fr, row = rb + loc;
                const float rs = tab[loc];
#pragma unroll
                for (int bj = 0; bj < 2; ++bj) {
                    f32x4 a = acc[ai][bj][m][0] * rs, b = acc[ai][bj][m][1] * rs;
#pragma unroll
                    for (int i = 0; i < 4; ++i) { const float x = fmaxf(a[i], 0.f), y = fmaxf(b[i], 0.f); a[i] = x * x; b[i] = y * y; }
                    u32x4 w; w.x = pk2(a[0], a[1]); w.y = pk2(a[2], a[3]); w.z = pk2(b[0], b[1]); w.w = pk2(b[2], b[3]);
                    *(u32x4*)(hid + (size_t)row * DFF + col0 + 128 * bj) = w;
                }
            }
    }
};

struct EpiQkv {
    static constexpr bool PERM = true, AFTER_DRAIN = false;
    const float* ssp; const float* qg; const float* kg; bf16_t* qkv; LAS float* tab;
    __device__ __forceinline__ void operator()(const AccT& acc, const pg8::Unit& u, int wr, int wc, int fr, int fq) const {
        const int blk = u.pn >> 2, head = 4 * (u.pn & 3) + wc, rb = rowbase(u.pm);
        bf16_t* dst = qkv + (size_t)blk * (UNIT / 2);
        const float* gg = blk == 0 ? qg : kg;
        const f32x4 g00 = *(const f32x4*)(gg + 8 * fq), g01 = *(const f32x4*)(gg + 8 * fq + 4), g10 = *(const f32x4*)(gg + 32 + 8 * fq), g11 = *(const f32x4*)(gg + 32 + 8 * fq + 4);
        build_rs_tab(ssp, tab, rb, wr, wc, fr, fq);
        const float post = blk == 0 ? 0.18033688011112042f : 1.0f;
#pragma unroll
        for (int ai = 0; ai < 2; ++ai)
#pragma unroll
            for (int m = 0; m < 4; ++m) {
                const int loc = ai * 128 + wr * 64 + m * 16 + fr, row = rb + loc;
                const float rs = tab[loc];
                f32x4 v00 = acc[ai][0][m][0] * rs, v01 = acc[ai][0][m][1] * rs, v10 = acc[ai][1][m][0] * rs, v11 = acc[ai][1][m][1] * rs;
                if (blk < 2) {
                    const f32x4 t = v00 * v00 + v01 * v01 + v10 * v10 + v11 * v11;
                    float ss = (t[0] + t[1]) + (t[2] + t[3]);
                    ss += __shfl_xor(ss, 16); ss += __shfl_xor(ss, 32);
                    const float r2 = rsqrtf(ss * (1.0f / 64.0f) + 1e-6f) * post;
                    v00 = v00 * r2 * g00; v01 = v01 * r2 * g01; v10 = v10 * r2 * g10; v11 = v11 * r2 * g11;
                }
                u32x4 w0, w1;
                w0.x = pk2(v00[0], v00[1]); w0.y = pk2(v00[2], v00[3]); w0.z = pk2(v01[0], v01[1]); w0.w = pk2(v01[2], v01[3]);
                w1.x = pk2(v10[0], v10[1]); w1.y = pk2(v10[2], v10[3]); w1.z = pk2(v11[0], v11[1]); w1.w = pk2(v11[2], v11[3]);
                *(u32x4*)(dst + (size_t)row * 1024 + head * 64 + 8 * fq) = w0;
                *(u32x4*)(dst + (size_t)row * 1024 + head * 64 + 32 + 8 * fq) = w1;
            }
    }
};

struct Params {
    const float *x, *meta, *norm_mix_g, *norm_mlp_g, *even_w_in, *even_gn_g, *even_conv_w, *even_conv_b, *even_ln_g, *even_ln_b, *even_w_out,
        *odd_w_qkv, *odd_qn_g, *odd_kn_g, *odd_w_o, *mlp_w1, *mlp_w2;
    float* out; unsigned char* ws;
};
typedef const __attribute__((address_space(4))) Params CParams;
__device__ __forceinline__ CParams* kparams() { CParams* kp = (CParams*)__builtin_amdgcn_kernarg_segment_ptr(); asm volatile("" : "+s"(kp)); return kp; }
#define KP (*kparams())

template <int MODE>
__device__ __forceinline__ void p0_transpose_item(const float* W, int K, int N, bf16_t* WT, const float* gain, LAS float* scr, int item, int lane) {
    const int nblk = N / 32, kb = item / nblk, nb = item % nblk, k0 = 64 * kb, n0 = 32 * nb;
    float wv[32];
#pragma unroll
    for (int i = 0; i < 32; ++i) wv[i] = W[(size_t)(k0 + 2 * i + (lane >> 5)) * N + n0 + (lane & 31)];
#pragma unroll
    for (int i = 0; i < 32; ++i) { const int kk = 2 * i + (lane >> 5); float w = wv[i]; if (gain) w *= gain[k0 + kk]; scr[kk * 33 + (lane & 31)] = w; }
    LDS_WAIT();
    const int c = lane & 7;
#pragma unroll
    for (int j = 0; j < 4; ++j) { const int n = (lane >> 3) + 8 * j; const LAS float* s = scr + (8 * c) * 33 + n;
        const int lc = n0 + n; const int prow = MODE == 1 ? l2p_in(lc) : (MODE == 2 ? l2p_qkv(lc) : lc);
        u32x4 o; o.x = pk2(s[0 * 33], s[1 * 33]); o.y = pk2(s[2 * 33], s[3 * 33]); o.z = pk2(s[4 * 33], s[5 * 33]); o.w = pk2(s[6 * 33], s[7 * 33]);
        *(u32x4*)(WT + (size_t)prow * K + k0 + 8 * c) = o; }
    LDS_WAIT();
}

__device__ __forceinline__ void phase0(CParams& P, LAS unsigned char* lds, int tid) {
    const int lane = tid & 63, wave = tid >> 6;
    const int gw = blockIdx.x * 8 + wave, NGW = gridDim.x * 8;
    LAS float* scr = (LAS float*)(lds + wave * 16384);
    unsigned char* ws = P.ws;
    constexpr int I_IN = 16 * 160, I_OUT = 32 * 32, I_W1 = 16 * 128, I_W2 = 64 * 32, I_QKV = 16 * 96, I_O = 16 * 32;
    constexpr int NITEMS = I_IN + I_OUT + 2 * I_W1 + 2 * I_W2 + I_QKV + I_O;
    for (int it = gw; it < NITEMS; it += NGW) {
        int r = it;
        if (r < I_IN) { p0_transpose_item<1>(P.even_w_in, 1024, 5120, (bf16_t*)(ws + WS_WIN), P.norm_mix_g, scr, r, lane); continue; } r -= I_IN;
        if (r < I_OUT) { p0_transpose_item<0>(P.even_w_out, 2048, 1024, (bf16_t*)(ws + WS_WOUT), nullptr, scr, r, lane); continue; } r -= I_OUT;
        if (r < I_W1) { p0_transpose_item<0>(P.mlp_w1, 1024, 4096, (bf16_t*)(ws + WS_W1), P.norm_mlp_g, scr, r, lane); continue; } r -= I_W1;
        if (r < I_W1) { p0_transpose_item<0>(P.mlp_w1 + (size_t)1024 * 4096, 1024, 4096, (bf16_t*)(ws + WS_W1) + (size_t)4096 * 1024, P.norm_mlp_g + 1024, scr, r, lane); continue; } r -= I_W1;
        if (r < I_W2) { p0_transpose_item<0>(P.mlp_w2, 4096, 1024, (bf16_t*)(ws + WS_W2), nullptr, scr, r, lane); continue; } r -= I_W2;
        if (r < I_W2) { p0_transpose_item<0>(P.mlp_w2 + (size_t)1024 * 4096, 4096, 1024, (bf16_t*)(ws + WS_W2) + (size_t)4096 * 1024, nullptr, scr, r, lane); continue; } r -= I_W2;
        if (r < I_QKV) { p0_transpose_item<2>(P.odd_w_qkv, 1024, 3072, (bf16_t*)(ws + WS_WQKV), P.norm_mix_g + 1024, scr, r, lane); continue; } r -= I_QKV;
        p0_transpose_item<0>(P.odd_w_o, 1024, 1024, (bf16_t*)(ws + WS_WO), nullptr, scr, r, lane);
    }
    float* rope = (float*)(ws + WS_ROPE);
    for (int i = blockIdx.x * NTHR + tid; i < PP * 64; i += gridDim.x * NTHR) {
        const int p = i >> 6, d = i & 63;
        const float inv = exp2f(-(float)d * 0.20762050593046014f);
        const float ang = (float)p * inv;
        double t = (double)ang * 0.15915494309189535; t -= floor(t);
        const float tf = (float)t;
        rope[2 * i] = __builtin_amdgcn_cosf(tf); rope[2 * i + 1] = __builtin_amdgcn_sinf(tf);
    }
    bf16_t* hb = (bf16_t*)(ws + WS_R0);
    float* rs0 = (float*)(ws + WS_SS);
    for (int m0 = 2 * gw; m0 < NB * SEQ; m0 += 2 * NGW) {
        f32x4 v[2][4];
#pragma unroll
        for (int q = 0; q < 2; ++q) { const f32x4* xr = (const f32x4*)(P.x + (size_t)(m0 + q) * DM) + lane;
#pragma unroll
            for (int j = 0; j < 4; ++j) v[q][j] = xr[64 * j]; }
#pragma unroll
        for (int q = 0; q < 2; ++q) {
            const int m = m0 + q, row = rowbase(m >> 8) + (m & 255);
            u32x2* o8 = (u32x2*)(hb + (size_t)row * 1024) + lane;
            float ss = 0.f;
#pragma unroll
            for (int j = 0; j < 4; ++j) { const f32x4 t = v[q][j]; ss += (t.x * t.x + t.y * t.y) + (t.z * t.z + t.w * t.w); u32x2 w; w.x = pk2(t.x, t.y); w.y = pk2(t.z, t.w); o8[64 * j] = w; }
            ss = wave_sum(ss);
            if (lane == 0) rs0[row] = rsqrtf(ss * (1.0f / 1024.0f) + 1e-6f);
        }
    }
    for (int i = gw; i < NB * PADF; i += NGW) {
        const int b = i / PADF, p = i - b * PADF; const size_t row = (size_t)b * PP + p;
        const u32x4 z = (u32x4){0u, 0u, 0u, 0u};
        u32x4* d4 = (u32x4*)(ws + WS_R4 + row * 2048) + lane; d4[0] = z; d4[64] = z;
        u32x4* d1 = (u32x4*)(ws + WS_R1 + row * 2048) + lane; d1[0] = z; d1[64] = z;
        u32x4* d3 = (u32x4*)(ws + WS_R3 + row * 2048) + lane; d3[0] = z; d3[64] = z;
    }
}

template <int NCOL, bool ABF, bool NORM, int UNR = 2>
__device__ __forceinline__ void meta_wave(const void* Aptr, int K, const bf16_t* Wt, const int (&wrow)[NCOL], int w, int lane, float (&out)[2][NCOL], float (&rs)[2]) {
    float q0 = 0.f, q1 = 0.f;
#pragma unroll
    for (int c = 0; c < NCOL; ++c) { out[0][c] = 0.f; out[1][c] = 0.f; }
#pragma unroll UNR
    for (int kc = lane; kc < (K >> 3); kc += 64) {
        float a0[8], a1[8];
        if (ABF) {
            const u32x4 u0 = *(const u32x4*)((const bf16_t*)Aptr + (size_t)(2 * w) * K + 8 * kc), u1 = *(const u32x4*)((const bf16_t*)Aptr + (size_t)(2 * w + 1) * K + 8 * kc);
            a0[0] = bf_lo(u0.x); a0[1] = bf_hi(u0.x); a0[2] = bf_lo(u0.y); a0[3] = bf_hi(u0.y); a0[4] = bf_lo(u0.z); a0[5] = bf_hi(u0.z); a0[6] = bf_lo(u0.w); a0[7] = bf_hi(u0.w);
            a1[0] = bf_lo(u1.x); a1[1] = bf_hi(u1.x); a1[2] = bf_lo(u1.y); a1[3] = bf_hi(u1.y); a1[4] = bf_lo(u1.z); a1[5] = bf_hi(u1.z); a1[6] = bf_lo(u1.w); a1[7] = bf_hi(u1.w);
        } else {
            const f32x4* p0 = (const f32x4*)((const float*)Aptr + (size_t)(2 * w) * K + 8 * kc); const f32x4* p1 = (const f32x4*)((const float*)Aptr + (size_t)(2 * w + 1) * K + 8 * kc);
            const f32x4 x0 = p0[0], x1 = p0[1], y0 = p1[0], y1 = p1[1];
#pragma unroll
            for (int i = 0; i < 4; ++i) { a0[i] = x0[i]; a0[4 + i] = x1[i]; a1[i] = y0[i]; a1[4 + i] = y1[i]; }
        }
        if (NORM) {
#pragma unroll
            for (int i = 0; i < 8; ++i) { q0 += a0[i] * a0[i]; q1 += a1[i] * a1[i]; }
        }
#pragma unroll
        for (int c = 0; c < NCOL; ++c) {
            const u32x4 wv = *(const u32x4*)(Wt + (size_t)wrow[c] * K + 8 * kc);
            const float wf[8] = {bf_lo(wv.x), bf_hi(wv.x), bf_lo(wv.y), bf_hi(wv.y), bf_lo(wv.z), bf_hi(wv.z), bf_lo(wv.w), bf_hi(wv.w)};
#pragma unroll
            for (int i = 0; i < 8; ++i) { out[0][c] += a0[i] * wf[i]; out[1][c] += a1[i] * wf[i]; }
        }
    }
#pragma unroll
    for (int c = 0; c < NCOL; ++c) { out[0][c] = wave_sum(out[0][c]); out[1][c] = wave_sum(out[1][c]); }
    if (NORM) { rs[0] = rsqrtf(wave_sum(q0) / (float)K + 1e-6f); rs[1] = rsqrtf(wave_sum(q1) / (float)K + 1e-6f); } else { rs[0] = 1.f; rs[1] = 1.f; }
}
template <int NN>
__device__ __forceinline__ float pick(LAS float* scr, const float (&a)[NN], int j, int lane) {
    if (lane == 0) {
#pragma unroll
        for (int i = 0; i < NN; ++i) scr[i] = a[i];
    }
    LDS_WAIT();
    const float r = scr[j];
    LDS_WAIT();
    return r;
}
__device__ __forceinline__ bf16_t bf1(float x) { return (bf16_t)(pk2(x, 0.f) & 0xffffu); }
__device__ __forceinline__ void store_meta_rows(bf16_t* buf, int r, int col, float val) {
    const bf16_t bv = bf1(val);
#pragma unroll
    for (int b = 0; b < NB; ++b) buf[((size_t)b * PP + PADF + r) * 1024 + col] = bv;
}
__device__ __forceinline__ void meta_in(CParams& P, LAS unsigned char* lds, int t, int tid) {
    const int lane = tid & 63, w = __builtin_amdgcn_readfirstlane(tid >> 6); int cb1, cb2, kind;
    if (t < 64) { const int pid = t * 8, blk = pid >> 8, head = (pid >> 6) & 3, d = pid & 63; kind = blk; cb1 = blk * 512 + head * 128 + d; cb2 = cb1 + 64; }
    else if (t < 192) { cb1 = 1024 + (t - 64) * 16; cb2 = cb1 + 8; kind = cb1 < 2048 ? 2 : 3; }
    else { kind = 4; cb1 = 3072 + (t - 192) * 8; cb2 = cb1 + 1024; }
    float o[2][16], rsv[2];
    int wrow[16];
#pragma unroll
    for (int c = 0; c < 8; ++c) { wrow[c] = l2p_in(cb1 + c); wrow[8 + c] = l2p_in(cb2 + c); }
    meta_wave<16, false, true>(P.meta, 1024, (const bf16_t*)(P.ws + WS_WIN), wrow, w, lane, o, rsv);
    unsigned char* ws = P.ws;
    const int j = lane & 7;
#pragma unroll
    for (int i = 0; i < 2; ++i) {
        const int r = 2 * w + i, p = PADF + r;
        if (kind <= 1 || kind == 4) {
            float lo8[8], hi8[8];
#pragma unroll
            for (int c = 0; c < 8; ++c) { lo8[c] = o[i][c]; hi8[c] = o[i][8 + c]; }
            const float y1 = pick<8>((LAS float*)(lds + 131072 + w * 1024), lo8, j, lane) * rsv[i], y2 = pick<8>((LAS float*)(lds + 131072 + w * 1024), hi8, j, lane) * rsv[i];
            if (lane < 8) {
                if (kind <= 1) {
                    const int head = (cb1 >> 7) & 3, d = (cb1 & 63) + j;
                    const float* rope = (const float*)(ws + WS_ROPE) + ((size_t)p * 64 + d) * 2;
                    const float c = rope[0], sn = rope[1];
                    const float ip1 = (float)(p + 1), lg = lg2gamma(head);
                    const float fac = kind == 0 ? fexp2(ip1 * lg) : fexp2(-ip1 * lg) * 0.08838834764831845f;
                    store_meta_rows((bf16_t*)(ws + WS_R4), r, l2p_in(cb1 + j), (y1 * c - y2 * sn) * fac);
                    store_meta_rows((bf16_t*)(ws + WS_R4), r, l2p_in(cb2 + j), (y1 * sn + y2 * c) * fac);
                } else {
                    store_meta_rows((bf16_t*)(ws + WS_R3), r, cb1 - 3072 + j, y1 * sigmoidf_(y2));
                }
            }
        } else {
            const float y = pick<16>((LAS float*)(lds + 131072 + w * 1024), o[i], lane & 15, lane) * rsv[i];
            if (lane < 16) {
                if (kind == 2) store_meta_rows((bf16_t*)(ws + WS_R1), r, cb1 - 1024 + lane, y);
                else store_meta_rows((bf16_t*)(ws + WS_R2), r, cb1 - 2048 + lane, y * sigmoidf_(y));
            }
        }
    }
}
__device__ __forceinline__ void meta_out(CParams& P, LAS unsigned char* lds, int t, int tid) {
    const int lane = tid & 63, w = __builtin_amdgcn_readfirstlane(tid >> 6);
    float o[2][4], rsv[2];
    const int wrow[4] = {4 * t, 4 * t + 1, 4 * t + 2, 4 * t + 3};
    meta_wave<4, true, false, 4>((const bf16_t*)(P.ws + WS_R0) + (size_t)PADF * 2048, 2048, (const bf16_t*)(P.ws + WS_WOUT), wrow, w, lane, o, rsv);
    float* hm1 = (float*)(P.ws + WS_HM1);
#pragma unroll
    for (int i = 0; i < 2; ++i) { const int r = 2 * w + i; const float y = pick<4>((LAS float*)(lds + 131072 + w * 1024), o[i], lane & 3, lane); if (lane < 4) hm1[r * 1024 + 4 * t + lane] = P.meta[r * 1024 + 4 * t + lane] + y; }
}
__device__ __forceinline__ void meta_up(CParams& P, LAS unsigned char* lds, int t, int tid) {
    const int lane = tid & 63, w = __builtin_amdgcn_readfirstlane(tid >> 6);
    float o[2][16], rsv[2];
    int wrow[16];
#pragma unroll
    for (int c = 0; c < 16; ++c) wrow[c] = 16 * t + c;
    meta_wave<16, false, true>((const float*)(P.ws + WS_HM1), 1024, (const bf16_t*)(P.ws + WS_W1), wrow, w, lane, o, rsv);
    float* hid = (float*)(P.ws + WS_HIDM);
#pragma unroll
    for (int i = 0; i < 2; ++i) { const int r = 2 * w + i; const float x = fmaxf(pick<16>((LAS float*)(lds + 131072 + w * 1024), o[i], lane & 15, lane) * rsv[i], 0.f); if (lane < 16) hid[r * 4096 + 16 * t + lane] = x * x; }
}
__device__ __forceinline__ void meta_down(CParams& P, LAS unsigned char* lds, int t, int tid) {
    const int lane = tid & 63, w = __builtin_amdgcn_readfirstlane(tid >> 6);
    float o[2][4], rsv[2];
    const int wrow[4] = {4 * t, 4 * t + 1, 4 * t + 2, 4 * t + 3};
    meta_wave<4, false, false, 4>((const float*)(P.ws + WS_HIDM), 4096, (const bf16_t*)(P.ws + WS_W2), wrow, w, lane, o, rsv);
    const float* hm1 = (const float*)(P.ws + WS_HM1);
    float* hm2 = (float*)(P.ws + WS_HM2P);
#pragma unroll
    for (int i = 0; i < 2; ++i) { const int r = 2 * w + i; const float y = pick<4>((LAS float*)(lds + 131072 + w * 1024), o[i], lane & 3, lane); if (lane < 4) hm2[r * 1024 + 4 * t + lane] = hm1[r * 1024 + 4 * t + lane] + y; }
}
constexpr size_t WS_KRAW = WS_HIDM, WS_VRAW = WS_HIDM + 65536, WS_KSS = WS_HIDM + 131072;
__device__ __forceinline__ void meta_kv(CParams& P, LAS unsigned char* lds, int t, int tid) {
    const int lane = tid & 63, w = __builtin_amdgcn_readfirstlane(tid >> 6);
    const int cb = 1024 + 16 * t;
    float o[2][16], rsv[2];
    int wrow[16];
#pragma unroll
    for (int c = 0; c < 16; ++c) wrow[c] = l2p_qkv(cb + c);
    meta_wave<16, false, true>((const float*)(P.ws + WS_HM2P), 1024, (const bf16_t*)(P.ws + WS_WQKV), wrow, w, lane, o, rsv);
    float* raw = (float*)(P.ws + (t < 64 ? WS_KRAW : WS_VRAW));
    float* kss = (float*)(P.ws + WS_KSS);
#pragma unroll
    for (int i = 0; i < 2; ++i) {
        const int r = 2 * w + i; float ss = 0.f;
#pragma unroll
        for (int c = 0; c < 16; ++c) { o[i][c] *= rsv[i]; ss += o[i][c] * o[i][c]; }
        const float y = pick<16>((LAS float*)(lds + 131072 + w * 1024), o[i], lane & 15, lane);
        if (lane < 16) raw[r * 1024 + 16 * (t & 63) + lane] = y;
        if (t < 64 && lane == 0) kss[r * 64 + t] = ss;
    }
}

__device__ __forceinline__ void load_T128(const bf16_t* src, int ld, int ncg, LAS unsigned char* dst, int tid) {
    for (int u = tid; u < 64 * ncg; u += NTHR) {
        const int jp = u & 63, cgi = u >> 6;
        const u32x4 a = *(const u32x4*)(src + (size_t)(2 * jp) * ld + cgi * 8), b = *(const u32x4*)(src + (size_t)(2 * jp + 1) * ld + cgi * 8);
        LAS unsigned* d = (LAS unsigned*)(dst + (cgi * 8) * 272 + jp * 4);
        d[0 * 68] = (a.x & 0xffffu) | (b.x << 16); d[1 * 68] = (a.x >> 16) | (b.x & 0xffff0000u);
        d[2 * 68] = (a.y & 0xffffu) | (b.y << 16); d[3 * 68] = (a.y >> 16) | (b.y & 0xffff0000u);
        d[4 * 68] = (a.z & 0xffffu) | (b.z << 16); d[5 * 68] = (a.z >> 16) | (b.z & 0xffff0000u);
        d[6 * 68] = (a.w & 0xffffu) | (b.w << 16); d[7 * 68] = (a.w >> 16) | (b.w & 0xffff0000u);
    }
}
template <int NU>
__device__ __forceinline__ void tload_issue(u32x4 (&a)[NU], u32x4 (&b)[NU], const bf16_t* src, int ld, int tid) {
#pragma unroll
    for (int i = 0; i < NU; ++i) { const int u = tid + i * NTHR, jp = u & 63, cgi = u >> 6;
        a[i] = *(const u32x4*)(src + (size_t)(2 * jp) * ld + cgi * 8); b[i] = *(const u32x4*)(src + (size_t)(2 * jp + 1) * ld + cgi * 8); }
}
template <int NU>
__device__ __forceinline__ void tload_store(const u32x4 (&a)[NU], const u32x4 (&b)[NU], LAS unsigned char* dst, int tid) {
#pragma unroll
    for (int i = 0; i < NU; ++i) { const int u = tid + i * NTHR, jp = u & 63, cgi = u >> 6;
        LAS unsigned* d = (LAS unsigned*)(dst + (cgi * 8) * 272 + jp * 4);
        d[0 * 68] = (a[i].x & 0xffffu) | (b[i].x << 16); d[1 * 68] = (a[i].x >> 16) | (b[i].x & 0xffff0000u);
        d[2 * 68] = (a[i].y & 0xffffu) | (b[i].y << 16); d[3 * 68] = (a[i].y >> 16) | (b[i].y & 0xffff0000u);
        d[4 * 68] = (a[i].z & 0xffffu) | (b[i].z << 16); d[5 * 68] = (a[i].z >> 16) | (b[i].z & 0xffff0000u);
        d[6 * 68] = (a[i].w & 0xffffu) | (b[i].w << 16); d[7 * 68] = (a[i].w >> 16) | (b[i].w & 0xffff0000u); }
}
constexpr int RET_KS = 0, RET_VT = 34816, RET_RED = 34816 + 69632;

__device__ __forceinline__ void ret_partial_item(CParams& P, LAS unsigned char* lds, int item, int tid) {
    asm volatile("" : "+v"(tid));
    const int lane = tid & 63, w = tid >> 6, l32 = lane & 31, hh = lane >> 5;
    int b, n, h;
    if (item < 128) { b = 0; n = item >> 2; h = item & 3; } else { const int j = item - 128; b = 1 + j / 124; const int r = j - (b - 1) * 124; n = 1 + (r >> 2); h = r & 3; }
    const bf16_t* qk = (const bf16_t*)(P.ws + WS_R4); const bf16_t* v = (const bf16_t*)(P.ws + WS_R1);
    bf16_t* G = (n == 0) ? (bf16_t*)P.out + (size_t)(1024 + h) * 32768 : (bf16_t*)P.out + ((size_t)((b * 4 + h) * 32 + n)) * 32768;
    const size_t R0 = (size_t)b * PP + 128 * n;
    {
        u32x4 ka[2], kb[2], va[4], vb[4];
        tload_issue<2>(ka, kb, qk + R0 * 1024 + 512 + h * 128, 1024, tid);
        tload_issue<4>(va, vb, v + R0 * 1024 + h * 256, 1024, tid);
        tload_store<2>(ka, kb, lds + RET_KS, tid);
        tload_store<4>(va, vb, lds + RET_VT, tid);
    }
    __syncthreads();
    const int dt = w & 3, eh = w >> 2;
    f32x16 acc[4];
#pragma unroll
    for (int et = 0; et < 4; ++et)
#pragma unroll
        for (int r = 0; r < 16; ++r) acc[et][r] = 0.f;
#pragma unroll
    for (int s = 0; s < 8; ++s) {
        const bf16x8 a = *(const LAS bf16x8*)(lds + RET_KS + (32 * dt + l32) * 272 + (16 * s + 8 * hh) * 2);
#pragma unroll
        for (int et = 0; et < 4; ++et) {
            const bf16x8 bb = *(const LAS bf16x8*)(lds + RET_VT + (32 * (4 * eh + et) + l32) * 272 + (16 * s + 8 * hh) * 2);
            acc[et] = MFMA32(a, bb, acc[et]);
        }
    }
    __syncthreads();
#pragma unroll
    for (int et = 0; et < 4; ++et)
#pragma unroll
        for (int g = 0; g < 4; ++g) {
            u32x2 o; o.x = pk2(acc[et][4 * g], acc[et][4 * g + 1]); o.y = pk2(acc[et][4 * g + 2], acc[et][4 * g + 3]);
            *(LAS u32x2*)(lds + RET_VT + (32 * (4 * eh + et) + l32) * 272 + (32 * dt + 8 * g + 4 * hh) * 2) = o;
        }
    __syncthreads();
    for (int c = tid; c < 4096; c += NTHR) { const int e = c >> 4, part = c & 15; *(u32x4*)(G + (size_t)c * 8) = *(const LAS u32x4*)(lds + RET_VT + e * 272 + part * 16); }
    __syncthreads();
}

template <int NT>
__device__ __forceinline__ void conv_item(CParams& P, LAS unsigned char* lds, int b, int p0, int tid) {
    const int lane = tid & 63, w = tid >> 6;
    const bf16_t* hdn = (const bf16_t*)(P.ws + WS_R3);
    bf16_t* mix = (bf16_t*)(P.ws + WS_R0);
    const size_t Rb = (size_t)b * PP;
    const unsigned* hd = (const unsigned*)(hdn + (Rb + p0 - 30) * 1024) + tid;
    unsigned xr[NT + 30];
#pragma unroll
    for (int r = 0; r < NT + 30; ++r) xr[r] = hd[r * 512];
    f32x2 W[31];
#pragma unroll
    for (int k = 0; k < 31; ++k) W[k] = *(const f32x2*)(P.even_conv_w + k * 1024 + 2 * tid);
    const f32x2 bias = *(const f32x2*)(P.even_conv_b + 2 * tid);
    LAS float* ys = (LAS float*)lds;
#pragma unroll
    for (int hf = 0; hf < NT / 16; ++hf) {
        f32x2 acc[16];
#pragma unroll
        for (int t = 0; t < 16; ++t) acc[t] = bias;
#pragma unroll
        for (int r = 0; r < 46; ++r) {
            const f32x2 xf = {bf_lo(xr[16 * hf + r]), bf_hi(xr[16 * hf + r])};
#pragma unroll
            for (int t = 0; t < 16; ++t) { const int k = r - t; if (k >= 0 && k <= 30) acc[t] += xf * W[k]; }
        }
#pragma unroll
        for (int t = 0; t < 16; ++t) *(LAS f32x2*)(ys + (16 * hf + t) * 1024 + 2 * tid) = acc[t];
    }
    f32x4 lg[4], lb[4];
#pragma unroll
    for (int j = 0; j < 4; ++j) { lg[j] = *(const f32x4*)(P.even_ln_g + 4 * lane + 256 * j); lb[j] = *(const f32x4*)(P.even_ln_b + 4 * lane + 256 * j); }
    __syncthreads();
    constexpr int TW = NT / 8;
#pragma unroll
    for (int q0 = 0; q0 < TW; q0 += 2) {
        f32x4 y[2][4]; float s[2] = {0.f, 0.f};
#pragma unroll
        for (int q = 0; q < 2; ++q)
#pragma unroll
            for (int j = 0; j < 4; ++j) { y[q][j] = *(const LAS f32x4*)(ys + (TW * w + q0 + q) * 1024 + 4 * lane + 256 * j); s[q] += (y[q][j].x + y[q][j].y) + (y[q][j].z + y[q][j].w); }
#pragma unroll
        for (int o = 1; o < 64; o <<= 1) { s[0] += __shfl_xor(s[0], o); s[1] += __shfl_xor(s[1], o); }
        float qv[2] = {0.f, 0.f};
#pragma unroll
        for (int q = 0; q < 2; ++q) { const float mean = s[q] * (1.0f / 1024.0f);
#pragma unroll
            for (int j = 0; j < 4; ++j) { y[q][j] = y[q][j] - mean; qv[q] += (y[q][j].x * y[q][j].x + y[q][j].y * y[q][j].y) + (y[q][j].z * y[q][j].z + y[q][j].w * y[q][j].w); } }
#pragma unroll
        for (int o = 1; o < 64; o <<= 1) { qv[0] += __shfl_xor(qv[0], o); qv[1] += __shfl_xor(qv[1], o); }
#pragma unroll
        for (int q = 0; q < 2; ++q) {
            const float rstd = rsqrtf(qv[q] * (1.0f / 1024.0f) + 1e-6f);
            const size_t row = Rb + p0 + TW * w + q0 + q;
#pragma unroll
            for (int j = 0; j < 4; ++j) {
                f32x4 o = y[q][j] * rstd * lg[j] + lb[j];
#pragma unroll
                for (int i = 0; i < 4; ++i) o[i] = o[i] * sigmoidf_(o[i]);
                u32x2 wv; wv.x = pk2(o[0], o[1]); wv.y = pk2(o[2], o[3]);
                *(u32x2*)(mix + row * 2048 + 1024 + 4 * lane + 256 * j) = wv;
            }
        }
    }
    __syncthreads();
}

__device__ __forceinline__ void ret_scan(CParams& P, int tid) {
    bf16_t* G = (bf16_t*)P.out;
    for (int c = blockIdx.x * NTHR + tid; c < 32 * 4096; c += gridDim.x * NTHR) {
        const int bh = c >> 12, off = (c & 4095) * 8, h = bh & 3;
        const float lam = fexp2(128.0f * lg2gamma(h));
        bf16_t* ptr = G + (size_t)bh * 32 * 32768 + off;
        float S[8];
#pragma unroll
        for (int k = 0; k < 8; ++k) S[k] = 0.f;
#pragma unroll 8
        for (int n = 0; n < 32; ++n) {
            const u32x4 g = (n == 0) ? *(const u32x4*)(G + (size_t)(1024 + h) * 32768 + off) : *(const u32x4*)(ptr + (size_t)n * 32768);
            S[0] = lam * (S[0] + bf_lo(g.x)); S[1] = lam * (S[1] + bf_hi(g.x)); S[2] = lam * (S[2] + bf_lo(g.y)); S[3] = lam * (S[3] + bf_hi(g.y));
            S[4] = lam * (S[4] + bf_lo(g.z)); S[5] = lam * (S[5] + bf_hi(g.z)); S[6] = lam * (S[6] + bf_lo(g.w)); S[7] = lam * (S[7] + bf_hi(g.w));
            u32x4 o; o.x = pk2(S[0], S[1]); o.y = pk2(S[2], S[3]); o.z = pk2(S[4], S[5]); o.w = pk2(S[6], S[7]);
            *(u32x4*)(ptr + (size_t)n * 32768) = o;
        }
    }
}

__device__ __forceinline__ void ret_out_item(CParams& P, LAS unsigned char* lds, int item, int tid) {
    asm volatile("" : "+v"(tid));
    const int lane = tid & 63, w = tid >> 6, l32 = lane & 31, hh = lane >> 5;
    const int b = item / 132, rem = item - b * 132, n = rem >> 2, h = rem & 3;
    const bf16_t* qk = (const bf16_t*)(P.ws + WS_R4); const bf16_t* v = (const bf16_t*)(P.ws + WS_R1); const bf16_t* gs = (const bf16_t*)(P.ws + WS_R2);
    bf16_t* mix = (bf16_t*)(P.ws + WS_R0);
    const size_t R0 = (size_t)b * PP + 128 * n;
    const int ib = w & 3, eh = w >> 2;
    bf16x8 qf[8];
    {
        u32x4 kt[4], va[4], vb[4];
#pragma unroll
        for (int i = 0; i < 4; ++i) { const int c = tid + i * NTHR; kt[i] = *(const u32x4*)(qk + (R0 + (c >> 4)) * 1024 + 512 + h * 128 + (c & 15) * 8); }
        tload_issue<4>(va, vb, v + R0 * 1024 + h * 256, 1024, tid);
#pragma unroll
        for (int s = 0; s < 8; ++s) qf[s] = *(const bf16x8*)(qk + (R0 + 32 * ib + l32) * 1024 + h * 128 + 16 * s + 8 * hh);
#pragma unroll
        for (int i = 0; i < 4; ++i) { const int c = tid + i * NTHR; *(LAS u32x4*)(lds + RET_KS + (c >> 4) * 272 + (c & 15) * 16) = kt[i]; }
        tload_store<4>(va, vb, lds + RET_VT, tid);
    }
    const bf16_t* prev = (const bf16_t*)P.out + ((size_t)((b * 4 + h) * 32 + (n > 0 ? n - 1 : 0))) * 32768;
    bf16x8 pf[4][4];
    if (n > 0) {
#pragma unroll
        for (int s = 0; s < 4; ++s)
#pragma unroll
            for (int et = 0; et < 4; ++et) pf[s][et] = *(const bf16x8*)(prev + (size_t)(32 * (4 * eh + et) + l32) * 128 + 16 * s + 8 * hh);
    }
    __syncthreads();
    f32x16 O[4];
#pragma unroll
    for (int et = 0; et < 4; ++et)
#pragma unroll
        for (int r = 0; r < 16; ++r) O[et][r] = 0.f;
    if (n > 0) {
#pragma unroll
        for (int s = 0; s < 4; ++s)
#pragma unroll
            for (int et = 0; et < 4; ++et) O[et] = MFMA32(pf[s][et], qf[s], O[et]);
#pragma unroll
        for (int s = 4; s < 8; ++s)
#pragma unroll
            for (int et = 0; et < 4; ++et) {
                const bf16x8 a = *(const bf16x8*)(prev + (size_t)(32 * (4 * eh + et) + l32) * 128 + 16 * s + 8 * hh);
                O[et] = MFMA32(a, qf[s], O[et]);
            }
    }
#pragma unroll 1
    for (int jt = 0; jt <= ib; ++jt) {
        f32x16 x;
#pragma unroll
        for (int r = 0; r < 16; ++r) x[r] = 0.f;
#pragma unroll
        for (int s = 0; s < 8; ++s) {
            const bf16x8 a = *(const LAS bf16x8*)(lds + RET_KS + (32 * jt + l32) * 272 + (16 * s + 8 * hh) * 2);
            x = MFMA32(a, qf[s], x);
        }
        if (jt == ib) {
#pragma unroll
            for (int r = 0; r < 16; ++r) x[r] = (crow(r, hh) > l32) ? 0.f : x[r];
        }
        u32x4 p0, p1;
        p0.x = pk2(x[0], x[1]); p0.y = pk2(x[2], x[3]); p0.z = pk2(x[4], x[5]); p0.w = pk2(x[6], x[7]);
        p1.x = pk2(x[8], x[9]); p1.y = pk2(x[10], x[11]); p1.z = pk2(x[12], x[13]); p1.w = pk2(x[14], x[15]);
        const bf16x8 pb0 = __builtin_bit_cast(bf16x8, p0), pb1 = __builtin_bit_cast(bf16x8, p1);
#pragma unroll
        for (int et = 0; et < 4; ++et) {
            const LAS unsigned char* vp = lds + RET_VT + (32 * (4 * eh + et) + l32) * 272 + (32 * jt + 4 * hh) * 2;
            const s16x4 lo0 = *(const LAS s16x4*)(vp), hi0 = *(const LAS s16x4*)(vp + 16), lo1 = *(const LAS s16x4*)(vp + 32), hi1 = *(const LAS s16x4*)(vp + 48);
            O[et] = MFMA32(__builtin_shufflevector(lo0, hi0, 0, 1, 2, 3, 4, 5, 6, 7), pb0, O[et]);
            O[et] = MFMA32(__builtin_shufflevector(lo1, hi1, 0, 1, 2, 3, 4, 5, 6, 7), pb1, O[et]);
        }
    }
    float sm = 0.f, sq = 0.f;
#pragma unroll
    for (int et = 0; et < 4; ++et)
#pragma unroll
        for (int r = 0; r < 16; ++r) { const float t = O[et][r]; sm += t; sq += t * t; }
    sm += __shfl_xor(sm, 32); sq += __shfl_xor(sq, 32);
    LAS f32x2* red = (LAS f32x2*)(lds + RET_RED);
    if (hh == 0) red[w * 32 + l32] = (f32x2){sm, sq};
    const f32x4 gn = *(const f32x4*)(P.even_gn_g + h * 256 + 4 * lane);
    u32x2 gvr[16];
#pragma unroll
    for (int it = 0; it < 16; ++it) gvr[it] = *(const u32x2*)(gs + (R0 + w * 16 + it) * 1024 + h * 256 + 4 * lane);
    __syncthreads();
    { const f32x2 o = red[(w ^ 4) * 32 + l32]; sm += o.x; sq += o.y; }
    const float mean = sm * (1.0f / 256.0f);
    const float rstd = rsqrtf(fmaxf(sq * (1.0f / 256.0f) - mean * mean, 0.f) + 1e-6f);
#pragma unroll
    for (int et = 0; et < 4; ++et)
#pragma unroll
        for (int g = 0; g < 4; ++g) {
            u32x2 o; o.x = pk2((O[et][4 * g] - mean) * rstd, (O[et][4 * g + 1] - mean) * rstd); o.y = pk2((O[et][4 * g + 2] - mean) * rstd, (O[et][4 * g + 3] - mean) * rstd);
            *(LAS u32x2*)(lds + RET_VT + (32 * ib + l32) * 520 + (32 * (4 * eh + et) + 8 * g + 4 * hh) * 2) = o;
        }
    __syncthreads();
#pragma unroll
    for (int it = 0; it < 16; ++it) {
        const int i = w * 16 + it;
        const u32x2 val = *(const LAS u32x2*)(lds + RET_VT + i * 520 + lane * 8);
        const u32x2 gv = gvr[it];
        u32x2 o; o.x = pk2(bf_lo(val.x) * gn.x * bf_lo(gv.x), bf_hi(val.x) * gn.y * bf_hi(gv.x)); o.y = pk2(bf_lo(val.y) * gn.z * bf_lo(gv.y), bf_hi(val.y) * gn.w * bf_hi(gv.y));
        *(u32x2*)(mix + (R0 + i) * 2048 + h * 256 + 4 * lane) = o;
    }
    __syncthreads();
}

constexpr int AT_KS = 0, AT_VT = 9216, AT_FLAG = 18432, AT_OST = 18688;
template <int MASK>
__device__ __forceinline__ void sb_subtile(f32x16& x, float& C, int hh, int key0, int qidx, u32x4& p0, u32x4& p1) {
    f32x2 e2[2][4], d2[2][4];
#pragma unroll
    for (int gp = 0; gp < 2; ++gp)
#pragma unroll
        for (int j = 0; j < 4; ++j) {
            float ev[2];
#pragma unroll
            for (int c = 0; c < 2; ++c) {
                const int r = 4 * (2 * gp + c) + j;
                float t = fexp2(__builtin_amdgcn_fmed3f(x[r], -126.f, 30.f));
                if (MASK == 1) { const int key = key0 + crow(r, hh); t = (key < qidx) ? t : 0.f; }
                if (MASK == 2) { const int key = key0 + crow(r, hh); t = (key < qidx && key >= PADF) ? t : 0.f; }
                ev[c] = t;
            }
            e2[gp][j] = (f32x2){ev[0], ev[1]};
            d2[gp][j] = e2[gp][j] + 1.0f;
        }
    float pg[4], qg[4], T[4];
#pragma unroll
    for (int gp = 0; gp < 2; ++gp) {
        const f32x2 Q = (d2[gp][3] * d2[gp][2]) * (d2[gp][1] * d2[gp][0]);
        pg[2 * gp] = frcp(Q.x); pg[2 * gp + 1] = frcp(Q.y);
    }
#pragma unroll
    for (int g = 0; g < 4; ++g) qg[g] = __shfl_xor(pg[g], 32);
    T[3] = C; T[2] = T[3] * (pg[3] * qg[3]); T[1] = T[2] * (pg[2] * qg[2]); T[0] = T[1] * (pg[1] * qg[1]);
    C = T[0] * (pg[0] * qg[0]);
    f32x2 w2[2][4];
#pragma unroll
    for (int gp = 0; gp < 2; ++gp) {
        const f32x2 base = hh ? (f32x2){T[2 * gp], T[2 * gp + 1]} : (f32x2){T[2 * gp] * qg[2 * gp], T[2 * gp + 1] * qg[2 * gp + 1]};
        const f32x2 b0 = base * (f32x2){pg[2 * gp], pg[2 * gp + 1]};
        const f32x2 b1 = b0 * d2[gp][0], b2 = b1 * d2[gp][1], b3 = b2 * d2[gp][2];
        w2[gp][0] = e2[gp][0] * b0; w2[gp][1] = e2[gp][1] * b1; w2[gp][2] = e2[gp][2] * b2; w2[gp][3] = e2[gp][3] * b3;
    }
    p0.x = pk2(w2[0][0].x, w2[0][1].x); p0.y = pk2(w2[0][2].x, w2[0][3].x); p0.z = pk2(w2[0][0].y, w2[0][1].y); p0.w = pk2(w2[0][2].y, w2[0][3].y);
    p1.x = pk2(w2[1][0].x, w2[1][1].x); p1.y = pk2(w2[1][2].x, w2[1][3].x); p1.z = pk2(w2[1][0].y, w2[1][1].y); p1.w = pk2(w2[1][2].y, w2[1][3].y);
}

__device__ __forceinline__ void attn_item(CParams& P, LAS unsigned char* lds, int item, int tid) {
    const int lane = tid & 63, w = tid >> 6, l32 = lane & 31, hh = lane >> 5;
    int bh, qb;
    if (item < 1920) { bh = item / 15; qb = 1 + (item - bh * 15); } else if (item < 2048) { bh = item - 1920; qb = 16; } else { bh = item - 2048; qb = 0; }
    const int b = bh >> 4, h = bh & 15;
    const bf16_t* q = (const bf16_t*)(P.ws + WS_R0); const bf16_t* k = (const bf16_t*)(P.ws + WS_R0 + UNIT); const bf16_t* v = (const bf16_t*)(P.ws + WS_R1);
    bf16_t* ao = (bf16_t*)(P.ws + WS_R2);
    const size_t Rb = (size_t)b * PP;
    const int qrow0 = 256 * qb + 32 * w;
    const bool wvalid = qrow0 < PP;
    bf16x8 qf[4];
#pragma unroll
    for (int s = 0; s < 4; ++s) {
        if (wvalid) qf[s] = *(const bf16x8*)(q + (Rb + qrow0 + l32) * 1024 + h * 64 + 16 * s + 8 * hh);
        else qf[s] = (bf16x8){0, 0, 0, 0, 0, 0, 0, 0};
    }
    f32x16 O[2];
#pragma unroll
    for (int dt = 0; dt < 2; ++dt)
#pragma unroll
        for (int r = 0; r < 16; ++r) O[dt][r] = 0.f;
    float C = 1.0f; bool done = !wvalid;
    int T = 4 * qb + 3; if (T > 65) T = 65;
    const bool vrole = tid < 256;
    const int jp = tid & 31, dg = (tid >> 5) & 7;
    const int ku = tid & 255;
    u32x4 ra, rb;
    {
        const size_t kb = Rb + 64 * T;
        if (vrole) { ra = *(const u32x4*)(v + (kb + 2 * jp) * 1024 + h * 64 + dg * 8); rb = *(const u32x4*)(v + (kb + 2 * jp + 1) * 1024 + h * 64 + dg * 8); }
        else { ra = *(const u32x4*)(k + (kb + (ku >> 3)) * 1024 + h * 64 + (ku & 7) * 8); rb = *(const u32x4*)(k + (kb + 32 + (ku >> 3)) * 1024 + h * 64 + (ku & 7) * 8); }
    }
    volatile LAS unsigned* flags = (volatile LAS unsigned*)(lds + AT_FLAG);
#pragma unroll 1
    for (; T >= 1; --T) {
        __syncthreads();
        if (vrole) {
            if (T == 1) {
                if (jp < 24) { ra = (u32x4){0u, 0u, 0u, 0u}; rb = ra; }
                else {
                    const float* vr = (const float*)(P.ws + WS_VRAW) + (size_t)(2 * jp - 48) * 1024 + h * 64 + dg * 8;
                    const f32x4 a0 = *(const f32x4*)vr, a1 = *(const f32x4*)(vr + 4), b0 = *(const f32x4*)(vr + 1024), b1 = *(const f32x4*)(vr + 1028);
                    ra.x = pk2(a0.x, a0.y); ra.y = pk2(a0.z, a0.w); ra.z = pk2(a1.x, a1.y); ra.w = pk2(a1.z, a1.w);
                    rb.x = pk2(b0.x, b0.y); rb.y = pk2(b0.z, b0.w); rb.z = pk2(b1.x, b1.y); rb.w = pk2(b1.z, b1.w);
                }
            }
            LAS unsigned* d = (LAS unsigned*)(lds + AT_VT + (dg * 8) * 144 + jp * 4);
            d[0 * 36] = (ra.x & 0xffffu) | (rb.x << 16); d[1 * 36] = (ra.x >> 16) | (rb.x & 0xffff0000u);
            d[2 * 36] = (ra.y & 0xffffu) | (rb.y << 16); d[3 * 36] = (ra.y >> 16) | (rb.y & 0xffff0000u);
            d[4 * 36] = (ra.z & 0xffffu) | (rb.z << 16); d[5 * 36] = (ra.z >> 16) | (rb.z & 0xffff0000u);
            d[6 * 36] = (ra.w & 0xffffu) | (rb.w << 16); d[7 * 36] = (ra.w >> 16) | (rb.w & 0xffff0000u);
        } else {
            if (T == 1 && (ku >> 3) >= 16) {
                const int r = (ku >> 3) - 16;
                const f32x4 s4 = *(const f32x4*)((const float*)(P.ws + WS_KSS) + r * 64 + 4 * h);
                const float n = rsqrtf(((s4.x + s4.y) + (s4.z + s4.w)) * (1.0f / 64.0f) + 1e-6f);
                const float* kr = (const float*)(P.ws + WS_KRAW) + (size_t)r * 1024 + h * 64 + (ku & 7) * 8;
                const f32x4 a0 = *(const f32x4*)kr * n * *(const f32x4*)(P.odd_kn_g + (ku & 7) * 8), a1 = *(const f32x4*)(kr + 4) * n * *(const f32x4*)(P.odd_kn_g + (ku & 7) * 8 + 4);
                rb.x = pk2(a0.x, a0.y); rb.y = pk2(a0.z, a0.w); rb.z = pk2(a1.x, a1.y); rb.w = pk2(a1.z, a1.w);
            }
            *(LAS u32x4*)(lds + AT_KS + (ku >> 3) * 144 + (ku & 7) * 16) = ra;
            *(LAS u32x4*)(lds + AT_KS + (32 + (ku >> 3)) * 144 + (ku & 7) * 16) = rb;
        }
        if (lane == 0) flags[w] = done ? 1u : 0u;
        __syncthreads();
        const u32x4 f0 = *(const LAS u32x4*)(lds + AT_FLAG), f1 = *(const LAS u32x4*)(lds + AT_FLAG + 16);
        const unsigned alld = (f0.x & f0.y) & (f0.z & f0.w) & (f1.x & f1.y) & (f1.z & f1.w);
        if (alld) break;
        if (T > 1) {
            const size_t kb = Rb + 64 * (T - 1);
            if (vrole) { ra = *(const u32x4*)(v + (kb + 2 * jp) * 1024 + h * 64 + dg * 8); rb = *(const u32x4*)(v + (kb + 2 * jp + 1) * 1024 + h * 64 + dg * 8); }
            else { ra = *(const u32x4*)(k + (kb + (ku >> 3)) * 1024 + h * 64 + (ku & 7) * 8); rb = *(const u32x4*)(k + (kb + 32 + (ku >> 3)) * 1024 + h * 64 + (ku & 7) * 8); }
        }
        if (!done && 64 * T <= qrow0 + 30) {
            const bool needmask = (64 * T + 63 >= qrow0) || (T == 1);
#pragma unroll
            for (int st = 1; st >= 0; --st) {
                if (64 * T + 32 * st >= qrow0 + 31) continue;
                f32x16 x;
#pragma unroll
                for (int r = 0; r < 16; ++r) x[r] = 0.f;
#pragma unroll
                for (int s = 0; s < 4; ++s) {
                    const bf16x8 a = *(const LAS bf16x8*)(lds + AT_KS + (32 * st + l32) * 144 + (16 * s + 8 * hh) * 2);
                    x = MFMA32(a, qf[s], x);
                }
                u32x4 p0, p1;
                if (T == 1) sb_subtile<2>(x, C, hh, 64 * T + 32 * st, qrow0 + l32, p0, p1);
                else if (needmask) sb_subtile<1>(x, C, hh, 64 * T + 32 * st, qrow0 + l32, p0, p1);
                else sb_subtile<0>(x, C, hh, 0, 0, p0, p1);
                const bf16x8 pb0 = __builtin_bit_cast(bf16x8, p0), pb1 = __builtin_bit_cast(bf16x8, p1);
#pragma unroll
                for (int dt = 0; dt < 2; ++dt) {
                    const LAS unsigned char* vp = lds + AT_VT + (32 * dt + l32) * 144 + (32 * st + 4 * hh) * 2;
                    const s16x4 lo0 = *(const LAS s16x4*)(vp), hi0 = *(const LAS s16x4*)(vp + 16), lo1 = *(const LAS s16x4*)(vp + 32), hi1 = *(const LAS s16x4*)(vp + 48);
                    O[dt] = MFMA32(__builtin_shufflevector(lo0, hi0, 0, 1, 2, 3, 4, 5, 6, 7), pb0, O[dt]);
                    O[dt] = MFMA32(__builtin_shufflevector(lo1, hi1, 0, 1, 2, 3, 4, 5, 6, 7), pb1, O[dt]);
                }
            }
            done = (__ballot(C >= 1e-37f) == 0ull);
        }
    }
    LAS unsigned char* ost = lds + AT_OST + w * 4352;
#pragma unroll
    for (int dt = 0; dt < 2; ++dt)
#pragma unroll
        for (int g = 0; g < 4; ++g) {
            u32x2 o; o.x = pk2(O[dt][4 * g], O[dt][4 * g + 1]); o.y = pk2(O[dt][4 * g + 2], O[dt][4 * g + 3]);
            *(LAS u32x2*)(ost + l32 * 136 + (32 * dt + 8 * g + 4 * hh) * 2) = o;
        }
    LDS_WAIT();
    if (wvalid) {
#pragma unroll
        for (int it = 0; it < 8; ++it) {
            const int row = 4 * it + (lane >> 4), part = lane & 15;
            const u32x2 val = *(const LAS u32x2*)(ost + row * 136 + part * 8);
            *(u32x2*)(ao + (Rb + qrow0 + row) * 1024 + h * 64 + part * 4) = val;
        }
    }
    LDS_WAIT();
}

constexpr size_t WS_BAR = WS_HM2P + (size_t)16 * 1024 * 4;
#define XB_TMO      128
#define XB_XCNT(j)  (256  + 64 * (j))
#define XB_XSUB(j)  (1280 + 64 * (j))
#define XB_XGEN(j)  (2304 + 64 * (j))
#define XB_TOP      3328
#define XB_TOPGEN   3392
#define XCD_BAR_WORDS 3456
#define XB_SPIN_CAP (1u << 18)

__device__ __forceinline__ unsigned xb_ld(unsigned* p)              { return __hip_atomic_load(p, __ATOMIC_RELAXED, __HIP_MEMORY_SCOPE_AGENT); }
__device__ __forceinline__ unsigned xb_add(unsigned* p, unsigned v) { return __hip_atomic_fetch_add(p, v, __ATOMIC_RELAXED, __HIP_MEMORY_SCOPE_AGENT); }
__device__ __forceinline__ unsigned xb_xcc_id() { return (unsigned)__builtin_amdgcn_s_getreg((3 << 11) | 20) & 0xFu; }
#define XB_SPIN(cond, bar) do { unsigned _sp = 0; while (cond) { __builtin_amdgcn_s_sleep(1); \
    if ((++_sp & 255u) == 0u) { if (xb_ld(&(bar)[XB_TMO])) break; if (_sp > XB_SPIN_CAP) { atomicAdd(&(bar)[XB_TMO], 1u); break; } } } } while (0)

struct XcdBarrier {
    unsigned* bar; unsigned x;
    volatile LAS unsigned* st;
};

__device__ __forceinline__ XcdBarrier xcd_barrier_post(unsigned* bar, volatile LAS unsigned* st) {
    XcdBarrier b; b.bar = bar; b.x = xb_xcc_id(); b.st = st;
    if (threadIdx.x == 0) (void)xb_add(&bar[XB_XCNT(b.x)], 1u);
    return b;
}
__device__ __forceinline__ void xcd_barrier_complete(unsigned* bar, unsigned x, unsigned& nloc, unsigned& nx) {
    const unsigned G = gridDim.x * gridDim.y * gridDim.z;
    unsigned sum, cnt, mine, sp = 0u;
    for (;;) {
        sum = 0u; cnt = 0u; mine = 0u;
#pragma unroll
        for (unsigned j = 0; j < 16; ++j) { const unsigned c = xb_ld(&bar[XB_XCNT(j)]); sum += c; cnt += (c > 0u) ? 1u : 0u; mine = (j == x) ? c : mine; }
        if (sum == G) break;
        __builtin_amdgcn_s_sleep(1);
        if ((++sp & 255u) == 0u) { if (xb_ld(&bar[XB_TMO])) break; if (sp > XB_SPIN_CAP) { atomicAdd(&bar[XB_TMO], 1u); break; } }
    }
    nloc = mine > 0u ? mine : 1u; nx = cnt > 0u ? cnt : 1u;
}

__device__ __forceinline__ void xcd_barrier(const XcdBarrier& b) {
    asm volatile("s_waitcnt vmcnt(0)" ::: "memory");
    __syncthreads();
    if (threadIdx.x == 0) {
        unsigned* bar = b.bar;
        __builtin_amdgcn_s_waitcnt(0);
        unsigned nloc = b.st[0], nx = b.st[1];
        if (nloc == 0u) { xcd_barrier_complete(bar, b.x, nloc, nx); b.st[0] = nloc; b.st[1] = nx; }
        const unsigned old = xb_add(&bar[XB_XSUB(b.x)], 1u);
        const unsigned gen = old / nloc;
        if (old + 1u == (gen + 1u) * nloc) {
            __builtin_amdgcn_fence(__ATOMIC_RELEASE, "agent");
            asm volatile("s_waitcnt vmcnt(0)" ::: "memory");
            const unsigned og = xb_add(&bar[XB_TOP], 1u);
            const unsigned tg = og / nx;
            if (og + 1u == (tg + 1u) * nx) xb_add(&bar[XB_TOPGEN], 1u);
            else XB_SPIN(xb_ld(&bar[XB_TOPGEN]) == tg, bar);
            __builtin_amdgcn_fence(__ATOMIC_ACQUIRE, "agent");
            xb_add(&bar[XB_XGEN(b.x)], 1u);
            asm volatile("s_waitcnt vmcnt(0)" ::: "memory");
        } else {
            XB_SPIN(xb_ld(&bar[XB_XGEN(b.x)]) == gen, bar);
            __builtin_amdgcn_fence(__ATOMIC_ACQUIRE, "agent");
            asm volatile("s_waitcnt vmcnt(0)" ::: "memory");
        }
    }
    __syncthreads();
}

#define GEMM_PHASE(EPI, Aptr, Bptr, N_, K_, E_) do { pg8::Gemm g_{(const pg8::bf16_t*)(Aptr), (const pg8::bf16_t*)(Bptr), NB * SEQ, (N_), (K_)}; pg8::StaticOrder S_; S_.init(NB * SEQ, (N_), (int)gridDim.x, (int)blockIdx.x); \
    pg8::gemm_phase<EPI, pg8::StaticOrder, true, true>(lds, g_, S_, E_); } while (0)
#define META_TASKS(FN, NT) do { RETID(); for (int t_ = blockIdx.x; t_ < (NT); t_ += gridDim.x) FN(KP, lds, t_, tid); asm volatile("s_waitcnt vmcnt(0)" ::: "memory"); __syncthreads(); } while (0)

__global__ void __launch_bounds__(NTHR) mega_fwd(Params Punused) {
    extern __shared__ __attribute__((aligned(16))) unsigned char lds_raw[];
    LAS unsigned char* lds = (LAS unsigned char*)lds_raw;
    cg::grid_group grid = cg::this_grid();
    int tid = threadIdx.x;
#define RETID() do { tid = threadIdx.x; asm volatile("" : "+v"(tid)); } while (0)
#define ws (KP.ws)
#define ss1 ((float*)(ws + WS_SS) + (size_t)RP * 16)
#define ss2 ((float*)(ws + WS_SS) + (size_t)RP * 32)
#define ss3 ((float*)(ws + WS_SS) + (size_t)RP * 48)
    volatile LAS unsigned* bst = (volatile LAS unsigned*)(lds + 139264);
    if (tid < 2) bst[tid] = 0u;
#define GBAR() xcd_barrier(xbar)
    RETID();
    if (blockIdx.x == 0) for (int i = tid; i < XCD_BAR_WORDS; i += NTHR) ((volatile unsigned*)(ws + WS_BAR))[i] = 0u;
    phase0(KP, lds, tid);
    grid.sync();
    const XcdBarrier xbar = xcd_barrier_post((unsigned*)(ws + WS_BAR), bst);
    META_TASKS(meta_in, 320);
    { EpiIn E{(const float*)(ws + WS_SS), (bf16_t*)(ws + WS_R4), (bf16_t*)(ws + WS_R1), (bf16_t*)(ws + WS_R2), (bf16_t*)(ws + WS_R3)};
      GEMM_PHASE(EpiIn, ws + WS_R0, ws + WS_WIN, 5120, 1024, E); }
    GBAR();
    RETID();
    for (int it = blockIdx.x; it < 996 + 1025 + 4; it += gridDim.x) {
        if (it < 996) ret_partial_item(KP, lds, it, tid);
        else if (it == 996) conv_item<16>(KP, lds, 0, PADF, tid);
        else if (it < 996 + 1025) { const int ci = it - 997; conv_item<32>(KP, lds, ci >> 7, 128 + 32 * (ci & 127), tid); }
        else ret_out_item(KP, lds, it - (996 + 1025), tid);
    }
    GBAR();
    RETID();
    ret_scan(KP, tid);
    GBAR();
    RETID();
    for (int it = blockIdx.x; it < NB * 32 * 4; it += gridDim.x) ret_out_item(KP, lds, (it >> 7) * 132 + 4 + (it & 127), tid);
    GBAR();
    META_TASKS(meta_out, 256);
    { EpiRes E{KP.x, KP.out, (bf16_t*)(ws + WS_R4), ss1, 1};
      GEMM_PHASE(EpiRes, ws + WS_R0, ws + WS_WOUT, 1024, 2048, E); }
    GBAR();
    META_TASKS(meta_up, 256);
    { EpiUp E{ss1, (bf16_t*)(ws + WS_R0), (LAS float*)(lds + RS_TAB_OFF)}; GEMM_PHASE(EpiUp, ws + WS_R4, ws + WS_W1, 4096, 1024, E); }
    GBAR();
    META_TASKS(meta_down, 256);
    { EpiRes E{KP.out, KP.out, (bf16_t*)(ws + WS_R4), ss2, 1};
      GEMM_PHASE(EpiRes, ws + WS_R0, ws + WS_W2, 1024, 4096, E); }
    GBAR();
    META_TASKS(meta_kv, 128);
    { EpiQkv E{ss2, KP.odd_qn_g, KP.odd_kn_g, (bf16_t*)(ws + WS_R0), (LAS float*)(lds + RS_TAB_OFF)};
      GEMM_PHASE(EpiQkv, ws + WS_R4, ws + WS_WQKV, 3072, 1024, E); }
    GBAR();
    RETID();
    for (int it = blockIdx.x; it < NB * 16 * 17; it += gridDim.x) attn_item(KP, lds, it, tid);
    GBAR();
    { EpiRes E{KP.out, KP.out, (bf16_t*)(ws + WS_R4), ss3, 1};
      GEMM_PHASE(EpiRes, ws + WS_R2, ws + WS_WO, 1024, 1024, E); }
    GBAR();
    { EpiUp E{ss3, (bf16_t*)(ws + WS_R0), (LAS float*)(lds + RS_TAB_OFF)}; GEMM_PHASE(EpiUp, ws + WS_R4, ws + WS_W1 + (size_t)4096 * 1024 * 2, 4096, 1024, E); }
    GBAR();
    { EpiRes E{KP.out, KP.out, nullptr, nullptr, 0};
      GEMM_PHASE(EpiRes, ws + WS_R0, ws + WS_W2 + (size_t)4096 * 1024 * 2, 1024, 4096, E); }
#undef ws
#undef ss1
#undef ss2
#undef ss3
}

extern "C" void kernel_launch(void* const* d_in, const int* in_sizes, int n_in, void* d_out, int out_size, void* d_ws, size_t ws_size, hipStream_t stream) {
    static int grid_blocks = 0;
    if (grid_blocks == 0) {
        if (n_in != 17 || ws_size < WS_END) { fprintf(stderr, "kernel_launch: unexpected inputs (n_in %d, ws %zu, need %zu)\n", n_in, ws_size, (size_t)WS_END); grid_blocks = -1; return; }
        int dev = 0, cus = 0, per_cu = 0;
        (void)hipGetDevice(&dev);
        (void)hipDeviceGetAttribute(&cus, hipDeviceAttributeMultiprocessorCount, dev);
        if (hipFuncSetAttribute((const void*)mega_fwd, hipFuncAttributeMaxDynamicSharedMemorySize, LDS_BYTES) != hipSuccess) fprintf(stderr, "kernel_launch: hipFuncSetAttribute failed\n");
        if (hipOccupancyMaxActiveBlocksPerMultiprocessor(&per_cu, (const void*)mega_fwd, NTHR, LDS_BYTES) != hipSuccess || per_cu < 1) { fprintf(stderr, "kernel_launch: occupancy query gave %d; using 1\n", per_cu); per_cu = 1; }
        (void)hipGetLastError();
        if (cus <= 0) cus = 256;
        grid_blocks = cus * per_cu;
    }
    if (grid_blocks < 0) return;
    Params p{};
    const float** pp = (const float**)&p;
    for (int i = 0; i < 17; ++i) pp[i] = (const float*)d_in[i];
    p.out = (float*)d_out; p.ws = (unsigned char*)d_ws;
    void* args[] = {&p};
    hipError_t e = hipLaunchCooperativeKernel((const void*)mega_fwd, dim3(grid_blocks), dim3(NTHR), args, LDS_BYTES, stream);
    if (e != hipSuccess) fprintf(stderr, "cooperative launch failed: %s (grid %d)\n", hipGetErrorString(e), grid_blocks);
}
```

```cpp
#include <hip/hip_runtime.h>
#include <hip/hip_cooperative_groups.h>
#include <cstdio>
#include <cstdint>
namespace cg = cooperative_groups;
__host__ __device__ __forceinline__ int rowbase(int pm) { return (pm >> 4) * 4224 + 128 + (pm & 15) * 256; }
namespace pg8 {
#define PG8_LAS __attribute__((address_space(3)))
typedef unsigned short bf16_t;
typedef short bf16x8 __attribute__((ext_vector_type(8)));
typedef float f32x4 __attribute__((ext_vector_type(4)));
typedef unsigned u32x4 __attribute__((ext_vector_type(4)));
constexpr int BM = 256, BK = 64, HALF = 128, HTB = HALF * BK * 2  , STAGE_BYTES = 8 * HTB, NXCD = 8, WGM = 8;

__host__ __device__ __forceinline__ int lds_byte(int r, int c) { const int st = (r >> 4) * 2 + (c >> 5), rr = r & 15, cc = c & 31, ob = rr * 64 + cc * 2; return st * 1024 + (ob ^ (((ob >> 9) & 1) << 5)); }
__host__ __device__ __forceinline__ void stage_rc(int b, int& R, int& C) { const int st = b / 1024, sb = b % 1024, swz = sb ^ (((sb >> 9) & 1) << 5); R = (st >> 1) * 16 + swz / 64; C = (st & 1) * 32 + (swz % 64) / 2; }
__host__ __device__ __forceinline__ int perm32(int rho) { const int n = rho >> 4, i = rho & 15; return 8 * (i >> 2) + 4 * n + (i & 3); }

struct Unit { int pm, pn; };
struct Gemm { const bf16_t* A; const bf16_t* Bt; int M, N, K; };

struct StaticOrder {
    int nM, nN, nwg, G, c;
    __host__ __device__ void init(int M, int N, int G_, int c_) { nM = M / BM; nN = N / BM; nwg = nM * nN; G = G_; c = c_; }
    __host__ __device__ bool next(int i, Unit& u) const {
        const long L = (long)i * G + c; if (L >= nwg) return false;
        int wgid = (int)L; { const int q = nwg / NXCD, r = nwg % NXCD, xcd = wgid % NXCD, off = wgid / NXCD; wgid = (xcd < r ? xcd * (q + 1) : r * (q + 1) + (xcd - r) * q) + off; }
        const int nig = WGM * nN, gid = wgid / nig, fm = gid * WGM, gsz = (nM - fm) < WGM ? (nM - fm) : WGM;
        u.pm = fm + ((wgid % nig) % gsz); u.pn = (wgid % nig) / gsz; return true;
    }
    __device__ __forceinline__ void a_ready(const Unit&) const {}
    __device__ __forceinline__ void done(const Unit&) const {}
};

template <class Epi, class Sched, bool ALIGN_EPI = false, bool SP2 = false>
__device__ __forceinline__ void gemm_phase(PG8_LAS unsigned char* lds, const Gemm g, const Sched& S, const Epi& E) {
    int tid_l = threadIdx.x; asm volatile("" : "+v"(tid_l));
    const int tid = tid_l, wid = __builtin_amdgcn_readfirstlane(tid >> 6), lane = tid & 63, wr = wid >> 2, wc = wid & 3, fr = lane & 15, fq = lane >> 4;
    const int K = g.K, nt = K / BK;
    unsigned voffA[2], voffB[2];
#pragma unroll
    for (int i = 0; i < 2; ++i) { int R, C; stage_rc(tid * 16 + i * 8192, R, C); const int Rb = Epi::PERM ? ((R & ~31) + perm32(R & 31)) : R;
        voffA[i] = (unsigned)(R * K + C) * 2u; voffB[i] = (unsigned)(Rb * K + C) * 2u; }
    const size_t kstep = (size_t)(BK * 2);
    const size_t hstep = (size_t)HALF * K * 2;
    const size_t tstep = 2 * hstep;
    const unsigned ldsw = (unsigned)wid * 1024u;
    const int aoff = lds_byte(wr * 64 + fr, fq * 8), boff = lds_byte(wc * 32 + fr, fq * 8);
#define PG8_SA(b, h) (((b) * 2 + (h)) * HTB)
#define PG8_SB(b, h) ((4 + (b) * 2 + (h)) * HTB)
#define PG8_STAGE(bufoff, gbase, voff) do { _Pragma("unroll") for (int _i = 0; _i < 2; ++_i) \
        __builtin_amdgcn_global_load_lds((const unsigned*)((const char*)(gbase) + (voff)[_i]), (PG8_LAS unsigned*)(lds + (bufoff) + ldsw + _i * 8192), 16, 0, 0); } while (0)
#define PG8_LDA(dst, b, h) do { _Pragma("unroll") for (int m = 0; m < 4; ++m) _Pragma("unroll") for (int k = 0; k < 2; ++k) dst[m][k] = *(const PG8_LAS bf16x8*)(lds + PG8_SA(b, h) + aoff + m * 2048 + k * 1024); } while (0)
#define PG8_LDB(dst, b, h) do { _Pragma("unroll") for (int n = 0; n < 2; ++n) _Pragma("unroll") for (int k = 0; k < 2; ++k) dst[n][k] = *(const PG8_LAS bf16x8*)(lds + PG8_SB(b, h) + boff + n * 2048 + k * 1024); } while (0)
#define PG8_MMA(ai, bj, At, Bt) do { __builtin_amdgcn_s_setprio(1); _Pragma("unroll") for (int m = 0; m < 4; ++m) _Pragma("unroll") for (int n = 0; n < 2; ++n) _Pragma("unroll") for (int k = 0; k < 2; ++k) \
        acc[ai][bj][m][n] = __builtin_amdgcn_mfma_f32_16x16x32_bf16(Bt[n][k], At[m][k], acc[ai][bj][m][n], 0, 0, 0); __builtin_amdgcn_s_setprio(0); } while (0)
#define PG8_WAIT_V(n) asm volatile("s_waitcnt vmcnt(" #n ")" ::: "memory")
#define PG8_WAIT_L(n) asm volatile("s_waitcnt lgkmcnt(" #n ")" ::: "memory")
#define PG8_BAR __builtin_amdgcn_s_barrier()
#define PG8_SCHED __builtin_amdgcn_sched_barrier(0)
    Unit cur, nxt; int ui = 0;
    if (!S.next(0, cur)) return;
    f32x4 acc[2][2][4][2];
#pragma unroll
    for (int a = 0; a < 2; ++a)
#pragma unroll
        for (int b = 0; b < 2; ++b)
#pragma unroll
            for (int m = 0; m < 4; ++m)
#pragma unroll
                for (int n = 0; n < 2; ++n) acc[a][b][m][n] = (f32x4){0.f, 0.f, 0.f, 0.f};
    bf16x8 At[4][2], B0[2][2], B1[2][2];
    const char* cA = (const char*)g.A + (size_t)rowbase(cur.pm) * (size_t)(K * 2); const char* cB = (const char*)g.Bt + (size_t)cur.pn * tstep;
    S.a_ready(cur);
    if constexpr (SP2) {
        PG8_STAGE(PG8_SB(0, 0), cB, voffB); PG8_STAGE(PG8_SB(0, 1), cB + hstep, voffB); PG8_STAGE(PG8_SA(0, 0), cA, voffA); PG8_STAGE(PG8_SA(0, 1), cA + hstep, voffA);
        if (wr == 1) PG8_BAR;
        PG8_WAIT_V(2); PG8_BAR;
        PG8_STAGE(PG8_SB(1, 0), cB + kstep, voffB); PG8_STAGE(PG8_SA(1, 0), cA + kstep, voffA); PG8_STAGE(PG8_SB(1, 1), cB + hstep + kstep, voffB);
        PG8_WAIT_V(6); PG8_BAR;
    } else {
        PG8_STAGE(PG8_SB(0, 0), cB, voffB); PG8_STAGE(PG8_SA(0, 0), cA, voffA); PG8_STAGE(PG8_SB(0, 1), cB + hstep, voffB); PG8_STAGE(PG8_SA(0, 1), cA + hstep, voffA);
        if (wr == 1) PG8_BAR;
        PG8_WAIT_V(4); PG8_BAR;
        PG8_STAGE(PG8_SB(1, 0), cB + kstep, voffB); PG8_STAGE(PG8_SA(1, 0), cA + kstep, voffA); PG8_STAGE(PG8_SB(1, 1), cB + hstep + kstep, voffB);
        PG8_WAIT_V(6); PG8_BAR;
    }
    for (;;) {
        const bool has_next = S.next(ui + 1, nxt);
        const char* nA = has_next ? (const char*)g.A + (size_t)rowbase(nxt.pm) * (size_t)(K * 2) : cA; const char* nB = has_next ? (const char*)g.Bt + (size_t)nxt.pn * tstep : cB;
        for (int t = 0; t < nt; t += 2) {
            const bool last = (t == nt - 2);
            const char* a1 = cA + (size_t)(t + 1) * kstep;
            const char* a2 = last ? nA : cA + (size_t)(t + 2) * kstep; const char* b2 = last ? nB : cB + (size_t)(t + 2) * kstep;
            const char* a3 = a2 + kstep; const char* b3 = b2 + kstep;
            if (last && has_next) S.a_ready(nxt);
            if constexpr (SP2) {
            PG8_LDB(B0, 0, 0); PG8_LDB(B1, 0, 1); PG8_SCHED; PG8_LDA(At, 0, 0); PG8_STAGE(PG8_SA(1, 1), a1 + hstep, voffA);
            PG8_WAIT_V(8); PG8_WAIT_L(0); PG8_BAR; PG8_MMA(0, 0, At, B0); PG8_MMA(0, 1, At, B1); PG8_BAR; PG8_SCHED;
            PG8_LDA(At, 0, 1); PG8_STAGE(PG8_SB(0, 0), b2, voffB); PG8_STAGE(PG8_SB(0, 1), b2 + hstep, voffB); PG8_STAGE(PG8_SA(0, 0), a2, voffA);
            PG8_WAIT_V(8); PG8_WAIT_L(0); PG8_BAR; PG8_MMA(1, 0, At, B0); PG8_MMA(1, 1, At, B1); PG8_BAR; PG8_SCHED;
            PG8_LDB(B0, 1, 0); PG8_LDB(B1, 1, 1); PG8_SCHED; PG8_LDA(At, 1, 0); PG8_STAGE(PG8_SA(0, 1), a2 + hstep, voffA);
            PG8_WAIT_V(8); PG8_WAIT_L(0); PG8_BAR; PG8_MMA(0, 0, At, B0); PG8_MMA(0, 1, At, B1); PG8_BAR; PG8_SCHED;
            PG8_LDA(At, 1, 1); PG8_STAGE(PG8_SB(1, 0), b3, voffB); PG8_STAGE(PG8_SB(1, 1), b3 + hstep, voffB); PG8_STAGE(PG8_SA(1, 0), a3, voffA);
            PG8_WAIT_V(8); PG8_WAIT_L(0); PG8_BAR; PG8_MMA(1, 0, At, B0); PG8_MMA(1, 1, At, B1); PG8_BAR; PG8_SCHED;
            } else {
            PG8_LDB(B0, 0, 0); PG8_SCHED; PG8_LDA(At, 0, 0); PG8_STAGE(PG8_SA(1, 1), a1 + hstep, voffA);
            PG8_WAIT_L(8); PG8_BAR; PG8_WAIT_L(0); PG8_MMA(0, 0, At, B0); PG8_BAR; PG8_SCHED;
            PG8_LDB(B1, 0, 1); PG8_STAGE(PG8_SB(0, 0), b2, voffB);
            PG8_BAR; PG8_WAIT_L(0); PG8_MMA(0, 1, At, B1); PG8_BAR;
            PG8_LDA(At, 0, 1); PG8_STAGE(PG8_SA(0, 0), a2, voffA);
            PG8_BAR; PG8_WAIT_L(0); PG8_MMA(1, 0, At, B0); PG8_BAR; PG8_SCHED;
            PG8_STAGE(PG8_SB(0, 1), b2 + hstep, voffB);
            PG8_WAIT_V(6); PG8_BAR; PG8_MMA(1, 1, At, B1); PG8_BAR;
            PG8_LDB(B0, 1, 0); PG8_SCHED; PG8_LDA(At, 1, 0); PG8_STAGE(PG8_SA(0, 1), a2 + hstep, voffA);
            PG8_WAIT_L(8); PG8_BAR; PG8_WAIT_L(0); PG8_MMA(0, 0, At, B0); PG8_BAR; PG8_SCHED;
            PG8_LDB(B1, 1, 1); PG8_STAGE(PG8_SB(1, 0), b3, voffB);
            PG8_BAR; PG8_WAIT_L(0); PG8_MMA(0, 1, At, B1); PG8_BAR;
            PG8_LDA(At, 1, 1); PG8_STAGE(PG8_SA(1, 0), a3, voffA);
            PG8_BAR; PG8_WAIT_L(0); PG8_MMA(1, 0, At, B0); PG8_BAR; PG8_SCHED;
            PG8_STAGE(PG8_SB(1, 1), b3 + hstep, voffB);
            PG8_WAIT_V(6); PG8_BAR; PG8_MMA(1, 1, At, B1); PG8_BAR;
            }
        }
        if constexpr (ALIGN_EPI) { if (wr == 0) PG8_BAR; }
        if constexpr (!Epi::AFTER_DRAIN) { E(acc, cur, wr, wc, fr, fq); S.done(cur); }
        if (!has_next) break;
#pragma unroll
        for (int a = 0; a < 2; ++a)
#pragma unroll
            for (int b = 0; b < 2; ++b)
#pragma unroll
                for (int m = 0; m < 4; ++m)
#pragma unroll
                    for (int n = 0; n < 2; ++n) acc[a][b][m][n] = (f32x4){0.f, 0.f, 0.f, 0.f};
        cur = nxt; cA = nA; cB = nB; ++ui;
        if constexpr (ALIGN_EPI) { if (wr == 1) PG8_BAR; }
    }
    PG8_WAIT_V(0);
    if constexpr (!ALIGN_EPI) { if (wr == 0) PG8_BAR; }
    PG8_BAR;
    if constexpr (Epi::AFTER_DRAIN) { E.fused(acc, cur, wr, wc, fr, fq, lds, wid, lane); S.done(cur); }
#undef PG8_SA
#undef PG8_SB
#undef PG8_STAGE
#undef PG8_LDA
#undef PG8_LDB
#undef PG8_MMA
#undef PG8_WAIT_V
#undef PG8_WAIT_L
#undef PG8_BAR
#undef PG8_SCHED
}
}

#define LAS __attribute__((address_space(3)))
typedef unsigned short bf16_t;
typedef short bf16x8 __attribute__((ext_vector_type(8)));
typedef short s16x4 __attribute__((ext_vector_type(4)));
typedef float f32x2 __attribute__((ext_vector_type(2)));
typedef float f32x4 __attribute__((ext_vector_type(4)));
typedef float f32x16 __attribute__((ext_vector_type(16)));
typedef unsigned u32x2 __attribute__((ext_vector_type(2)));
typedef unsigned u32x4 __attribute__((ext_vector_type(4)));
typedef __bf16 bf16x2v __attribute__((ext_vector_type(2)));

constexpr int DM = 1024, NB = 8, SEQ = 4096, NMETA = 16, PADF = 112, PP = 4224, RP = NB * PP, DFF = 4096;
constexpr int NTHR = 512;
constexpr int LDS_BYTES = 147456;
constexpr size_t UNIT = (size_t)RP * 1024 * 2;
constexpr size_t WS_R0 = 0, WS_R1 = 2 * UNIT, WS_R2 = 3 * UNIT, WS_R3 = 4 * UNIT, WS_R4 = 5 * UNIT;
constexpr size_t WS_WIN = 6 * UNIT;
constexpr size_t WS_WOUT = WS_WIN + (size_t)5120 * 1024 * 2;
constexpr size_t WS_W1 = WS_WOUT + (size_t)1024 * 2048 * 2;
constexpr size_t WS_W2 = WS_W1 + 2 * (size_t)4096 * 1024 * 2;
constexpr size_t WS_WQKV = WS_W2 + 2 * (size_t)4096 * 1024 * 2;
constexpr size_t WS_WO = WS_WQKV + (size_t)3072 * 1024 * 2;
constexpr size_t WS_ROPE = WS_WO + (size_t)1024 * 1024 * 2;
constexpr size_t WS_SS = WS_ROPE + (size_t)PP * 64 * 8;
constexpr size_t SS_BYTES = (size_t)RP * 16 * 4;
constexpr size_t WS_METAH = WS_SS + 4 * SS_BYTES;
constexpr size_t WS_HM1 = WS_METAH;
constexpr size_t WS_HIDM = WS_HM1 + (size_t)16 * 1024 * 4;
constexpr size_t WS_HM2P = WS_HIDM + (size_t)16 * 4096 * 4;
constexpr size_t WS_END = WS_HM2P + (size_t)4 * 16 * 1024 * 4 + 16384;

__device__ __forceinline__ unsigned pk2(float a, float b) { f32x2 v = {a, b}; bf16x2v r = __builtin_convertvector(v, bf16x2v); return __builtin_bit_cast(unsigned, r); }
__device__ __forceinline__ float bf_lo(unsigned u) { return __uint_as_float(u << 16); }
__device__ __forceinline__ float bf_hi(unsigned u) { return __uint_as_float(u & 0xffff0000u); }
__device__ __forceinline__ float wave_sum(float v) {
#pragma unroll
    for (int o = 1; o < 64; o <<= 1) v += __shfl_xor(v, o);
    return v;
}
__device__ __forceinline__ float rs_of(const float* ssp, int row) {
    const f32x4* s = (const f32x4*)(ssp + (size_t)row * 16);
    const f32x4 a = (s[0] + s[1]) + (s[2] + s[3]);
    return rsqrtf(((a.x + a.y) + (a.z + a.w)) * (1.0f / 1024.0f) + 1e-6f);
}
__device__ __forceinline__ float lg2gamma(int h) { return h == 0 ? -0.04580368961312479f : h == 1 ? -0.02272007650008353f : h == 2 ? -0.011315313227834146f : -0.005646563141142063f; }
__device__ __forceinline__ float fexp2(float x) { return __builtin_amdgcn_exp2f(x); }
__device__ __forceinline__ float frcp(float x) { return __builtin_amdgcn_rcpf(x); }
__device__ __forceinline__ float sigmoidf_(float x) { return frcp(1.0f + fexp2(-1.4426950408889634f * x)); }
__device__ __forceinline__ int crow(int r, int h) { return (r & 3) + 8 * (r >> 2) + 4 * h; }
#define MFMA32(a, b, c) __builtin_amdgcn_mfma_f32_32x32x16_bf16((a), (b), (c), 0, 0, 0)
#define LDS_WAIT() asm volatile("s_waitcnt lgkmcnt(0)" ::: "memory")

__device__ __forceinline__ int l2p_in(int c) {
    if (c < 1024) { const int blk = c >> 9, cc = c & 511, head = cc >> 7, dd = cc & 127, n = dd >> 6, rem = dd & 63, wc = rem >> 4, fq = (rem >> 2) & 3, i = rem & 3;
        return blk * 512 + (head >> 1) * 256 + (head & 1) * 128 + wc * 32 + fq * 8 + n * 4 + i; }
    if (c < 3072) return c;
    const int cu = c - 3072, n = cu >> 10, ch = cu & 1023, pu = ch >> 7, r = ch & 127, bj = r >> 6, r2 = r & 63, wc = r2 >> 4, fq = (r2 >> 2) & 3, i = r2 & 3;
    return 3072 + pu * 256 + bj * 128 + wc * 32 + fq * 8 + n * 4 + i;
}
__device__ __forceinline__ int l2p_qkv(int c) {
    const int blk = c >> 10, cc = c & 1023, head = cc >> 6, d = cc & 63, pnp = head >> 2, wc = head & 3, bj = d >> 5, fq = (d >> 3) & 3, n = (d >> 2) & 1, i = d & 3;
    return blk * 1024 + pnp * 256 + bj * 128 + wc * 32 + fq * 8 + n * 4 + i;
}

typedef f32x4 AccT[2][2][4][2];

constexpr int RS_TAB_OFF = 140288;
struct RsIssue { f32x4 a0, a1; int row, half; };
__device__ __forceinline__ RsIssue rs_tab_issue(const float* ssp, int rb, int wr, int wc, int fr, int fq) {
    RsIssue r; const int t = (wr * 4 + wc) * 64 + fq * 16 + fr; r.row = t >> 1; r.half = t & 1;
    const f32x4* sp = (const f32x4*)(ssp + (size_t)(rb + r.row) * 16 + r.half * 8);
    r.a0 = sp[0]; r.a1 = sp[1]; return r;
}
__device__ __forceinline__ void rs_tab_finish(const RsIssue& r, LAS float* tab) {
    const f32x4 a = r.a0 + r.a1;
    float sum = (a.x + a.y) + (a.z + a.w);
    sum += __shfl_xor(sum, 1);
    if (!r.half) tab[r.row] = rsqrtf(sum * (1.0f / 1024.0f) + 1e-6f);
    asm volatile("s_waitcnt lgkmcnt(0)" ::: "memory"); __builtin_amdgcn_s_barrier(); asm volatile("" ::: "memory");
}

struct EpiIn {
    static constexpr bool PERM = true, AFTER_DRAIN = false;
    const float* rsv; bf16_t *qk, *v, *gs, *hdn;
    __device__ __forceinline__ void operator()(const AccT& acc, const pg8::Unit& u, int wr, int wc, int fr, int fq) const {
        const int pn = u.pn, rb = rowbase(u.pm), pb = 128 + (u.pm & 15) * 256;
        float rsr[2][4];
#pragma unroll
        for (int ai = 0; ai < 2; ++ai)
#pragma unroll
            for (int m = 0; m < 4; ++m) rsr[ai][m] = rsv[rb + ai * 128 + wr * 64 + m * 16 + fr];
        float invf[4];
#pragma unroll
        for (int i = 0; i < 4; ++i) invf[i] = exp2f(-(float)(16 * wc + 4 * fq + i) * 0.20762050593046014f);
#pragma unroll
        for (int ai = 0; ai < 2; ++ai)
#pragma unroll
            for (int m = 0; m < 4; ++m) {
                const int loc = ai * 128 + wr * 64 + m * 16 + fr;
                const int row = rb + loc, p = pb + loc;
                const float rs = rsr[ai][m];
                if (pn < 4) {
                    float cs[4], sn[4];
#pragma unroll
                    for (int i = 0; i < 4; ++i) {
                        const float ang = (float)p * invf[i];
                        const float nrev = rintf(ang * 0.15915493667125702f);
                        float r = fmaf(ang, 0.15915493667125702f, -nrev); r = fmaf(ang, 6.4206382432985265e-09f, r);
                        cs[i] = __builtin_amdgcn_cosf(r); sn[i] = __builtin_amdgcn_sinf(r);
                    }
                    const float ip1 = (float)((p & 127) + 1);
#pragma unroll
                    for (int bj = 0; bj < 2; ++bj) {
                        const int head = 2 * (pn & 1) + bj;
                        const float lg = lg2gamma(head);
                        const float fac = (pn < 2) ? fexp2(ip1 * lg) : fexp2(-ip1 * lg) * 0.08838834764831845f;
                        const f32x4 x1 = acc[ai][bj][m][0] * rs, x2 = acc[ai][bj][m][1] * rs;
                        float y1[4], y2[4];
#pragma unroll
                        for (int i = 0; i < 4; ++i) { y1[i] = (x1[i] * cs[i] - x2[i] * sn[i]) * fac; y2[i] = (x1[i] * sn[i] + x2[i] * cs[i]) * fac; }
                        u32x4 w; w.x = pk2(y1[0], y1[1]); w.y = pk2(y1[2], y1[3]); w.z = pk2(y2[0], y2[1]); w.w = pk2(y2[2], y2[3]);
                        *(u32x4*)(qk + (size_t)row * 1024 + 256 * pn + 128 * bj + 32 * wc + 8 * fq) = w;
                    }
                } else if (pn < 8) {
#pragma unroll
                    for (int bj = 0; bj < 2; ++bj) {
                        const f32x4 a = acc[ai][bj][m][0] * rs, b = acc[ai][bj][m][1] * rs;
                        u32x4 w; w.x = pk2(a[0], a[1]); w.y = pk2(a[2], a[3]); w.z = pk2(b[0], b[1]); w.w = pk2(b[2], b[3]);
                        *(u32x4*)(v + (size_t)row * 1024 + 256 * (pn - 4) + 128 * bj + 32 * wc + 8 * fq) = w;
                    }
                } else if (pn < 12) {
#pragma unroll
                    for (int bj = 0; bj < 2; ++bj) {
                        f32x4 a = acc[ai][bj][m][0] * rs, b = acc[ai][bj][m][1] * rs;
#pragma unroll
                        for (int i = 0; i < 4; ++i) { a[i] = a[i] * sigmoidf_(a[i]); b[i] = b[i] * sigmoidf_(b[i]); }
                        u32x4 w; w.x = pk2(a[0], a[1]); w.y = pk2(a[2], a[3]); w.z = pk2(b[0], b[1]); w.w = pk2(b[2], b[3]);
                        *(u32x4*)(gs + (size_t)row * 1024 + 256 * (pn - 8) + 128 * bj + 32 * wc + 8 * fq) = w;
                    }
                } else {
#pragma unroll
                    for (int bj = 0; bj < 2; ++bj) {
                        const f32x4 a = acc[ai][bj][m][0] * rs, g = acc[ai][bj][m][1] * rs;
                        float o[4];
#pragma unroll
                        for (int i = 0; i < 4; ++i) o[i] = a[i] * sigmoidf_(g[i]);
                        u32x2 w; w.x = pk2(o[0], o[1]); w.y = pk2(o[2], o[3]);
                        *(u32x2*)(hdn + (size_t)row * 1024 + 128 * (pn - 12) + 64 * bj + 16 * wc + 4 * fq) = w;
                    }
                }
            }
    }
};

template <bool BASE_F32, bool OUT_F32>
struct EpiRes {
    static constexpr bool PERM = true, AFTER_DRAIN = false;
    const float* bx; float* ox; bf16_t* hb; float* ssp;
    __device__ __forceinline__ void operator()(const AccT& acc, const pg8::Unit& u, int wr, int wc, int fr, int fq) const {
        const int col0 = u.pn * 256 + wc * 32 + 8 * fq, rb = rowbase(u.pm);
        if (BASE_F32) {
#pragma unroll
            for (int ai = 0; ai < 2; ++ai) {
                f32x4 base[4][2][2];
#pragma unroll
                for (int m = 0; m < 4; ++m) { const size_t off = (size_t)(u.pm * 256 + ai * 128 + wr * 64 + m * 16 + fr) * DM;
#pragma unroll
                    for (int bj = 0; bj < 2; ++bj) { base[m][bj][0] = *(const f32x4*)(bx + off + col0 + 128 * bj); base[m][bj][1] = *(const f32x4*)(bx + off + col0 + 128 * bj + 4); } }
#pragma unroll
                for (int m = 0; m < 4; ++m) {
                    const int row = rb + ai * 128 + wr * 64 + m * 16 + fr;
                    float ss = 0.f;
#pragma unroll
                    for (int bj = 0; bj < 2; ++bj) {
                        const f32x4 h0 = base[m][bj][0] + acc[ai][bj][m][0], h1 = base[m][bj][1] + acc[ai][bj][m][1];
                        ss += (h0[0] * h0[0] + h0[1] * h0[1]) + (h0[2] * h0[2] + h0[3] * h0[3]) + (h1[0] * h1[0] + h1[1] * h1[1]) + (h1[2] * h1[2] + h1[3] * h1[3]);
                        u32x4 w; w.x = pk2(h0[0], h0[1]); w.y = pk2(h0[2], h0[3]); w.z = pk2(h1[0], h1[1]); w.w = pk2(h1[2], h1[3]);
                        *(u32x4*)(hb + (size_t)row * 1024 + col0 + 128 * bj) = w;
                    }
                    ss += __shfl_xor(ss, 16); ss += __shfl_xor(ss, 32);
                    if (fq == 0) ssp[(size_t)row * 16 + u.pn * 4 + wc] = ss;
                }
            }
        } else {
            u32x4 base[2][4][2];
#pragma unroll
            for (int ai = 0; ai < 2; ++ai)
#pragma unroll
                for (int m = 0; m < 4; ++m) { const int row = rb + ai * 128 + wr * 64 + m * 16 + fr;
#pragma unroll
                    for (int bj = 0; bj < 2; ++bj) base[ai][m][bj] = *(const u32x4*)(hb + (size_t)row * 1024 + col0 + 128 * bj); }
#pragma unroll
            for (int ai = 0; ai < 2; ++ai)
#pragma unroll
                for (int m = 0; m < 4; ++m) {
                    const int loc = ai * 128 + wr * 64 + m * 16 + fr, row = rb + loc;
                    const size_t off = (size_t)(u.pm * 256 + loc) * DM;
                    float ss = 0.f;
#pragma unroll
                    for (int bj = 0; bj < 2; ++bj) {
                        const u32x4 bv = base[ai][m][bj];
                        const f32x4 h0 = (f32x4){bf_lo(bv.x), bf_hi(bv.x), bf_lo(bv.y), bf_hi(bv.y)} + acc[ai][bj][m][0];
                        const f32x4 h1 = (f32x4){bf_lo(bv.z), bf_hi(bv.z), bf_lo(bv.w), bf_hi(bv.w)} + acc[ai][bj][m][1];
                        if (OUT_F32) {
                            *(f32x4*)(ox + off + col0 + 128 * bj) = h0;
                            *(f32x4*)(ox + off + col0 + 128 * bj + 4) = h1;
                        } else {
                            ss += (h0[0] * h0[0] + h0[1] * h0[1]) + (h0[2] * h0[2] + h0[3] * h0[3]) + (h1[0] * h1[0] + h1[1] * h1[1]) + (h1[2] * h1[2] + h1[3] * h1[3]);
                            u32x4 w; w.x = pk2(h0[0], h0[1]); w.y = pk2(h0[2], h0[3]); w.z = pk2(h1[0], h1[1]); w.w = pk2(h1[2], h1[3]);
                            *(u32x4*)(hb + (size_t)row * 1024 + col0 + 128 * bj) = w;
                        }
                    }
                    if (!OUT_F32) {
                        ss += __shfl_xor(ss, 16); ss += __shfl_xor(ss, 32);
                        if (fq == 0) ssp[(size_t)row * 16 + u.pn * 4 + wc] = ss;
                    }
                }
        }
    }
};

struct EpiUp {
    static constexpr bool PERM = true, AFTER_DRAIN = false;
    const float* ssp; bf16_t* hid; LAS float* tab;
    __device__ __forceinline__ void operator()(const AccT& acc_, const pg8::Unit& u, int wr, int wc, int fr, int fq) const {
        AccT& acc = const_cast<AccT&>(acc_);
        const int col0 = u.pn * 256 + wc * 32 + 8 * fq, rb = rowbase(u.pm);
        const RsIssue ri = rs_tab_issue(ssp, rb, wr, wc, fr, fq);
#pragma unroll
        for (int ai = 0; ai < 2; ++ai)
#pragma unroll
            for (int bj = 0; bj < 2; ++bj)
#pragma unroll
                for (int m = 0; m < 4; ++m)
#pragma unroll
                    for (int n = 0; n < 2; ++n) { f32x4 t = acc[ai][bj][m][n];
#pragma unroll
                        for (int i = 0; i < 4; ++i) t[i] = fmaxf(t[i], 0.f);
                        acc[ai][bj][m][n] = t * t; }
        rs_tab_finish(ri, tab);
#pragma unroll
        for (int ai = 0; ai < 2; ++ai)
#pragma unroll
            for (int m = 0; m < 4; ++m) {
                const int loc = ai * 128 + wr * 64 + m * 16 + fr, row = rb + loc;
                const float rs = tab[loc], rs2 = rs * rs;
#pragma unroll
                for (int bj = 0; bj < 2; ++bj) {
                    const f32x4 a = acc[ai][bj][m][0] * rs2, b = acc[ai][bj][m][1] * rs2;
                    u32x4 w; w.x = pk2(a[0], a[1]); w.y = pk2(a[2], a[3]); w.z = pk2(b[0], b[1]); w.w = pk2(b[2], b[3]);
                    *(u32x4*)(hid + (size_t)row * DFF + col0 + 128 * bj) = w;
                }
            }
    }
};

struct EpiQkv {
    static constexpr bool PERM = true, AFTER_DRAIN = false;
    const float* ssp; const float* qg; const float* kg; bf16_t* qkv; LAS float* tab;
    __device__ __forceinline__ void operator()(const AccT& acc, const pg8::Unit& u, int wr, int wc, int fr, int fq) const {
        const int blk = u.pn >> 2, head = 4 * (u.pn & 3) + wc, rb = rowbase(u.pm);
        bf16_t* dst = qkv + (size_t)blk * (UNIT / 2);
        const float* gg = blk == 0 ? qg : kg;
        const f32x4 g00 = *(const f32x4*)(gg + 8 * fq), g01 = *(const f32x4*)(gg + 8 * fq + 4), g10 = *(const f32x4*)(gg + 32 + 8 * fq), g11 = *(const f32x4*)(gg + 32 + 8 * fq + 4);
        const RsIssue ri = rs_tab_issue(ssp, rb, wr, wc, fr, fq);
        float ssr[2][4];
#pragma unroll
        for (int ai = 0; ai < 2; ++ai)
#pragma unroll
            for (int m = 0; m < 4; ++m) {
                const f32x4 t = acc[ai][0][m][0] * acc[ai][0][m][0] + acc[ai][0][m][1] * acc[ai][0][m][1] + acc[ai][1][m][0] * acc[ai][1][m][0] + acc[ai][1][m][1] * acc[ai][1][m][1];
                float ss = (t[0] + t[1]) + (t[2] + t[3]);
                ss += __shfl_xor(ss, 16); ss += __shfl_xor(ss, 32);
                ssr[ai][m] = ss;
            }
        rs_tab_finish(ri, tab);
        const float post = blk == 0 ? 0.18033688011112042f : 1.0f;
#pragma unroll
        for (int ai = 0; ai < 2; ++ai)
#pragma unroll
            for (int m = 0; m < 4; ++m) {
                const int loc = ai * 128 + wr * 64 + m * 16 + fr, row = rb + loc;
                const float rs = tab[loc];
                f32x4 v00 = acc[ai][0][m][0], v01 = acc[ai][0][m][1], v10 = acc[ai][1][m][0], v11 = acc[ai][1][m][1];
                if (blk < 2) {
                    const float sc = rs * rsqrtf(rs * rs * ssr[ai][m] * (1.0f / 64.0f) + 1e-6f) * post;
                    v00 = v00 * sc * g00; v01 = v01 * sc * g01; v10 = v10 * sc * g10; v11 = v11 * sc * g11;
                } else { v00 = v00 * rs; v01 = v01 * rs; v10 = v10 * rs; v11 = v11 * rs; }
                u32x4 w0, w1;
                w0.x = pk2(v00[0], v00[1]); w0.y = pk2(v00[2], v00[3]); w0.z = pk2(v01[0], v01[1]); w0.w = pk2(v01[2], v01[3]);
                w1.x = pk2(v10[0], v10[1]); w1.y = pk2(v10[2], v10[3]); w1.z = pk2(v11[0], v11[1]); w1.w = pk2(v11[2], v11[3]);
                *(u32x4*)(dst + (size_t)row * 1024 + head * 64 + 8 * fq) = w0;
                *(u32x4*)(dst + (size_t)row * 1024 + head * 64 + 32 + 8 * fq) = w1;
            }
    }
};

struct Params {
    const float *x, *meta, *norm_mix_g, *norm_mlp_g, *even_w_in, *even_gn_g, *even_conv_w, *even_conv_b, *even_ln_g, *even_ln_b, *even_w_out,
        *odd_w_qkv, *odd_qn_g, *odd_kn_g, *odd_w_o, *mlp_w1, *mlp_w2;
    float* out; unsigned char* ws;
};
typedef const __attribute__((address_space(4))) Params CParams;
__device__ __forceinline__ CParams* kparams() { CParams* kp = (CParams*)__builtin_amdgcn_kernarg_segment_ptr(); asm volatile("" : "+s"(kp)); return kp; }
#define KP (*kparams())

template <int MODE>
__device__ __forceinline__ void p0_transpose_item(const float* W, int K, int N, bf16_t* WT, const float* gain, LAS float* scr, int item, int lane) {
    const int nblk = N / 32, kb = item / nblk, nb = item % nblk, k0 = 64 * kb, n0 = 32 * nb;
    float wv[32];
#pragma unroll
    for (int i = 0; i < 32; ++i) wv[i] = W[(size_t)(k0 + 2 * i + (lane >> 5)) * N + n0 + (lane & 31)];
#pragma unroll
    for (int i = 0; i < 32; ++i) { const int kk = 2 * i + (lane >> 5); float w = wv[i]; if (gain) w *= gain[k0 + kk]; scr[kk * 33 + (lane & 31)] = w; }
    LDS_WAIT();
    const int c = lane & 7;
#pragma unroll
    for (int j = 0; j < 4; ++j) { const int n = (lane >> 3) + 8 * j; const LAS float* s = scr + (8 * c) * 33 + n;
        const int lc = n0 + n; const int prow = MODE == 1 ? l2p_in(lc) : (MODE == 2 ? l2p_qkv(lc) : lc);
        u32x4 o; o.x = pk2(s[0 * 33], s[1 * 33]); o.y = pk2(s[2 * 33], s[3 * 33]); o.z = pk2(s[4 * 33], s[5 * 33]); o.w = pk2(s[6 * 33], s[7 * 33]);
        *(u32x4*)(WT + (size_t)prow * K + k0 + 8 * c) = o; }
    LDS_WAIT();
}

__device__ __forceinline__ void phase0(CParams& P, LAS unsigned char* lds, int tid) {
    const int lane = tid & 63, wave = tid >> 6;
    const int gw = blockIdx.x * 8 + wave, NGW = gridDim.x * 8;
    LAS float* scr = (LAS float*)(lds + wave * 16384);
    unsigned char* ws = P.ws;
    constexpr int I_IN = 16 * 160, I_OUT = 32 * 32, I_W1 = 16 * 128, I_W2 = 64 * 32, I_QKV = 16 * 96, I_O = 16 * 32;
    constexpr int NITEMS = I_IN + I_OUT + 2 * I_W1 + 2 * I_W2 + I_QKV + I_O;
    for (int it = gw; it < NITEMS; it += NGW) {
        int r = it;
        if (r < I_IN) { p0_transpose_item<1>(P.even_w_in, 1024, 5120, (bf16_t*)(ws + WS_WIN), P.norm_mix_g, scr, r, lane); continue; } r -= I_IN;
        if (r < I_OUT) { p0_transpose_item<0>(P.even_w_out, 2048, 1024, (bf16_t*)(ws + WS_WOUT), nullptr, scr, r, lane); continue; } r -= I_OUT;
        if (r < I_W1) { p0_transpose_item<0>(P.mlp_w1, 1024, 4096, (bf16_t*)(ws + WS_W1), P.norm_mlp_g, scr, r, lane); continue; } r -= I_W1;
        if (r < I_W1) { p0_transpose_item<0>(P.mlp_w1 + (size_t)1024 * 4096, 1024, 4096, (bf16_t*)(ws + WS_W1) + (size_t)4096 * 1024, P.norm_mlp_g + 1024, scr, r, lane); continue; } r -= I_W1;
        if (r < I_W2) { p0_transpose_item<0>(P.mlp_w2, 4096, 1024, (bf16_t*)(ws + WS_W2), nullptr, scr, r, lane); continue; } r -= I_W2;
        if (r < I_W2) { p0_transpose_item<0>(P.mlp_w2 + (size_t)1024 * 4096, 4096, 1024, (bf16_t*)(ws + WS_W2) + (size_t)4096 * 1024, nullptr, scr, r, lane); continue; } r -= I_W2;
        if (r < I_QKV) { p0_transpose_item<2>(P.odd_w_qkv, 1024, 3072, (bf16_t*)(ws + WS_WQKV), P.norm_mix_g + 1024, scr, r, lane); continue; } r -= I_QKV;
        p0_transpose_item<0>(P.odd_w_o, 1024, 1024, (bf16_t*)(ws + WS_WO), nullptr, scr, r, lane);
    }
    float* rope = (float*)(ws + WS_ROPE);
    for (int i = blockIdx.x * NTHR + tid; i < PP * 64; i += gridDim.x * NTHR) {
        const int p = i >> 6, d = i & 63;
        const float inv = exp2f(-(float)d * 0.20762050593046014f);
        const float ang = (float)p * inv;
        double t = (double)ang * 0.15915494309189535; t -= floor(t);
        const float tf = (float)t;
        rope[2 * i] = __builtin_amdgcn_cosf(tf); rope[2 * i + 1] = __builtin_amdgcn_sinf(tf);
    }
    bf16_t* hb = (bf16_t*)(ws + WS_R0);
    float* rs0 = (float*)(ws + WS_SS);
    for (int m0 = 2 * gw; m0 < NB * SEQ; m0 += 2 * NGW) {
        f32x4 v[2][4];
#pragma unroll
        for (int q = 0; q < 2; ++q) { const f32x4* xr = (const f32x4*)(P.x + (size_t)(m0 + q) * DM) + lane;
#pragma unroll
            for (int j = 0; j < 4; ++j) v[q][j] = xr[64 * j]; }
#pragma unroll
        for (int q = 0; q < 2; ++q) {
            const int m = m0 + q, row = rowbase(m >> 8) + (m & 255);
            u32x2* o8 = (u32x2*)(hb + (size_t)row * 1024) + lane;
            float ss = 0.f;
#pragma unroll
            for (int j = 0; j < 4; ++j) { const f32x4 t = v[q][j]; ss += (t.x * t.x + t.y * t.y) + (t.z * t.z + t.w * t.w); u32x2 w; w.x = pk2(t.x, t.y); w.y = pk2(t.z, t.w); o8[64 * j] = w; }
            ss = wave_sum(ss);
            if (lane == 0) rs0[row] = rsqrtf(ss * (1.0f / 1024.0f) + 1e-6f);
        }
    }
    for (int i = gw; i < NB * PADF; i += NGW) {
        const int b = i / PADF, p = i - b * PADF; const size_t row = (size_t)b * PP + p;
        const u32x4 z = (u32x4){0u, 0u, 0u, 0u};
        u32x4* d4 = (u32x4*)(ws + WS_R4 + row * 2048) + lane; d4[0] = z; d4[64] = z;
        u32x4* d1 = (u32x4*)(ws + WS_R1 + row * 2048) + lane; d1[0] = z; d1[64] = z;
        u32x4* d3 = (u32x4*)(ws + WS_R3 + row * 2048) + lane; d3[0] = z; d3[64] = z;
    }
}

template <int NCOL, bool ABF, bool NORM, int UNR = 2>
__device__ __forceinline__ void meta_wave(const void* Aptr, int K, const bf16_t* Wt, const int (&wrow)[NCOL], int w, int lane, float (&out)[2][NCOL], float (&rs)[2]) {
    float q0 = 0.f, q1 = 0.f;
#pragma unroll
    for (int c = 0; c < NCOL; ++c) { out[0][c] = 0.f; out[1][c] = 0.f; }
#pragma unroll UNR
    for (int kc = lane; kc < (K >> 3); kc += 64) {
        float a0[8], a1[8];
        if (ABF) {
            const u32x4 u0 = *(const u32x4*)((const bf16_t*)Aptr + (size_t)(2 * w) * K + 8 * kc), u1 = *(const u32x4*)((const bf16_t*)Aptr + (size_t)(2 * w + 1) * K + 8 * kc);
            a0[0] = bf_lo(u0.x); a0[1] = bf_hi(u0.x); a0[2] = bf_lo(u0.y); a0[3] = bf_hi(u0.y); a0[4] = bf_lo(u0.z); a0[5] = bf_hi(u0.z); a0[6] = bf_lo(u0.w); a0[7] = bf_hi(u0.w);
            a1[0] = bf_lo(u1.x); a1[1] = bf_hi(u1.x); a1[2] = bf_lo(u1.y); a1[3] = bf_hi(u1.y); a1[4] = bf_lo(u1.z); a1[5] = bf_hi(u1.z); a1[6] = bf_lo(u1.w); a1[7] = bf_hi(u1.w);
        } else {
            const f32x4* p0 = (const f32x4*)((const float*)Aptr + (size_t)(2 * w) * K + 8 * kc); const f32x4* p1 = (const f32x4*)((const float*)Aptr + (size_t)(2 * w + 1) * K + 8 * kc);
            const f32x4 x0 = p0[0], x1 = p0[1], y0 = p1[0], y1 = p1[1];
#pragma unroll
            for (int i = 0; i < 4; ++i) { a0[i] = x0[i]; a0[4 + i] = x1[i]; a1[i] = y0[i]; a1[4 + i] = y1[i]; }
        }
        if (NORM) {
#pragma unroll
            for (int i = 0; i < 8; ++i) { q0 += a0[i] * a0[i]; q1 += a1[i] * a1[i]; }
        }
#pragma unroll
        for (int c = 0; c < NCOL; ++c) {
            const u32x4 wv = *(const u32x4*)(Wt + (size_t)wrow[c] * K + 8 * kc);
            const float wf[8] = {bf_lo(wv.x), bf_hi(wv.x), bf_lo(wv.y), bf_hi(wv.y), bf_lo(wv.z), bf_hi(wv.z), bf_lo(wv.w), bf_hi(wv.w)};
#pragma unroll
            for (int i = 0; i < 8; ++i) { out[0][c] += a0[i] * wf[i]; out[1][c] += a1[i] * wf[i]; }
        }
    }
#pragma unroll
    for (int c = 0; c < NCOL; ++c) { out[0][c] = wave_sum(out[0][c]); out[1][c] = wave_sum(out[1][c]); }
    if (NORM) { rs[0] = rsqrtf(wave_sum(q0) / (float)K + 1e-6f); rs[1] = rsqrtf(wave_sum(q1) / (float)K + 1e-6f); } else { rs[0] = 1.f; rs[1] = 1.f; }
}
template <int NN>
__device__ __forceinline__ float pick(LAS float* scr, const float (&a)[NN], int j, int lane) {
    if (lane == 0) {
#pragma unroll
        for (int i = 0; i < NN; ++i) scr[i] = a[i];
    }
    LDS_WAIT();
    const float r = scr[j];
    LDS_WAIT();
    return r;
}
__device__ __forceinline__ bf16_t bf1(float x) { return (bf16_t)(pk2(x, 0.f) & 0xffffu); }
__device__ __forceinline__ void store_meta_rows(bf16_t* buf, int r, int col, float val) {
    const bf16_t bv = bf1(val);
#pragma unroll
    for (int b = 0; b < NB; ++b) buf[((size_t)b * PP + PADF + r) * 1024 + col] = bv;
}
__device__ __forceinline__ void meta_in(CParams& P, LAS unsigned char* lds, int t, int tid) {
    const int lane = tid & 63, w = __builtin_amdgcn_readfirstlane(tid >> 6); int cb1, cb2, kind;
    if (t < 64) { const int pid = t * 8, blk = pid >> 8, head = (pid >> 6) & 3, d = pid & 63; kind = blk; cb1 = blk * 512 + head * 128 + d; cb2 = cb1 + 64; }
    else if (t < 192) { cb1 = 1024 + (t - 64) * 16; cb2 = cb1 + 8; kind = cb1 < 2048 ? 2 : 3; }
    else { kind = 4; cb1 = 3072 + (t - 192) * 8; cb2 = cb1 + 1024; }
    float o[2][16], rsv[2];
    int wrow[16];
#pragma unroll
    for (int c = 0; c < 8; ++c) { wrow[c] = l2p_in(cb1 + c); wrow[8 + c] = l2p_in(cb2 + c); }
    meta_wave<16, false, true>(P.meta, 1024, (const bf16_t*)(P.ws + WS_WIN), wrow, w, lane, o, rsv);
    unsigned char* ws = P.ws;
    const int j = lane & 7;
#pragma unroll
    for (int i = 0; i < 2; ++i) {
        const int r = 2 * w + i, p = PADF + r;
        if (kind <= 1 || kind == 4) {
            float lo8[8], hi8[8];
#pragma unroll
            for (int c = 0; c < 8; ++c) { lo8[c] = o[i][c]; hi8[c] = o[i][8 + c]; }
            const float y1 = pick<8>((LAS float*)(lds + 131072 + w * 1024), lo8, j, lane) * rsv[i], y2 = pick<8>((LAS float*)(lds + 131072 + w * 1024), hi8, j, lane) * rsv[i];
            if (lane < 8) {
                if (kind <= 1) {
                    const int head = (cb1 >> 7) & 3, d = (cb1 & 63) + j;
                    const float* rope = (const float*)(ws + WS_ROPE) + ((size_t)p * 64 + d) * 2;
                    const float c = rope[0], sn = rope[1];
                    const float ip1 = (float)(p + 1), lg = lg2gamma(head);
                    const float fac = kind == 0 ? fexp2(ip1 * lg) : fexp2(-ip1 * lg) * 0.08838834764831845f;
                    store_meta_rows((bf16_t*)(ws + WS_R4), r, l2p_in(cb1 + j), (y1 * c - y2 * sn) * fac);
                    store_meta_rows((bf16_t*)(ws + WS_R4), r, l2p_in(cb2 + j), (y1 * sn + y2 * c) * fac);
                } else {
                    store_meta_rows((bf16_t*)(ws + WS_R3), r, cb1 - 3072 + j, y1 * sigmoidf_(y2));
                }
            }
        } else {
            const float y = pick<16>((LAS float*)(lds + 131072 + w * 1024), o[i], lane & 15, lane) * rsv[i];
            if (lane < 16) {
                if (kind == 2) store_meta_rows((bf16_t*)(ws + WS_R1), r, cb1 - 1024 + lane, y);
                else store_meta_rows((bf16_t*)(ws + WS_R2), r, cb1 - 2048 + lane, y * sigmoidf_(y));
            }
        }
    }
}
__device__ __forceinline__ void meta_out(CParams& P, LAS unsigned char* lds, int t, int tid) {
    const int lane = tid & 63, w = __builtin_amdgcn_readfirstlane(tid >> 6);
    float o[2][4], rsv[2];
    const int wrow[4] = {4 * t, 4 * t + 1, 4 * t + 2, 4 * t + 3};
    meta_wave<4, true, false, 4>((const bf16_t*)(P.ws + WS_R0) + (size_t)PADF * 2048, 2048, (const bf16_t*)(P.ws + WS_WOUT), wrow, w, lane, o, rsv);
    float* hm1 = (float*)(P.ws + WS_HM1);
#pragma unroll
    for (int i = 0; i < 2; ++i) { const int r = 2 * w + i; const float y = pick<4>((LAS float*)(lds + 131072 + w * 1024), o[i], lane & 3, lane); if (lane < 4) hm1[r * 1024 + 4 * t + lane] = P.meta[r * 1024 + 4 * t + lane] + y; }
}
__device__ __forceinline__ void meta_up(CParams& P, LAS unsigned char* lds, int t, int tid) {
    const int lane = tid & 63, w = __builtin_amdgcn_readfirstlane(tid >> 6);
    float o[2][16], rsv[2];
    int wrow[16];
#pragma unroll
    for (int c = 0; c < 16; ++c) wrow[c] = 16 * t + c;
    meta_wave<16, false, true>((const float*)(P.ws + WS_HM1), 1024, (const bf16_t*)(P.ws + WS_W1), wrow, w, lane, o, rsv);
    float* hid = (float*)(P.ws + WS_HIDM);
#pragma unroll
    for (int i = 0; i < 2; ++i) { const int r = 2 * w + i; const float x = fmaxf(pick<16>((LAS float*)(lds + 131072 + w * 1024), o[i], lane & 15, lane) * rsv[i], 0.f); if (lane < 16) hid[r * 4096 + 16 * t + lane] = x * x; }
}
__device__ __forceinline__ void meta_down(CParams& P, LAS unsigned char* lds, int t, int tid) {
    const int lane = tid & 63, w = __builtin_amdgcn_readfirstlane(tid >> 6);
    float o[2][4], rsv[2];
    const int wrow[4] = {4 * t, 4 * t + 1, 4 * t + 2, 4 * t + 3};
    meta_wave<4, false, false, 4>((const float*)(P.ws + WS_HIDM), 4096, (const bf16_t*)(P.ws + WS_W2), wrow, w, lane, o, rsv);
    const float* hm1 = (const float*)(P.ws + WS_HM1);
    float* hm2 = (float*)(P.ws + WS_HM2P);
#pragma unroll
    for (int i = 0; i < 2; ++i) { const int r = 2 * w + i; const float y = pick<4>((LAS float*)(lds + 131072 + w * 1024), o[i], lane & 3, lane); if (lane < 4) hm2[r * 1024 + 4 * t + lane] = hm1[r * 1024 + 4 * t + lane] + y; }
}
constexpr size_t WS_KRAW = WS_HIDM, WS_VRAW = WS_HIDM + 65536, WS_KSS = WS_HIDM + 131072;
__device__ __forceinline__ void meta_kv(CParams& P, LAS unsigned char* lds, int t, int tid) {
    const int lane = tid & 63, w = __builtin_amdgcn_readfirstlane(tid >> 6);
    const int cb = 1024 + 16 * t;
    float o[2][16], rsv[2];
    int wrow[16];
#pragma unroll
    for (int c = 0; c < 16; ++c) wrow[c] = l2p_qkv(cb + c);
    meta_wave<16, false, true>((const float*)(P.ws + WS_HM2P), 1024, (const bf16_t*)(P.ws + WS_WQKV), wrow, w, lane, o, rsv);
    float* raw = (float*)(P.ws + (t < 64 ? WS_KRAW : WS_VRAW));
    float* kss = (float*)(P.ws + WS_KSS);
#pragma unroll
    for (int i = 0; i < 2; ++i) {
        const int r = 2 * w + i; float ss = 0.f;
#pragma unroll
        for (int c = 0; c < 16; ++c) { o[i][c] *= rsv[i]; ss += o[i][c] * o[i][c]; }
        const float y = pick<16>((LAS float*)(lds + 131072 + w * 1024), o[i], lane & 15, lane);
        if (lane < 16) raw[r * 1024 + 16 * (t & 63) + lane] = y;
        if (t < 64 && lane == 0) kss[r * 64 + t] = ss;
    }
}

__device__ __forceinline__ void load_T128(const bf16_t* src, int ld, int ncg, LAS unsigned char* dst, int tid) {
    for (int u = tid; u < 64 * ncg; u += NTHR) {
        const int jp = u & 63, cgi = u >> 6;
        const u32x4 a = *(const u32x4*)(src + (size_t)(2 * jp) * ld + cgi * 8), b = *(const u32x4*)(src + (size_t)(2 * jp + 1) * ld + cgi * 8);
        LAS unsigned* d = (LAS unsigned*)(dst + (cgi * 8) * 272 + jp * 4);
        d[0 * 68] = (a.x & 0xffffu) | (b.x << 16); d[1 * 68] = (a.x >> 16) | (b.x & 0xffff0000u);
        d[2 * 68] = (a.y & 0xffffu) | (b.y << 16); d[3 * 68] = (a.y >> 16) | (b.y & 0xffff0000u);
        d[4 * 68] = (a.z & 0xffffu) | (b.z << 16); d[5 * 68] = (a.z >> 16) | (b.z & 0xffff0000u);
        d[6 * 68] = (a.w & 0xffffu) | (b.w << 16); d[7 * 68] = (a.w >> 16) | (b.w & 0xffff0000u);
    }
}
template <int NU>
__device__ __forceinline__ void tload_issue(u32x4 (&a)[NU], u32x4 (&b)[NU], const bf16_t* src, int ld, int tid) {
#pragma unroll
    for (int i = 0; i < NU; ++i) { const int u = tid + i * NTHR, jp = u & 63, cgi = u >> 6;
        a[i] = *(const u32x4*)(src + (size_t)(2 * jp) * ld + cgi * 8); b[i] = *(const u32x4*)(src + (size_t)(2 * jp + 1) * ld + cgi * 8); }
}
template <int NU>
__device__ __forceinline__ void tload_store(const u32x4 (&a)[NU], const u32x4 (&b)[NU], LAS unsigned char* dst, int tid) {
#pragma unroll
    for (int i = 0; i < NU; ++i) { const int u = tid + i * NTHR, jp = u & 63, cgi = u >> 6;
        LAS unsigned* d = (LAS unsigned*)(dst + (cgi * 8) * 272 + jp * 4);
        d[0 * 68] = (a[i].x & 0xffffu) | (b[i].x << 16); d[1 * 68] = (a[i].x >> 16) | (b[i].x & 0xffff0000u);
        d[2 * 68] = (a[i].y & 0xffffu) | (b[i].y << 16); d[3 * 68] = (a[i].y >> 16) | (b[i].y & 0xffff0000u);
        d[4 * 68] = (a[i].z & 0xffffu) | (b[i].z << 16); d[5 * 68] = (a[i].z >> 16) | (b[i].z & 0xffff0000u);
        d[6 * 68] = (a[i].w & 0xffffu) | (b[i].w << 16); d[7 * 68] = (a[i].w >> 16) | (b[i].w & 0xffff0000u); }
}
constexpr int RET_KS = 0, RET_VT = 34816, RET_RED = 34816 + 69632;

__device__ __forceinline__ void ret_partial_item(CParams& P, LAS unsigned char* lds, int item, int tid) {
    asm volatile("" : "+v"(tid));
    const int lane = tid & 63, w = tid >> 6, l32 = lane & 31, hh = lane >> 5;
    int b, n, h;
    if (item < 128) { b = 0; n = item >> 2; h = item & 3; } else { const int j = item - 128; b = 1 + j / 124; const int r = j - (b - 1) * 124; n = 1 + (r >> 2); h = r & 3; }
    const bf16_t* qk = (const bf16_t*)(P.ws + WS_R4); const bf16_t* v = (const bf16_t*)(P.ws + WS_R1);
    bf16_t* G = (n == 0) ? (bf16_t*)P.out + (size_t)(1024 + h) * 32768 : (bf16_t*)P.out + ((size_t)((b * 4 + h) * 32 + n)) * 32768;
    const size_t R0 = (size_t)b * PP + 128 * n;
    {
        u32x4 ka[2], kb[2], va[4], vb[4];
        tload_issue<2>(ka, kb, qk + R0 * 1024 + 512 + h * 128, 1024, tid);
        tload_issue<4>(va, vb, v + R0 * 1024 + h * 256, 1024, tid);
        tload_store<2>(ka, kb, lds + RET_KS, tid);
        tload_store<4>(va, vb, lds + RET_VT, tid);
    }
    __syncthreads();
    const int dt = w & 3, eh = w >> 2;
    f32x16 acc[4];
#pragma unroll
    for (int et = 0; et < 4; ++et)
#pragma unroll
        for (int r = 0; r < 16; ++r) acc[et][r] = 0.f;
#pragma unroll
    for (int s = 0; s < 8; ++s) {
        const bf16x8 a = *(const LAS bf16x8*)(lds + RET_KS + (32 * dt + l32) * 272 + (16 * s + 8 * hh) * 2);
#pragma unroll
        for (int et = 0; et < 4; ++et) {
            const bf16x8 bb = *(const LAS bf16x8*)(lds + RET_VT + (32 * (4 * eh + et) + l32) * 272 + (16 * s + 8 * hh) * 2);
            acc[et] = MFMA32(a, bb, acc[et]);
        }
    }
    __syncthreads();
#pragma unroll
    for (int et = 0; et < 4; ++et)
#pragma unroll
        for (int g = 0; g < 4; ++g) {
            u32x2 o; o.x = pk2(acc[et][4 * g], acc[et][4 * g + 1]); o.y = pk2(acc[et][4 * g + 2], acc[et][4 * g + 3]);
            *(LAS u32x2*)(lds + RET_VT + (32 * (4 * eh + et) + l32) * 272 + (32 * dt + 8 * g + 4 * hh) * 2) = o;
        }
    __syncthreads();
    for (int c = tid; c < 4096; c += NTHR) { const int e = c >> 4, part = c & 15; *(u32x4*)(G + (size_t)c * 8) = *(const LAS u32x4*)(lds + RET_VT + e * 272 + part * 16); }
    __syncthreads();
}

template <int NT>
__device__ __forceinline__ void conv_item(CParams& P, LAS unsigned char* lds, int b, int p0, int tid) {
    const int lane = tid & 63, w = tid >> 6;
    const bf16_t* hdn = (const bf16_t*)(P.ws + WS_R3);
    bf16_t* mix = (bf16_t*)(P.ws + WS_R0);
    const size_t Rb = (size_t)b * PP;
    const unsigned* hd = (const unsigned*)(hdn + (Rb + p0 - 30) * 1024) + tid;
    unsigned xr[NT + 30];
#pragma unroll
    for (int r = 0; r < NT + 30; ++r) xr[r] = hd[r * 512];
    f32x2 W[31];
#pragma unroll
    for (int k = 0; k < 31; ++k) W[k] = *(const f32x2*)(P.even_conv_w + k * 1024 + 2 * tid);
    const f32x2 bias = *(const f32x2*)(P.even_conv_b + 2 * tid);
    LAS float* ys = (LAS float*)lds;
#pragma unroll
    for (int hf = 0; hf < NT / 16; ++hf) {
        f32x2 acc[16];
#pragma unroll
        for (int t = 0; t < 16; ++t) acc[t] = bias;
#pragma unroll
        for (int r = 0; r < 46; ++r) {
            const f32x2 xf = {bf_lo(xr[16 * hf + r]), bf_hi(xr[16 * hf + r])};
#pragma unroll
            for (int t = 0; t < 16; ++t) { const int k = r - t; if (k >= 0 && k <= 30) acc[t] += xf * W[k]; }
        }
#pragma unroll
        for (int t = 0; t < 16; ++t) *(LAS f32x2*)(ys + (16 * hf + t) * 1024 + 2 * tid) = acc[t];
    }
    f32x4 lg[4], lb[4];
#pragma unroll
    for (int j = 0; j < 4; ++j) { lg[j] = *(const f32x4*)(P.even_ln_g + 4 * lane + 256 * j); lb[j] = *(const f32x4*)(P.even_ln_b + 4 * lane + 256 * j); }
    __syncthreads();
    constexpr int TW = NT / 8;
#pragma unroll
    for (int q0 = 0; q0 < TW; q0 += 2) {
        f32x4 y[2][4]; float s[2] = {0.f, 0.f};
#pragma unroll
        for (int q = 0; q < 2; ++q)
#pragma unroll
            for (int j = 0; j < 4; ++j) { y[q][j] = *(const LAS f32x4*)(ys + (TW * w + q0 + q) * 1024 + 4 * lane + 256 * j); s[q] += (y[q][j].x + y[q][j].y) + (y[q][j].z + y[q][j].w); }
#pragma unroll
        for (int o = 1; o < 64; o <<= 1) { s[0] += __shfl_xor(s[0], o); s[1] += __shfl_xor(s[1], o); }
        float qv[2] = {0.f, 0.f};
#pragma unroll
        for (int q = 0; q < 2; ++q) { const float mean = s[q] * (1.0f / 1024.0f);
#pragma unroll
            for (int j = 0; j < 4; ++j) { y[q][j] = y[q][j] - mean; qv[q] += (y[q][j].x * y[q][j].x + y[q][j].y * y[q][j].y) + (y[q][j].z * y[q][j].z + y[q][j].w * y[q][j].w); } }
#pragma unroll
        for (int o = 1; o < 64; o <<= 1) { qv[0] += __shfl_xor(qv[0], o); qv[1] += __shfl_xor(qv[1], o); }
#pragma unroll
        for (int q = 0; q < 2; ++q) {
            const float rstd = rsqrtf(qv[q] * (1.0f / 1024.0f) + 1e-6f);
            const size_t row = Rb + p0 + TW * w + q0 + q;
#pragma unroll
            for (int j = 0; j < 4; ++j) {
                f32x4 o = y[q][j] * rstd * lg[j] + lb[j];
#pragma unroll
                for (int i = 0; i < 4; ++i) o[i] = o[i] * sigmoidf_(o[i]);
                u32x2 wv; wv.x = pk2(o[0], o[1]); wv.y = pk2(o[2], o[3]);
                *(u32x2*)(mix + row * 2048 + 1024 + 4 * lane + 256 * j) = wv;
            }
        }
    }
    __syncthreads();
}

__device__ __forceinline__ void ret_scan(CParams& P, int tid) {
    bf16_t* G = (bf16_t*)P.out;
    for (int c = blockIdx.x * NTHR + tid; c < 32 * 4096; c += gridDim.x * NTHR) {
        const int bh = c >> 12, off = (c & 4095) * 8, h = bh & 3;
        const float lam = fexp2(128.0f * lg2gamma(h));
        bf16_t* ptr = G + (size_t)bh * 32 * 32768 + off;
        float S[8];
#pragma unroll
        for (int k = 0; k < 8; ++k) S[k] = 0.f;
#pragma unroll 8
        for (int n = 0; n < 32; ++n) {
            const u32x4 g = (n == 0) ? *(const u32x4*)(G + (size_t)(1024 + h) * 32768 + off) : *(const u32x4*)(ptr + (size_t)n * 32768);
            S[0] = lam * (S[0] + bf_lo(g.x)); S[1] = lam * (S[1] + bf_hi(g.x)); S[2] = lam * (S[2] + bf_lo(g.y)); S[3] = lam * (S[3] + bf_hi(g.y));
            S[4] = lam * (S[4] + bf_lo(g.z)); S[5] = lam * (S[5] + bf_hi(g.z)); S[6] = lam * (S[6] + bf_lo(g.w)); S[7] = lam * (S[7] + bf_hi(g.w));
            u32x4 o; o.x = pk2(S[0], S[1]); o.y = pk2(S[2], S[3]); o.z = pk2(S[4], S[5]); o.w = pk2(S[6], S[7]);
            *(u32x4*)(ptr + (size_t)n * 32768) = o;
        }
    }
}

__device__ __forceinline__ void ret_out_item(CParams& P, LAS unsigned char* lds, int item, int tid) {
    asm volatile("" : "+v"(tid));
    const int lane = tid & 63, w = tid >> 6, l32 = lane & 31, hh = lane >> 5;
    const int b = item / 132, rem = item - b * 132, n = rem >> 2, h = rem & 3;
    const bf16_t* qk = (const bf16_t*)(P.ws + WS_R4); const bf16_t* v = (const bf16_t*)(P.ws + WS_R1); const bf16_t* gs = (const bf16_t*)(P.ws + WS_R2);
    bf16_t* mix = (bf16_t*)(P.ws + WS_R0);
    const size_t R0 = (size_t)b * PP + 128 * n;
    const int ib = w & 3, eh = w >> 2;
    bf16x8 qf[8];
    {
        u32x4 kt[4], va[4], vb[4];
#pragma unroll
        for (int i = 0; i < 4; ++i) { const int c = tid + i * NTHR; kt[i] = *(const u32x4*)(qk + (R0 + (c >> 4)) * 1024 + 512 + h * 128 + (c & 15) * 8); }
        tload_issue<4>(va, vb, v + R0 * 1024 + h * 256, 1024, tid);
#pragma unroll
        for (int s = 0; s < 8; ++s) qf[s] = *(const bf16x8*)(qk + (R0 + 32 * ib + l32) * 1024 + h * 128 + 16 * s + 8 * hh);
#pragma unroll
        for (int i = 0; i < 4; ++i) { const int c = tid + i * NTHR; *(LAS u32x4*)(lds + RET_KS + (c >> 4) * 272 + (c & 15) * 16) = kt[i]; }
        tload_store<4>(va, vb, lds + RET_VT, tid);
    }
    const bf16_t* prev = (const bf16_t*)P.out + ((size_t)((b * 4 + h) * 32 + (n > 0 ? n - 1 : 0))) * 32768;
    bf16x8 pf[4][4];
    if (n > 0) {
#pragma unroll
        for (int s = 0; s < 4; ++s)
#pragma unroll
            for (int et = 0; et < 4; ++et) pf[s][et] = *(const bf16x8*)(prev + (size_t)(32 * (4 * eh + et) + l32) * 128 + 16 * s + 8 * hh);
    }
    __syncthreads();
    f32x16 O[4];
#pragma unroll
    for (int et = 0; et < 4; ++et)
#pragma unroll
        for (int r = 0; r < 16; ++r) O[et][r] = 0.f;
    if (n > 0) {
#pragma unroll
        for (int s = 0; s < 4; ++s)
#pragma unroll
            for (int et = 0; et < 4; ++et) O[et] = MFMA32(pf[s][et], qf[s], O[et]);
#pragma unroll
        for (int s = 4; s < 8; ++s)
#pragma unroll
            for (int et = 0; et < 4; ++et) {
                const bf16x8 a = *(const bf16x8*)(prev + (size_t)(32 * (4 * eh + et) + l32) * 128 + 16 * s + 8 * hh);
                O[et] = MFMA32(a, qf[s], O[et]);
            }
    }
#pragma unroll 1
    for (int jt = 0; jt <= ib; ++jt) {
        f32x16 x;
#pragma unroll
        for (int r = 0; r < 16; ++r) x[r] = 0.f;
#pragma unroll
        for (int s = 0; s < 8; ++s) {
            const bf16x8 a = *(const LAS bf16x8*)(lds + RET_KS + (32 * jt + l32) * 272 + (16 * s + 8 * hh) * 2);
            x = MFMA32(a, qf[s], x);
        }
        if (jt == ib) {
#pragma unroll
            for (int r = 0; r < 16; ++r) x[r] = (crow(r, hh) > l32) ? 0.f : x[r];
        }
        u32x4 p0, p1;
        p0.x = pk2(x[0], x[1]); p0.y = pk2(x[2], x[3]); p0.z = pk2(x[4], x[5]); p0.w = pk2(x[6], x[7]);
        p1.x = pk2(x[8], x[9]); p1.y = pk2(x[10], x[11]); p1.z = pk2(x[12], x[13]); p1.w = pk2(x[14], x[15]);
        const bf16x8 pb0 = __builtin_bit_cast(bf16x8, p0), pb1 = __builtin_bit_cast(bf16x8, p1);
#pragma unroll
        for (int et = 0; et < 4; ++et) {
            const LAS unsigned char* vp = lds + RET_VT + (32 * (4 * eh + et) + l32) * 272 + (32 * jt + 4 * hh) * 2;
            const s16x4 lo0 = *(const LAS s16x4*)(vp), hi0 = *(const LAS s16x4*)(vp + 16), lo1 = *(const LAS s16x4*)(vp + 32), hi1 = *(const LAS s16x4*)(vp + 48);
            O[et] = MFMA32(__builtin_shufflevector(lo0, hi0, 0, 1, 2, 3, 4, 5, 6, 7), pb0, O[et]);
            O[et] = MFMA32(__builtin_shufflevector(lo1, hi1, 0, 1, 2, 3, 4, 5, 6, 7), pb1, O[et]);
        }
    }
    float sm = 0.f, sq = 0.f;
#pragma unroll
    for (int et = 0; et < 4; ++et)
#pragma unroll
        for (int r = 0; r < 16; ++r) { const float t = O[et][r]; sm += t; sq += t * t; }
    sm += __shfl_xor(sm, 32); sq += __shfl_xor(sq, 32);
    LAS f32x2* red = (LAS f32x2*)(lds + RET_RED);
    if (hh == 0) red[w * 32 + l32] = (f32x2){sm, sq};
    const f32x4 gn = *(const f32x4*)(P.even_gn_g + h * 256 + 4 * lane);
    u32x2 gvr[16];
#pragma unroll
    for (int it = 0; it < 16; ++it) gvr[it] = *(const u32x2*)(gs + (R0 + w * 16 + it) * 1024 + h * 256 + 4 * lane);
    __syncthreads();
    { const f32x2 o = red[(w ^ 4) * 32 + l32]; sm += o.x; sq += o.y; }
    const float mean = sm * (1.0f / 256.0f);
    const float rstd = rsqrtf(fmaxf(sq * (1.0f / 256.0f) - mean * mean, 0.f) + 1e-6f);
#pragma unroll
    for (int et = 0; et < 4; ++et)
#pragma unroll
        for (int g = 0; g < 4; ++g) {
            u32x2 o; o.x = pk2((O[et][4 * g] - mean) * rstd, (O[et][4 * g + 1] - mean) * rstd); o.y = pk2((O[et][4 * g + 2] - mean) * rstd, (O[et][4 * g + 3] - mean) * rstd);
            *(LAS u32x2*)(lds + RET_VT + (32 * ib + l32) * 520 + (32 * (4 * eh + et) + 8 * g + 4 * hh) * 2) = o;
        }
    __syncthreads();
#pragma unroll
    for (int it = 0; it < 16; ++it) {
        const int i = w * 16 + it;
        const u32x2 val = *(const LAS u32x2*)(lds + RET_VT + i * 520 + lane * 8);
        const u32x2 gv = gvr[it];
        u32x2 o; o.x = pk2(bf_lo(val.x) * gn.x * bf_lo(gv.x), bf_hi(val.x) * gn.y * bf_hi(gv.x)); o.y = pk2(bf_lo(val.y) * gn.z * bf_lo(gv.y), bf_hi(val.y) * gn.w * bf_hi(gv.y));
        *(u32x2*)(mix + (R0 + i) * 2048 + h * 256 + 4 * lane) = o;
    }
    __syncthreads();
}

constexpr int AT_KS = 0, AT_VT = 9216, AT_FLAG = 18432, AT_OST = 18688;
template <int MASK>
__device__ __forceinline__ void sb_subtile(f32x16& x, float& C, int hh, int key0, int qidx, u32x4& p0, u32x4& p1) {
    f32x2 e2[2][4], d2[2][4];
#pragma unroll
    for (int gp = 0; gp < 2; ++gp)
#pragma unroll
        for (int j = 0; j < 4; ++j) {
            float ev[2];
#pragma unroll
            for (int c = 0; c < 2; ++c) {
                const int r = 4 * (2 * gp + c) + j;
                float t = fexp2(__builtin_amdgcn_fmed3f(x[r], -126.f, 30.f));
                if (MASK == 1) { const int key = key0 + crow(r, hh); t = (key < qidx) ? t : 0.f; }
                if (MASK == 2) { const int key = key0 + crow(r, hh); t = (key < qidx && key >= PADF) ? t : 0.f; }
                ev[c] = t;
            }
            e2[gp][j] = (f32x2){ev[0], ev[1]};
            d2[gp][j] = e2[gp][j] + 1.0f;
        }
    float pg[4], qg[4], T[4];
#pragma unroll
    for (int gp = 0; gp < 2; ++gp) {
        const f32x2 Q = (d2[gp][3] * d2[gp][2]) * (d2[gp][1] * d2[gp][0]);
        pg[2 * gp] = frcp(Q.x); pg[2 * gp + 1] = frcp(Q.y);
    }
#pragma unroll
    for (int g = 0; g < 4; ++g) qg[g] = __shfl_xor(pg[g], 32);
    T[3] = C; T[2] = T[3] * (pg[3] * qg[3]); T[1] = T[2] * (pg[2] * qg[2]); T[0] = T[1] * (pg[1] * qg[1]);
    C = T[0] * (pg[0] * qg[0]);
    f32x2 w2[2][4];
#pragma unroll
    for (int gp = 0; gp < 2; ++gp) {
        const f32x2 base = hh ? (f32x2){T[2 * gp], T[2 * gp + 1]} : (f32x2){T[2 * gp] * qg[2 * gp], T[2 * gp + 1] * qg[2 * gp + 1]};
        const f32x2 b0 = base * (f32x2){pg[2 * gp], pg[2 * gp + 1]};
        const f32x2 b1 = b0 * d2[gp][0], b2 = b1 * d2[gp][1], b3 = b2 * d2[gp][2];
        w2[gp][0] = e2[gp][0] * b0; w2[gp][1] = e2[gp][1] * b1; w2[gp][2] = e2[gp][2] * b2; w2[gp][3] = e2[gp][3] * b3;
    }
    p0.x = pk2(w2[0][0].x, w2[0][1].x); p0.y = pk2(w2[0][2].x, w2[0][3].x); p0.z = pk2(w2[0][0].y, w2[0][1].y); p0.w = pk2(w2[0][2].y, w2[0][3].y);
    p1.x = pk2(w2[1][0].x, w2[1][1].x); p1.y = pk2(w2[1][2].x, w2[1][3].x); p1.z = pk2(w2[1][0].y, w2[1][1].y); p1.w = pk2(w2[1][2].y, w2[1][3].y);
}

__device__ __forceinline__ void attn_item(CParams& P, LAS unsigned char* lds, int item, int tid) {
    const int lane = tid & 63, w = tid >> 6, l32 = lane & 31, hh = lane >> 5;
    int bh, qb;
    if (item < 1920) { bh = item / 15; qb = 1 + (item - bh * 15); } else if (item < 2048) { bh = item - 1920; qb = 16; } else { bh = item - 2048; qb = 0; }
    const int b = bh >> 4, h = bh & 15;
    const bf16_t* q = (const bf16_t*)(P.ws + WS_R0); const bf16_t* k = (const bf16_t*)(P.ws + WS_R0 + UNIT); const bf16_t* v = (const bf16_t*)(P.ws + WS_R1);
    bf16_t* ao = (bf16_t*)(P.ws + WS_R2);
    const size_t Rb = (size_t)b * PP;
    const int qrow0 = 256 * qb + 32 * w;
    const bool wvalid = qrow0 < PP;
    bf16x8 qf[4];
#pragma unroll
    for (int s = 0; s < 4; ++s) {
        if (wvalid) qf[s] = *(const bf16x8*)(q + (Rb + qrow0 + l32) * 1024 + h * 64 + 16 * s + 8 * hh);
        else qf[s] = (bf16x8){0, 0, 0, 0, 0, 0, 0, 0};
    }
    f32x16 O[2];
#pragma unroll
    for (int dt = 0; dt < 2; ++dt)
#pragma unroll
        for (int r = 0; r < 16; ++r) O[dt][r] = 0.f;
    float C = 1.0f; bool done = !wvalid;
    int T = 4 * qb + 3; if (T > 65) T = 65;
    const bool vrole = tid < 256;
    const int jp = tid & 31, dg = (tid >> 5) & 7;
    const int ku = tid & 255;
    u32x4 ra, rb;
    {
        const size_t kb = Rb + 64 * T;
        if (vrole) { ra = *(const u32x4*)(v + (kb + 2 * jp) * 1024 + h * 64 + dg * 8); rb = *(const u32x4*)(v + (kb + 2 * jp + 1) * 1024 + h * 64 + dg * 8); }
        else { ra = *(const u32x4*)(k + (kb + (ku >> 3)) * 1024 + h * 64 + (ku & 7) * 8); rb = *(const u32x4*)(k + (kb + 32 + (ku >> 3)) * 1024 + h * 64 + (ku & 7) * 8); }
    }
    volatile LAS unsigned* flags = (volatile LAS unsigned*)(lds + AT_FLAG);
#pragma unroll 1
    for (; T >= 1; --T) {
        __syncthreads();
        if (vrole) {
            if (T == 1) {
                if (jp < 24) { ra = (u32x4){0u, 0u, 0u, 0u}; rb = ra; }
                else {
                    const float* vr = (const float*)(P.ws + WS_VRAW) + (size_t)(2 * jp - 48) * 1024 + h * 64 + dg * 8;
                    const f32x4 a0 = *(const f32x4*)vr, a1 = *(const f32x4*)(vr + 4), b0 = *(const f32x4*)(vr + 1024), b1 = *(const f32x4*)(vr + 1028);
                    ra.x = pk2(a0.x, a0.y); ra.y = pk2(a0.z, a0.w); ra.z = pk2(a1.x, a1.y); ra.w = pk2(a1.z, a1.w);
                    rb.x = pk2(b0.x, b0.y); rb.y = pk2(b0.z, b0.w); rb.z = pk2(b1.x, b1.y); rb.w = pk2(b1.z, b1.w);
                }
            }
            LAS unsigned* d = (LAS unsigned*)(lds + AT_VT + (dg * 8) * 144 + jp * 4);
            d[0 * 36] = (ra.x & 0xffffu) | (rb.x << 16); d[1 * 36] = (ra.x >> 16) | (rb.x & 0xffff0000u);
            d[2 * 36] = (ra.y & 0xffffu) | (rb.y << 16); d[3 * 36] = (ra.y >> 16) | (rb.y & 0xffff0000u);
            d[4 * 36] = (ra.z & 0xffffu) | (rb.z << 16); d[5 * 36] = (ra.z >> 16) | (rb.z & 0xffff0000u);
            d[6 * 36] = (ra.w & 0xffffu) | (rb.w << 16); d[7 * 36] = (ra.w >> 16) | (rb.w & 0xffff0000u);
        } else {
            if (T == 1 && (ku >> 3) >= 16) {
                const int r = (ku >> 3) - 16;
                const f32x4 s4 = *(const f32x4*)((const float*)(P.ws + WS_KSS) + r * 64 + 4 * h);
                const float n = rsqrtf(((s4.x + s4.y) + (s4.z + s4.w)) * (1.0f / 64.0f) + 1e-6f);
                const float* kr = (const float*)(P.ws + WS_KRAW) + (size_t)r * 1024 + h * 64 + (ku & 7) * 8;
                const f32x4 a0 = *(const f32x4*)kr * n * *(const f32x4*)(P.odd_kn_g + (ku & 7) * 8), a1 = *(const f32x4*)(kr + 4) * n * *(const f32x4*)(P.odd_kn_g + (ku & 7) * 8 + 4);
                rb.x = pk2(a0.x, a0.y); rb.y = pk2(a0.z, a0.w); rb.z = pk2(a1.x, a1.y); rb.w = pk2(a1.z, a1.w);
            }
            *(LAS u32x4*)(lds + AT_KS + (ku >> 3) * 144 + (ku & 7) * 16) = ra;
            *(LAS u32x4*)(lds + AT_KS + (32 + (ku >> 3)) * 144 + (ku & 7) * 16) = rb;
        }
        if (lane == 0) flags[w] = done ? 1u : 0u;
        __syncthreads();
        const u32x4 f0 = *(const LAS u32x4*)(lds + AT_FLAG), f1 = *(const LAS u32x4*)(lds + AT_FLAG + 16);
        const unsigned alld = (f0.x & f0.y) & (f0.z & f0.w) & (f1.x & f1.y) & (f1.z & f1.w);
        if (alld) break;
        if (T > 1) {
            const size_t kb = Rb + 64 * (T - 1);
            if (vrole) { ra = *(const u32x4*)(v + (kb + 2 * jp) * 1024 + h * 64 + dg * 8); rb = *(const u32x4*)(v + (kb + 2 * jp + 1) * 1024 + h * 64 + dg * 8); }
            else { ra = *(const u32x4*)(k + (kb + (ku >> 3)) * 1024 + h * 64 + (ku & 7) * 8); rb = *(const u32x4*)(k + (kb + 32 + (ku >> 3)) * 1024 + h * 64 + (ku & 7) * 8); }
        }
        if (!done && 64 * T <= qrow0 + 30) {
            const bool needmask = (64 * T + 63 >= qrow0) || (T == 1);
#pragma unroll
            for (int st = 1; st >= 0; --st) {
                if (64 * T + 32 * st >= qrow0 + 31) continue;
                f32x16 x;
#pragma unroll
                for (int r = 0; r < 16; ++r) x[r] = 0.f;
#pragma unroll
                for (int s = 0; s < 4; ++s) {
                    const bf16x8 a = *(const LAS bf16x8*)(lds + AT_KS + (32 * st + l32) * 144 + (16 * s + 8 * hh) * 2);
                    x = MFMA32(a, qf[s], x);
                }
                u32x4 p0, p1;
                if (T == 1) sb_subtile<2>(x, C, hh, 64 * T + 32 * st, qrow0 + l32, p0, p1);
                else if (needmask) sb_subtile<1>(x, C, hh, 64 * T + 32 * st, qrow0 + l32, p0, p1);
                else sb_subtile<0>(x, C, hh, 0, 0, p0, p1);
                const bf16x8 pb0 = __builtin_bit_cast(bf16x8, p0), pb1 = __builtin_bit_cast(bf16x8, p1);
#pragma unroll
                for (int dt = 0; dt < 2; ++dt) {
                    const LAS unsigned char* vp = lds + AT_VT + (32 * dt + l32) * 144 + (32 * st + 4 * hh) * 2;
                    const s16x4 lo0 = *(const LAS s16x4*)(vp), hi0 = *(const LAS s16x4*)(vp + 16), lo1 = *(const LAS s16x4*)(vp + 32), hi1 = *(const LAS s16x4*)(vp + 48);
                    O[dt] = MFMA32(__builtin_shufflevector(lo0, hi0, 0, 1, 2, 3, 4, 5, 6, 7), pb0, O[dt]);
                    O[dt] = MFMA32(__builtin_shufflevector(lo1, hi1, 0, 1, 2, 3, 4, 5, 6, 7), pb1, O[dt]);
                }
                if (__ballot(C >= 1e-37f) == 0ull) { done = true; break; }
            }
        }
    }
    LAS unsigned char* ost = lds + AT_OST + w * 4352;
#pragma unroll
    for (int dt = 0; dt < 2; ++dt)
#pragma unroll
        for (int g = 0; g < 4; ++g) {
            u32x2 o; o.x = pk2(O[dt][4 * g], O[dt][4 * g + 1]); o.y = pk2(O[dt][4 * g + 2], O[dt][4 * g + 3]);
            *(LAS u32x2*)(ost + l32 * 136 + (32 * dt + 8 * g + 4 * hh) * 2) = o;
        }
    LDS_WAIT();
    if (wvalid) {
#pragma unroll
        for (int it = 0; it < 8; ++it) {
            const int row = 4 * it + (lane >> 4), part = lane & 15;
            const u32x2 val = *(const LAS u32x2*)(ost + row * 136 + part * 8);
            *(u32x2*)(ao + (Rb + qrow0 + row) * 1024 + h * 64 + part * 4) = val;
        }
    }
    LDS_WAIT();
}

constexpr size_t WS_BAR = WS_HM2P + (size_t)16 * 1024 * 4;
#define XB_TMO      128
#define XB_XCNT(j)  (256  + 64 * (j))
#define XB_XSUB(j)  (1280 + 64 * (j))
#define XB_XGEN(j)  (2304 + 64 * (j))
#define XB_TOP      3328
#define XB_TOPGEN   3392
#define XCD_BAR_WORDS 3456
#define XB_SPIN_CAP (1u << 18)

__device__ __forceinline__ unsigned xb_ld(unsigned* p)              { return __hip_atomic_load(p, __ATOMIC_RELAXED, __HIP_MEMORY_SCOPE_AGENT); }
__device__ __forceinline__ unsigned xb_add(unsigned* p, unsigned v) { return __hip_atomic_fetch_add(p, v, __ATOMIC_RELAXED, __HIP_MEMORY_SCOPE_AGENT); }
__device__ __forceinline__ unsigned xb_xcc_id() { return (unsigned)__builtin_amdgcn_s_getreg((3 << 11) | 20) & 0xFu; }
#define XB_SPIN(cond, bar) do { unsigned _sp = 0; while (cond) { __builtin_amdgcn_s_sleep(1); \
    if ((++_sp & 255u) == 0u) { if (xb_ld(&(bar)[XB_TMO])) break; if (_sp > XB_SPIN_CAP) { atomicAdd(&(bar)[XB_TMO], 1u); break; } } } } while (0)

struct XcdBarrier {
    unsigned* bar; unsigned x;
    volatile LAS unsigned* st;
};

__device__ __forceinline__ XcdBarrier xcd_barrier_post(unsigned* bar, volatile LAS unsigned* st) {
    XcdBarrier b; b.bar = bar; b.x = xb_xcc_id(); b.st = st;
    if (threadIdx.x == 0) (void)xb_add(&bar[XB_XCNT(b.x)], 1u);
    return b;
}
__device__ __forceinline__ void xcd_barrier_complete(unsigned* bar, unsigned x, unsigned& nloc, unsigned& nx) {
    const unsigned G = gridDim.x * gridDim.y * gridDim.z;
    unsigned sum, cnt, mine, sp = 0u;
    for (;;) {
        sum = 0u; cnt = 0u; mine = 0u;
#pragma unroll
        for (unsigned j = 0; j < 16; ++j) { const unsigned c = xb_ld(&bar[XB_XCNT(j)]); sum += c; cnt += (c > 0u) ? 1u : 0u; mine = (j == x) ? c : mine; }
        if (sum == G) break;
        __builtin_amdgcn_s_sleep(1);
        if ((++sp & 255u) == 0u) { if (xb_ld(&bar[XB_TMO])) break; if (sp > XB_SPIN_CAP) { atomicAdd(&bar[XB_TMO], 1u); break; } }
    }
    nloc = mine > 0u ? mine : 1u; nx = cnt > 0u ? cnt : 1u;
}

__device__ __forceinline__ void xcd_barrier(const XcdBarrier& b) {
    asm volatile("s_waitcnt vmcnt(0)" ::: "memory");
    __syncthreads();
    if (threadIdx.x == 0) {
        unsigned* bar = b.bar;
        __builtin_amdgcn_s_waitcnt(0);
        unsigned nloc = b.st[0], nx = b.st[1];
        if (nloc == 0u) { xcd_barrier_complete(bar, b.x, nloc, nx); b.st[0] = nloc; b.st[1] = nx; }
        const unsigned old = xb_add(&bar[XB_XSUB(b.x)], 1u);
        const unsigned gen = old / nloc;
        if (old + 1u == (gen + 1u) * nloc) {
            __builtin_amdgcn_fence(__ATOMIC_RELEASE, "agent");
            asm volatile("s_waitcnt vmcnt(0)" ::: "memory");
            const unsigned og = xb_add(&bar[XB_TOP], 1u);
            const unsigned tg = og / nx;
            if (og + 1u == (tg + 1u) * nx) xb_add(&bar[XB_TOPGEN], 1u);
            else XB_SPIN(xb_ld(&bar[XB_TOPGEN]) == tg, bar);
            __builtin_amdgcn_fence(__ATOMIC_ACQUIRE, "agent");
            xb_add(&bar[XB_XGEN(b.x)], 1u);
            asm volatile("s_waitcnt vmcnt(0)" ::: "memory");
        } else {
            XB_SPIN(xb_ld(&bar[XB_XGEN(b.x)]) == gen, bar);
            __builtin_amdgcn_fence(__ATOMIC_ACQUIRE, "agent");
            asm volatile("s_waitcnt vmcnt(0)" ::: "memory");
        }
    }
    __syncthreads();
}

#define GEMM_PHASE(EPI, Aptr, Bptr, N_, K_, E_) do { pg8::Gemm g_{(const pg8::bf16_t*)(Aptr), (const pg8::bf16_t*)(Bptr), NB * SEQ, (N_), (K_)}; pg8::StaticOrder S_; S_.init(NB * SEQ, (N_), (int)gridDim.x, (int)blockIdx.x); \
    pg8::gemm_phase<EPI, pg8::StaticOrder, true, true>(lds, g_, S_, E_); } while (0)
#define META_TASKS(FN, NT) do { RETID(); for (int t_ = blockIdx.x; t_ < (NT); t_ += gridDim.x) FN(KP, lds, t_, tid); asm volatile("s_waitcnt vmcnt(0)" ::: "memory"); __syncthreads(); } while (0)

__global__ void __launch_bounds__(NTHR) mega_fwd(Params Punused) {
    extern __shared__ __attribute__((aligned(16))) unsigned char lds_raw[];
    LAS unsigned char* lds = (LAS unsigned char*)lds_raw;
    cg::grid_group grid = cg::this_grid();
    int tid = threadIdx.x;
#define RETID() do { tid = threadIdx.x; asm volatile("" : "+v"(tid)); } while (0)
#define ws (KP.ws)
#define ss1 ((float*)(ws + WS_SS) + (size_t)RP * 16)
#define ss2 ((float*)(ws + WS_SS) + (size_t)RP * 32)
#define ss3 ((float*)(ws + WS_SS) + (size_t)RP * 48)
    volatile LAS unsigned* bst = (volatile LAS unsigned*)(lds + 139264);
    if (tid < 2) bst[tid] = 0u;
#define GBAR() xcd_barrier(xbar)
    RETID();
    if (blockIdx.x == 0) for (int i = tid; i < XCD_BAR_WORDS; i += NTHR) ((volatile unsigned*)(ws + WS_BAR))[i] = 0u;
    phase0(KP, lds, tid);
    grid.sync();
    const XcdBarrier xbar = xcd_barrier_post((unsigned*)(ws + WS_BAR), bst);
    META_TASKS(meta_in, 320);
    { EpiIn E{(const float*)(ws + WS_SS), (bf16_t*)(ws + WS_R4), (bf16_t*)(ws + WS_R1), (bf16_t*)(ws + WS_R2), (bf16_t*)(ws + WS_R3)};
      GEMM_PHASE(EpiIn, ws + WS_R0, ws + WS_WIN, 5120, 1024, E); }
    GBAR();
    RETID();
    for (int it = blockIdx.x; it < 996 + 1025 + 4; it += gridDim.x) {
        if (it < 996) ret_partial_item(KP, lds, it, tid);
        else if (it == 996) conv_item<16>(KP, lds, 0, PADF, tid);
        else if (it < 996 + 1025) { const int ci = it - 997; conv_item<32>(KP, lds, ci >> 7, 128 + 32 * (ci & 127), tid); }
        else ret_out_item(KP, lds, it - (996 + 1025), tid);
    }
    GBAR();
    RETID();
    ret_scan(KP, tid);
    GBAR();
    RETID();
    for (int it = blockIdx.x; it < NB * 32 * 4; it += gridDim.x) ret_out_item(KP, lds, (it >> 7) * 132 + 4 + (it & 127), tid);
    GBAR();
    META_TASKS(meta_out, 256);
    { typedef EpiRes<true, false> EpiR0; EpiR0 E{KP.x, nullptr, (bf16_t*)(ws + WS_R4), ss1};
      GEMM_PHASE(EpiR0, ws + WS_R0, ws + WS_WOUT, 1024, 2048, E); }
    GBAR();
    META_TASKS(meta_up, 256);
    { EpiUp E{ss1, (bf16_t*)(ws + WS_R0), (LAS float*)(lds + RS_TAB_OFF)}; GEMM_PHASE(EpiUp, ws + WS_R4, ws + WS_W1, 4096, 1024, E); }
    GBAR();
    META_TASKS(meta_down, 256);
    { typedef EpiRes<false, false> EpiR1; EpiR1 E{nullptr, nullptr, (bf16_t*)(ws + WS_R4), ss2};
      GEMM_PHASE(EpiR1, ws + WS_R0, ws + WS_W2, 1024, 4096, E); }
    GBAR();
    META_TASKS(meta_kv, 128);
    { EpiQkv E{ss2, KP.odd_qn_g, KP.odd_kn_g, (bf16_t*)(ws + WS_R0), (LAS float*)(lds + RS_TAB_OFF)};
      GEMM_PHASE(EpiQkv, ws + WS_R4, ws + WS_WQKV, 3072, 1024, E); }
    GBAR();
    RETID();
    for (int it = blockIdx.x; it < NB * 16 * 17; it += gridDim.x) attn_item(KP, lds, it, tid);
    GBAR();
    { typedef EpiRes<false, false> EpiR1; EpiR1 E{nullptr, nullptr, (bf16_t*)(ws + WS_R4), ss3};
      GEMM_PHASE(EpiR1, ws + WS_R2, ws + WS_WO, 1024, 1024, E); }
    GBAR();
    { EpiUp E{ss3, (bf16_t*)(ws + WS_R0), (LAS float*)(lds + RS_TAB_OFF)}; GEMM_PHASE(EpiUp, ws + WS_R4, ws + WS_W1 + (size_t)4096 * 1024 * 2, 4096, 1024, E); }
    GBAR();
    { typedef EpiRes<false, true> EpiR2; EpiR2 E{nullptr, KP.out, (bf16_t*)(ws + WS_R4), nullptr};
      GEMM_PHASE(EpiR2, ws + WS_R0, ws + WS_W2 + (size_t)4096 * 1024 * 2, 1024, 4096, E); }
#undef ws
#undef ss1
#undef ss2
#undef ss3
}

extern "C" void kernel_launch(void* const* d_in, const int* in_sizes, int n_in, void* d_out, int out_size, void* d_ws, size_t ws_size, hipStream_t stream) {
    static int grid_blocks = 0;
    if (grid_blocks == 0) {
        if (n_in != 17 || ws_size < WS_END) { fprintf(stderr, "kernel_launch: unexpected inputs (n_in %d, ws %zu, need %zu)\n", n_in, ws_size, (size_t)WS_END); grid_blocks = -1; return; }
        int dev = 0, cus = 0, per_cu = 0;
        (void)hipGetDevice(&dev);
        (void)hipDeviceGetAttribute(&cus, hipDeviceAttributeMultiprocessorCount, dev);
        if (hipFuncSetAttribute((const void*)mega_fwd, hipFuncAttributeMaxDynamicSharedMemorySize, LDS_BYTES) != hipSuccess) fprintf(stderr, "kernel_launch: hipFuncSetAttribute failed\n");
        if (hipOccupancyMaxActiveBlocksPerMultiprocessor(&per_cu, (const void*)mega_fwd, NTHR, LDS_BYTES) != hipSuccess || per_cu < 1) { fprintf(stderr, "kernel_launch: occupancy query gave %d; using 1\n", per_cu); per_cu = 1; }
        (void)hipGetLastError();
        if (cus <= 0) cus = 256;
        grid_blocks = cus * per_cu;
    }
    if (grid_blocks < 0) return;
    Params p{};
    const float** pp = (const float**)&p;
    for (int i = 0; i < 17; ++i) pp[i] = (const float*)d_in[i];
    p.out = (float*)d_out; p.ws = (unsigned char*)d_ws;
    void* args[] = {&p};
    hipError_t e = hipLaunchCooperativeKernel((const void*)mega_fwd, dim3(grid_blocks), dim3(NTHR), args, LDS_BYTES, stream);
    if (e != hipSuccess) fprintf(stderr, "cooperative launch failed: %s (grid %d)\n", hipGetErrorString(e), grid_blocks);
}
```

```cpp
#include <hip/hip_runtime.h>
#include <hip/hip_cooperative_groups.h>
#include <cstdio>
#include <cstdint>
namespace cg = cooperative_groups;
__host__ __device__ __forceinline__ int rowbase(int pm) { return (pm >> 4) * 4224 + 128 + (pm & 15) * 256; }
namespace pg8 {
#define PG8_LAS __attribute__((address_space(3)))
typedef unsigned short bf16_t;
typedef short bf16x8 __attribute__((ext_vector_type(8)));
typedef float f32x4 __attribute__((ext_vector_type(4)));
typedef unsigned u32x4 __attribute__((ext_vector_type(4)));
constexpr int BM = 256, BK = 64, HALF = 128, HTB = HALF * BK * 2  , STAGE_BYTES = 8 * HTB, NXCD = 8, WGM = 8;

__host__ __device__ __forceinline__ int lds_byte(int r, int c) { const int st = (r >> 4) * 2 + (c >> 5), rr = r & 15, cc = c & 31, ob = rr * 64 + cc * 2; return st * 1024 + (ob ^ (((ob >> 9) & 1) << 5)); }
__host__ __device__ __forceinline__ void stage_rc(int b, int& R, int& C) { const int st = b / 1024, sb = b % 1024, swz = sb ^ (((sb >> 9) & 1) << 5); R = (st >> 1) * 16 + swz / 64; C = (st & 1) * 32 + (swz % 64) / 2; }
__host__ __device__ __forceinline__ int perm32(int rho) { const int n = rho >> 4, i = rho & 15; return 8 * (i >> 2) + 4 * n + (i & 3); }

struct Unit { int pm, pn; };
struct Gemm { const bf16_t* A; const bf16_t* Bt; int M, N, K; int compactA; };

struct StaticOrder {
    int nM, nN, nwg, G, c;
    __host__ __device__ void init(int M, int N, int G_, int c_) { nM = M / BM; nN = N / BM; nwg = nM * nN; G = G_; c = c_; }
    __host__ __device__ bool next(int i, Unit& u) const {
        const long L = (long)i * G + c; if (L >= nwg) return false;
        int wgid = (int)L; { const int q = nwg / NXCD, r = nwg % NXCD, xcd = wgid % NXCD, off = wgid / NXCD; wgid = (xcd < r ? xcd * (q + 1) : r * (q + 1) + (xcd - r) * q) + off; }
        const int nig = WGM * nN, gid = wgid / nig, fm = gid * WGM, gsz = (nM - fm) < WGM ? (nM - fm) : WGM;
        u.pm = fm + ((wgid % nig) % gsz); u.pn = (wgid % nig) / gsz; return true;
    }
    __device__ __forceinline__ void a_ready(const Unit&) const {}
    __device__ __forceinline__ void done(const Unit&) const {}
};

template <class Epi, class Sched, bool ALIGN_EPI = false, bool SP2 = false>
__device__ __forceinline__ void gemm_phase(PG8_LAS unsigned char* lds, const Gemm g, const Sched& S, const Epi& E) {
    int tid_l = threadIdx.x; asm volatile("" : "+v"(tid_l));
    const int tid = tid_l, wid = __builtin_amdgcn_readfirstlane(tid >> 6), lane = tid & 63, wr = wid >> 2, wc = wid & 3, fr = lane & 15, fq = lane >> 4;
    const int K = g.K, nt = K / BK;
    unsigned voffA[2], voffB[2];
#pragma unroll
    for (int i = 0; i < 2; ++i) { int R, C; stage_rc(tid * 16 + i * 8192, R, C); const int Rb = Epi::PERM ? ((R & ~31) + perm32(R & 31)) : R;
        voffA[i] = (unsigned)(R * K + C) * 2u; voffB[i] = (unsigned)(Rb * K + C) * 2u; }
    const size_t kstep = (size_t)(BK * 2);
    const size_t hstep = (size_t)HALF * K * 2;
    const size_t tstep = 2 * hstep;
    const unsigned ldsw = (unsigned)wid * 1024u;
    const int aoff = lds_byte(wr * 64 + fr, fq * 8), boff = lds_byte(wc * 32 + fr, fq * 8);
#define PG8_SA(b, h) (((b) * 2 + (h)) * HTB)
#define PG8_SB(b, h) ((4 + (b) * 2 + (h)) * HTB)
#define PG8_STAGE(bufoff, gbase, voff) do { _Pragma("unroll") for (int _i = 0; _i < 2; ++_i) \
        __builtin_amdgcn_global_load_lds((const unsigned*)((const char*)(gbase) + (voff)[_i]), (PG8_LAS unsigned*)(lds + (bufoff) + ldsw + _i * 8192), 16, 0, 0); } while (0)
#define PG8_LDA(dst, b, h) do { _Pragma("unroll") for (int m = 0; m < 4; ++m) _Pragma("unroll") for (int k = 0; k < 2; ++k) dst[m][k] = *(const PG8_LAS bf16x8*)(lds + PG8_SA(b, h) + aoff + m * 2048 + k * 1024); } while (0)
#define PG8_LDB(dst, b, h) do { _Pragma("unroll") for (int n = 0; n < 2; ++n) _Pragma("unroll") for (int k = 0; k < 2; ++k) dst[n][k] = *(const PG8_LAS bf16x8*)(lds + PG8_SB(b, h) + boff + n * 2048 + k * 1024); } while (0)
#define PG8_MMA(ai, bj, At, Bt) do { __builtin_amdgcn_s_setprio(1); _Pragma("unroll") for (int m = 0; m < 4; ++m) _Pragma("unroll") for (int n = 0; n < 2; ++n) _Pragma("unroll") for (int k = 0; k < 2; ++k) \
        acc[ai][bj][m][n] = __builtin_amdgcn_mfma_f32_16x16x32_bf16(Bt[n][k], At[m][k], acc[ai][bj][m][n], 0, 0, 0); __builtin_amdgcn_s_setprio(0); } while (0)
#define PG8_WAIT_V(n) asm volatile("s_waitcnt vmcnt(" #n ")" ::: "memory")
#define PG8_WAIT_L(n) asm volatile("s_waitcnt lgkmcnt(" #n ")" ::: "memory")
#define PG8_BAR __builtin_amdgcn_s_barrier()
#define PG8_SCHED __builtin_amdgcn_sched_barrier(0)
    Unit cur, nxt; int ui = 0;
    if (!S.next(0, cur)) return;
    f32x4 acc[2][2][4][2];
#pragma unroll
    for (int a = 0; a < 2; ++a)
#pragma unroll
        for (int b = 0; b < 2; ++b)
#pragma unroll
            for (int m = 0; m < 4; ++m)
#pragma unroll
                for (int n = 0; n < 2; ++n) acc[a][b][m][n] = (f32x4){0.f, 0.f, 0.f, 0.f};
    bf16x8 At[4][2], B0[2][2], B1[2][2];
    const char* cA = (const char*)g.A + (size_t)(g.compactA ? cur.pm * 256 : rowbase(cur.pm)) * (size_t)(K * 2); const char* cB = (const char*)g.Bt + (size_t)cur.pn * tstep;
    S.a_ready(cur);
    if constexpr (SP2) {
        PG8_STAGE(PG8_SB(0, 0), cB, voffB); PG8_STAGE(PG8_SB(0, 1), cB + hstep, voffB); PG8_STAGE(PG8_SA(0, 0), cA, voffA); PG8_STAGE(PG8_SA(0, 1), cA + hstep, voffA);
        if (wr == 1) PG8_BAR;
        PG8_WAIT_V(2); PG8_BAR;
        PG8_STAGE(PG8_SB(1, 0), cB + kstep, voffB); PG8_STAGE(PG8_SA(1, 0), cA + kstep, voffA); PG8_STAGE(PG8_SB(1, 1), cB + hstep + kstep, voffB);
        PG8_WAIT_V(6); PG8_BAR;
    } else {
        PG8_STAGE(PG8_SB(0, 0), cB, voffB); PG8_STAGE(PG8_SA(0, 0), cA, voffA); PG8_STAGE(PG8_SB(0, 1), cB + hstep, voffB); PG8_STAGE(PG8_SA(0, 1), cA + hstep, voffA);
        if (wr == 1) PG8_BAR;
        PG8_WAIT_V(4); PG8_BAR;
        PG8_STAGE(PG8_SB(1, 0), cB + kstep, voffB); PG8_STAGE(PG8_SA(1, 0), cA + kstep, voffA); PG8_STAGE(PG8_SB(1, 1), cB + hstep + kstep, voffB);
        PG8_WAIT_V(6); PG8_BAR;
    }
    for (;;) {
        const bool has_next = S.next(ui + 1, nxt);
        const char* nA = has_next ? (const char*)g.A + (size_t)(g.compactA ? nxt.pm * 256 : rowbase(nxt.pm)) * (size_t)(K * 2) : cA; const char* nB = has_next ? (const char*)g.Bt + (size_t)nxt.pn * tstep : cB;
        for (int t = 0; t < nt; t += 2) {
            const bool last = (t == nt - 2);
            const char* a1 = cA + (size_t)(t + 1) * kstep;
            const char* a2 = last ? nA : cA + (size_t)(t + 2) * kstep; const char* b2 = last ? nB : cB + (size_t)(t + 2) * kstep;
            const char* a3 = a2 + kstep; const char* b3 = b2 + kstep;
            if (last && has_next) S.a_ready(nxt);
            if constexpr (SP2) {
            PG8_LDB(B0, 0, 0); PG8_LDB(B1, 0, 1); PG8_SCHED; PG8_LDA(At, 0, 0); PG8_STAGE(PG8_SA(1, 1), a1 + hstep, voffA);
            PG8_WAIT_V(8); PG8_WAIT_L(0); PG8_BAR; PG8_MMA(0, 0, At, B0); PG8_MMA(0, 1, At, B1); PG8_BAR; PG8_SCHED;
            PG8_LDA(At, 0, 1); PG8_STAGE(PG8_SB(0, 0), b2, voffB); PG8_STAGE(PG8_SB(0, 1), b2 + hstep, voffB); PG8_STAGE(PG8_SA(0, 0), a2, voffA);
            PG8_WAIT_V(8); PG8_WAIT_L(0); PG8_BAR; PG8_MMA(1, 0, At, B0); PG8_MMA(1, 1, At, B1); PG8_BAR; PG8_SCHED;
            PG8_LDB(B0, 1, 0); PG8_LDB(B1, 1, 1); PG8_SCHED; PG8_LDA(At, 1, 0); PG8_STAGE(PG8_SA(0, 1), a2 + hstep, voffA);
            PG8_WAIT_V(8); PG8_WAIT_L(0); PG8_BAR; PG8_MMA(0, 0, At, B0); PG8_MMA(0, 1, At, B1); PG8_BAR; PG8_SCHED;
            PG8_LDA(At, 1, 1); PG8_STAGE(PG8_SB(1, 0), b3, voffB); PG8_STAGE(PG8_SB(1, 1), b3 + hstep, voffB); PG8_STAGE(PG8_SA(1, 0), a3, voffA);
            PG8_WAIT_V(8); PG8_WAIT_L(0); PG8_BAR; PG8_MMA(1, 0, At, B0); PG8_MMA(1, 1, At, B1); PG8_BAR; PG8_SCHED;
            } else {
            PG8_LDB(B0, 0, 0); PG8_SCHED; PG8_LDA(At, 0, 0); PG8_STAGE(PG8_SA(1, 1), a1 + hstep, voffA);
            PG8_WAIT_L(8); PG8_BAR; PG8_WAIT_L(0); PG8_MMA(0, 0, At, B0); PG8_BAR; PG8_SCHED;
            PG8_LDB(B1, 0, 1); PG8_STAGE(PG8_SB(0, 0), b2, voffB);
            PG8_BAR; PG8_WAIT_L(0); PG8_MMA(0, 1, At, B1); PG8_BAR;
            PG8_LDA(At, 0, 1); PG8_STAGE(PG8_SA(0, 0), a2, voffA);
            PG8_BAR; PG8_WAIT_L(0); PG8_MMA(1, 0, At, B0); PG8_BAR; PG8_SCHED;
            PG8_STAGE(PG8_SB(0, 1), b2 + hstep, voffB);
            PG8_WAIT_V(6); PG8_BAR; PG8_MMA(1, 1, At, B1); PG8_BAR;
            PG8_LDB(B0, 1, 0); PG8_SCHED; PG8_LDA(At, 1, 0); PG8_STAGE(PG8_SA(0, 1), a2 + hstep, voffA);
            PG8_WAIT_L(8); PG8_BAR; PG8_WAIT_L(0); PG8_MMA(0, 0, At, B0); PG8_BAR; PG8_SCHED;
            PG8_LDB(B1, 1, 1); PG8_STAGE(PG8_SB(1, 0), b3, voffB);
            PG8_BAR; PG8_WAIT_L(0); PG8_MMA(0, 1, At, B1); PG8_BAR;
            PG8_LDA(At, 1, 1); PG8_STAGE(PG8_SA(1, 0), a3, voffA);
            PG8_BAR; PG8_WAIT_L(0); PG8_MMA(1, 0, At, B0); PG8_BAR; PG8_SCHED;
            PG8_STAGE(PG8_SB(1, 1), b3 + hstep, voffB);
            PG8_WAIT_V(6); PG8_BAR; PG8_MMA(1, 1, At, B1); PG8_BAR;
            }
        }
        if constexpr (ALIGN_EPI) { if (wr == 0) PG8_BAR; }
        if constexpr (!Epi::AFTER_DRAIN) { E(acc, cur, wr, wc, fr, fq); S.done(cur); }
        if (!has_next) break;
#pragma unroll
        for (int a = 0; a < 2; ++a)
#pragma unroll
            for (int b = 0; b < 2; ++b)
#pragma unroll
                for (int m = 0; m < 4; ++m)
#pragma unroll
                    for (int n = 0; n < 2; ++n) acc[a][b][m][n] = (f32x4){0.f, 0.f, 0.f, 0.f};
        cur = nxt; cA = nA; cB = nB; ++ui;
        if constexpr (ALIGN_EPI) { if (wr == 1) PG8_BAR; }
    }
    PG8_WAIT_V(0);
    if constexpr (!ALIGN_EPI) { if (wr == 0) PG8_BAR; }
    PG8_BAR;
    if constexpr (Epi::AFTER_DRAIN) { E.fused(acc, cur, wr, wc, fr, fq, lds, wid, lane); S.done(cur); }
#undef PG8_SA
#undef PG8_SB
#undef PG8_STAGE
#undef PG8_LDA
#undef PG8_LDB
#undef PG8_MMA
#undef PG8_WAIT_V
#undef PG8_WAIT_L
#undef PG8_BAR
#undef PG8_SCHED
}
}

#define LAS __attribute__((address_space(3)))
typedef unsigned short bf16_t;
typedef short bf16x8 __attribute__((ext_vector_type(8)));
typedef short s16x4 __attribute__((ext_vector_type(4)));
typedef float f32x2 __attribute__((ext_vector_type(2)));
typedef float f32x4 __attribute__((ext_vector_type(4)));
typedef float f32x16 __attribute__((ext_vector_type(16)));
typedef unsigned u32x2 __attribute__((ext_vector_type(2)));
typedef unsigned u32x4 __attribute__((ext_vector_type(4)));
typedef __bf16 bf16x2v __attribute__((ext_vector_type(2)));

constexpr int DM = 1024, NB = 8, SEQ = 4096, NMETA = 16, PADF = 112, PP = 4224, RP = NB * PP, DFF = 4096;
constexpr int NTHR = 512;
constexpr int LDS_BYTES = 147456;
constexpr size_t UNIT = (size_t)RP * 1024 * 2;
constexpr size_t WS_R0 = 0, WS_R1 = 2 * UNIT, WS_R2 = 3 * UNIT, WS_R3 = 4 * UNIT, WS_R4 = 5 * UNIT;
constexpr size_t WS_WIN = 6 * UNIT;
constexpr size_t WS_WOUT = WS_WIN + (size_t)5120 * 1024 * 2;
constexpr size_t WS_W1 = WS_WOUT + (size_t)1024 * 2048 * 2;
constexpr size_t WS_W2 = WS_W1 + 2 * (size_t)4096 * 1024 * 2;
constexpr size_t WS_WQKV = WS_W2 + 2 * (size_t)4096 * 1024 * 2;
constexpr size_t WS_WO = WS_WQKV + (size_t)3072 * 1024 * 2;
constexpr size_t WS_ROPE = WS_WO + (size_t)1024 * 1024 * 2;
constexpr size_t WS_SS = WS_ROPE + (size_t)PP * 64 * 8;
constexpr size_t SS_BYTES = (size_t)RP * 16 * 4;
constexpr size_t WS_METAH = WS_SS + 4 * SS_BYTES;
constexpr size_t WS_HM1 = WS_METAH;
constexpr size_t WS_HIDM = WS_HM1 + (size_t)16 * 1024 * 4;
constexpr size_t WS_HM2P = WS_HIDM + (size_t)16 * 4096 * 4;
constexpr size_t WS_END = WS_HM2P + (size_t)4 * 16 * 1024 * 4 + 16384;

__device__ __forceinline__ unsigned pk2(float a, float b) { f32x2 v = {a, b}; bf16x2v r = __builtin_convertvector(v, bf16x2v); return __builtin_bit_cast(unsigned, r); }
__device__ __forceinline__ float bf_lo(unsigned u) { return __uint_as_float(u << 16); }
__device__ __forceinline__ float bf_hi(unsigned u) { return __uint_as_float(u & 0xffff0000u); }
__device__ __forceinline__ float wave_sum(float v) {
#pragma unroll
    for (int o = 1; o < 64; o <<= 1) v += __shfl_xor(v, o);
    return v;
}
__device__ __forceinline__ float rs_of(const float* ssp, int row) {
    const f32x4* s = (const f32x4*)(ssp + (size_t)row * 16);
    const f32x4 a = (s[0] + s[1]) + (s[2] + s[3]);
    return rsqrtf(((a.x + a.y) + (a.z + a.w)) * (1.0f / 1024.0f) + 1e-6f);
}
__device__ __forceinline__ float lg2gamma(int h) { return h == 0 ? -0.04580368961312479f : h == 1 ? -0.02272007650008353f : h == 2 ? -0.011315313227834146f : -0.005646563141142063f; }
__device__ __forceinline__ float fexp2(float x) { return __builtin_amdgcn_exp2f(x); }
__device__ __forceinline__ float frcp(float x) { return __builtin_amdgcn_rcpf(x); }
__device__ __forceinline__ float sigmoidf_(float x) { return frcp(1.0f + fexp2(-1.4426950408889634f * x)); }
__device__ __forceinline__ int crow(int r, int h) { return (r & 3) + 8 * (r >> 2) + 4 * h; }
#define MFMA32(a, b, c) __builtin_amdgcn_mfma_f32_32x32x16_bf16((a), (b), (c), 0, 0, 0)
#define LDS_WAIT() asm volatile("s_waitcnt lgkmcnt(0)" ::: "memory")

__device__ __forceinline__ int l2p_in(int c) {
    if (c < 1024) { const int blk = c >> 9, cc = c & 511, head = cc >> 7, dd = cc & 127, n = dd >> 6, rem = dd & 63, wc = rem >> 4, fq = (rem >> 2) & 3, i = rem & 3;
        return blk * 512 + (head >> 1) * 256 + (head & 1) * 128 + wc * 32 + fq * 8 + n * 4 + i; }
    if (c < 3072) return c;
    const int cu = c - 3072, n = cu >> 10, ch = cu & 1023, pu = ch >> 7, r = ch & 127, bj = r >> 6, r2 = r & 63, wc = r2 >> 4, fq = (r2 >> 2) & 3, i = r2 & 3;
    return 3072 + pu * 256 + bj * 128 + wc * 32 + fq * 8 + n * 4 + i;
}
__device__ __forceinline__ int l2p_qkv(int c) {
    const int blk = c >> 10, cc = c & 1023, head = cc >> 6, d = cc & 63, pnp = head >> 2, wc = head & 3, bj = d >> 5, fq = (d >> 3) & 3, n = (d >> 2) & 1, i = d & 3;
    return blk * 1024 + pnp * 256 + bj * 128 + wc * 32 + fq * 8 + n * 4 + i;
}

typedef f32x4 AccT[2][2][4][2];

constexpr int RS_TAB_OFF = 140288;
struct RsIssue { f32x4 a0, a1; int row, half; };
__device__ __forceinline__ RsIssue rs_tab_issue(const float* ssp, int rb, int wr, int wc, int fr, int fq) {
    RsIssue r; const int t = (wr * 4 + wc) * 64 + fq * 16 + fr; r.row = t >> 1; r.half = t & 1;
    const f32x4* sp = (const f32x4*)(ssp + (size_t)(rb + r.row) * 16 + r.half * 8);
    r.a0 = sp[0]; r.a1 = sp[1]; return r;
}
__device__ __forceinline__ void rs_tab_finish(const RsIssue& r, LAS float* tab) {
    const f32x4 a = r.a0 + r.a1;
    float sum = (a.x + a.y) + (a.z + a.w);
    sum += __shfl_xor(sum, 1);
    if (!r.half) tab[r.row] = rsqrtf(sum * (1.0f / 1024.0f) + 1e-6f);
    asm volatile("s_waitcnt lgkmcnt(0)" ::: "memory"); __builtin_amdgcn_s_barrier(); asm volatile("" ::: "memory");
}

struct EpiIn {
    static constexpr bool PERM = true, AFTER_DRAIN = false;
    const float* rsv; bf16_t *qk, *v, *gs, *hdn;
    __device__ __forceinline__ void operator()(const AccT& acc, const pg8::Unit& u, int wr, int wc, int fr, int fq) const {
        const int pn = u.pn, rb = rowbase(u.pm), pb = 128 + (u.pm & 15) * 256;
        float rsr[2][4];
#pragma unroll
        for (int ai = 0; ai < 2; ++ai)
#pragma unroll
            for (int m = 0; m < 4; ++m) rsr[ai][m] = rsv[rb + ai * 128 + wr * 64 + m * 16 + fr];
        float invf[4];
#pragma unroll
        for (int i = 0; i < 4; ++i) invf[i] = exp2f(-(float)(16 * wc + 4 * fq + i) * 0.20762050593046014f);
#pragma unroll
        for (int ai = 0; ai < 2; ++ai)
#pragma unroll
            for (int m = 0; m < 4; ++m) {
                const int loc = ai * 128 + wr * 64 + m * 16 + fr;
                const int row = rb + loc, p = pb + loc;
                const float rs = rsr[ai][m];
                if (pn < 4) {
                    float cs[4], sn[4];
#pragma unroll
                    for (int i = 0; i < 4; ++i) {
                        const float ang = (float)p * invf[i];
                        const float nrev = rintf(ang * 0.15915493667125702f);
                        float r = fmaf(ang, 0.15915493667125702f, -nrev); r = fmaf(ang, 6.4206382432985265e-09f, r);
                        cs[i] = __builtin_amdgcn_cosf(r); sn[i] = __builtin_amdgcn_sinf(r);
                    }
                    const float ip1 = (float)((p & 127) + 1);
#pragma unroll
                    for (int bj = 0; bj < 2; ++bj) {
                        const int head = 2 * (pn & 1) + bj;
                        const float lg = lg2gamma(head);
                        const float fac = (pn < 2) ? fexp2(ip1 * lg) : fexp2(-ip1 * lg) * 0.08838834764831845f;
                        const f32x4 x1 = acc[ai][bj][m][0] * rs, x2 = acc[ai][bj][m][1] * rs;
                        float y1[4], y2[4];
#pragma unroll
                        for (int i = 0; i < 4; ++i) { y1[i] = (x1[i] * cs[i] - x2[i] * sn[i]) * fac; y2[i] = (x1[i] * sn[i] + x2[i] * cs[i]) * fac; }
                        u32x4 w; w.x = pk2(y1[0], y1[1]); w.y = pk2(y1[2], y1[3]); w.z = pk2(y2[0], y2[1]); w.w = pk2(y2[2], y2[3]);
                        *(u32x4*)(qk + (size_t)row * 1024 + 256 * pn + 128 * bj + 32 * wc + 8 * fq) = w;
                    }
                } else if (pn < 8) {
#pragma unroll
                    for (int bj = 0; bj < 2; ++bj) {
                        const f32x4 a = acc[ai][bj][m][0] * rs, b = acc[ai][bj][m][1] * rs;
                        u32x4 w; w.x = pk2(a[0], a[1]); w.y = pk2(a[2], a[3]); w.z = pk2(b[0], b[1]); w.w = pk2(b[2], b[3]);
                        *(u32x4*)(v + (size_t)row * 1024 + 256 * (pn - 4) + 128 * bj + 32 * wc + 8 * fq) = w;
                    }
                } else if (pn < 12) {
#pragma unroll
                    for (int bj = 0; bj < 2; ++bj) {
                        f32x4 a = acc[ai][bj][m][0] * rs, b = acc[ai][bj][m][1] * rs;
#pragma unroll
                        for (int i = 0; i < 4; ++i) { a[i] = a[i] * sigmoidf_(a[i]); b[i] = b[i] * sigmoidf_(b[i]); }
                        u32x4 w; w.x = pk2(a[0], a[1]); w.y = pk2(a[2], a[3]); w.z = pk2(b[0], b[1]); w.w = pk2(b[2], b[3]);
                        *(u32x4*)(gs + (size_t)row * 1024 + 256 * (pn - 8) + 128 * bj + 32 * wc + 8 * fq) = w;
                    }
                } else {
#pragma unroll
                    for (int bj = 0; bj < 2; ++bj) {
                        const f32x4 a = acc[ai][bj][m][0] * rs, g = acc[ai][bj][m][1] * rs;
                        float o[4];
#pragma unroll
                        for (int i = 0; i < 4; ++i) o[i] = a[i] * sigmoidf_(g[i]);
                        u32x2 w; w.x = pk2(o[0], o[1]); w.y = pk2(o[2], o[3]);
                        *(u32x2*)(hdn + (size_t)row * 1024 + 128 * (pn - 12) + 64 * bj + 16 * wc + 4 * fq) = w;
                    }
                }
            }
    }
};

template <int BASE  , bool OUT_F32>
struct EpiRes {
    static constexpr bool PERM = true, AFTER_DRAIN = false;
    const float* bx; float* ox; bf16_t* hb; float* ssp;
    __device__ __forceinline__ void operator()(const AccT& acc, const pg8::Unit& u, int wr, int wc, int fr, int fq) const {
        const int col0 = u.pn * 256 + wc * 32 + 8 * fq, rb = rowbase(u.pm);
        if (BASE == 0) {
#pragma unroll
            for (int ai = 0; ai < 2; ++ai) {
                f32x4 base[4][2][2];
#pragma unroll
                for (int m = 0; m < 4; ++m) { const size_t off = (size_t)(u.pm * 256 + ai * 128 + wr * 64 + m * 16 + fr) * DM;
#pragma unroll
                    for (int bj = 0; bj < 2; ++bj) { base[m][bj][0] = *(const f32x4*)(bx + off + col0 + 128 * bj); base[m][bj][1] = *(const f32x4*)(bx + off + col0 + 128 * bj + 4); } }
#pragma unroll
                for (int m = 0; m < 4; ++m) {
                    const int row = rb + ai * 128 + wr * 64 + m * 16 + fr;
                    float ss = 0.f;
#pragma unroll
                    for (int bj = 0; bj < 2; ++bj) {
                        const f32x4 h0 = base[m][bj][0] + acc[ai][bj][m][0], h1 = base[m][bj][1] + acc[ai][bj][m][1];
                        ss += (h0[0] * h0[0] + h0[1] * h0[1]) + (h0[2] * h0[2] + h0[3] * h0[3]) + (h1[0] * h1[0] + h1[1] * h1[1]) + (h1[2] * h1[2] + h1[3] * h1[3]);
                        u32x4 w; w.x = pk2(h0[0], h0[1]); w.y = pk2(h0[2], h0[3]); w.z = pk2(h1[0], h1[1]); w.w = pk2(h1[2], h1[3]);
                        *(u32x4*)(hb + (size_t)row * 1024 + col0 + 128 * bj) = w;
                    }
                    ss += __shfl_xor(ss, 16); ss += __shfl_xor(ss, 32);
                    if (fq == 0) ssp[(size_t)row * 16 + u.pn * 4 + wc] = ss;
                }
            }
        } else {
            u32x4 base[2][4][2];
#pragma unroll
            for (int ai = 0; ai < 2; ++ai)
#pragma unroll
                for (int m = 0; m < 4; ++m) { const int row = rb + ai * 128 + wr * 64 + m * 16 + fr;
                    const bf16_t* bsrc = (BASE == 2) ? (const bf16_t*)bx + (size_t)(u.pm * 256 + ai * 128 + wr * 64 + m * 16 + fr) * 1024 : hb + (size_t)row * 1024;
#pragma unroll
                    for (int bj = 0; bj < 2; ++bj) base[ai][m][bj] = *(const u32x4*)(bsrc + col0 + 128 * bj); }
#pragma unroll
            for (int ai = 0; ai < 2; ++ai)
#pragma unroll
                for (int m = 0; m < 4; ++m) {
                    const int loc = ai * 128 + wr * 64 + m * 16 + fr, row = rb + loc;
                    const size_t off = (size_t)(u.pm * 256 + loc) * DM;
                    float ss = 0.f;
#pragma unroll
                    for (int bj = 0; bj < 2; ++bj) {
                        const u32x4 bv = base[ai][m][bj];
                        const f32x4 h0 = (f32x4){bf_lo(bv.x), bf_hi(bv.x), bf_lo(bv.y), bf_hi(bv.y)} + acc[ai][bj][m][0];
                        const f32x4 h1 = (f32x4){bf_lo(bv.z), bf_hi(bv.z), bf_lo(bv.w), bf_hi(bv.w)} + acc[ai][bj][m][1];
                        if (OUT_F32) {
                            *(f32x4*)(ox + off + col0 + 128 * bj) = h0;
                            *(f32x4*)(ox + off + col0 + 128 * bj + 4) = h1;
                        } else {
                            ss += (h0[0] * h0[0] + h0[1] * h0[1]) + (h0[2] * h0[2] + h0[3] * h0[3]) + (h1[0] * h1[0] + h1[1] * h1[1]) + (h1[2] * h1[2] + h1[3] * h1[3]);
                            u32x4 w; w.x = pk2(h0[0], h0[1]); w.y = pk2(h0[2], h0[3]); w.z = pk2(h1[0], h1[1]); w.w = pk2(h1[2], h1[3]);
                            *(u32x4*)(hb + (size_t)row * 1024 + col0 + 128 * bj) = w;
                        }
                    }
                    if (!OUT_F32) {
                        ss += __shfl_xor(ss, 16); ss += __shfl_xor(ss, 32);
                        if (fq == 0) ssp[(size_t)row * 16 + u.pn * 4 + wc] = ss;
                    }
                }
        }
    }
};

struct EpiUp {
    static constexpr bool PERM = true, AFTER_DRAIN = false;
    const float* ssp; bf16_t* hid; LAS float* tab;
    __device__ __forceinline__ void operator()(const AccT& acc_, const pg8::Unit& u, int wr, int wc, int fr, int fq) const {
        AccT& acc = const_cast<AccT&>(acc_);
        const int col0 = u.pn * 256 + wc * 32 + 8 * fq, rb = rowbase(u.pm);
        const RsIssue ri = rs_tab_issue(ssp, rb, wr, wc, fr, fq);
#pragma unroll
        for (int ai = 0; ai < 2; ++ai)
#pragma unroll
            for (int bj = 0; bj < 2; ++bj)
#pragma unroll
                for (int m = 0; m < 4; ++m)
#pragma unroll
                    for (int n = 0; n < 2; ++n) { f32x4 t = acc[ai][bj][m][n];
#pragma unroll
                        for (int i = 0; i < 4; ++i) t[i] = fmaxf(t[i], 0.f);
                        acc[ai][bj][m][n] = t * t; }
        rs_tab_finish(ri, tab);
#pragma unroll
        for (int ai = 0; ai < 2; ++ai)
#pragma unroll
            for (int m = 0; m < 4; ++m) {
                const int loc = ai * 128 + wr * 64 + m * 16 + fr, row = rb + loc;
                const float rs = tab[loc], rs2 = rs * rs;
#pragma unroll
                for (int bj = 0; bj < 2; ++bj) {
                    const f32x4 a = acc[ai][bj][m][0] * rs2, b = acc[ai][bj][m][1] * rs2;
                    u32x4 w; w.x = pk2(a[0], a[1]); w.y = pk2(a[2], a[3]); w.z = pk2(b[0], b[1]); w.w = pk2(b[2], b[3]);
                    *(u32x4*)(hid + (size_t)row * DFF + col0 + 128 * bj) = w;
                }
            }
    }
};

struct EpiQkv {
    static constexpr bool PERM = true, AFTER_DRAIN = false;
    const float* ssp; const float* qg; const float* kg; bf16_t* qkv; LAS float* tab;
    __device__ __forceinline__ void operator()(const AccT& acc, const pg8::Unit& u, int wr, int wc, int fr, int fq) const {
        const int blk = u.pn >> 2, head = 4 * (u.pn & 3) + wc, rb = rowbase(u.pm);
        bf16_t* dst = qkv + (size_t)blk * (UNIT / 2);
        const float* gg = blk == 0 ? qg : kg;
        const f32x4 g00 = *(const f32x4*)(gg + 8 * fq), g01 = *(const f32x4*)(gg + 8 * fq + 4), g10 = *(const f32x4*)(gg + 32 + 8 * fq), g11 = *(const f32x4*)(gg + 32 + 8 * fq + 4);
        const RsIssue ri = rs_tab_issue(ssp, rb, wr, wc, fr, fq);
        float ssr[2][4];
#pragma unroll
        for (int ai = 0; ai < 2; ++ai)
#pragma unroll
            for (int m = 0; m < 4; ++m) {
                const f32x4 t = acc[ai][0][m][0] * acc[ai][0][m][0] + acc[ai][0][m][1] * acc[ai][0][m][1] + acc[ai][1][m][0] * acc[ai][1][m][0] + acc[ai][1][m][1] * acc[ai][1][m][1];
                float ss = (t[0] + t[1]) + (t[2] + t[3]);
                ss += __shfl_xor(ss, 16); ss += __shfl_xor(ss, 32);
                ssr[ai][m] = ss;
            }
        rs_tab_finish(ri, tab);
        const float post = blk == 0 ? 0.18033688011112042f : 1.0f;
#pragma unroll
        for (int ai = 0; ai < 2; ++ai)
#pragma unroll
            for (int m = 0; m < 4; ++m) {
                const int loc = ai * 128 + wr * 64 + m * 16 + fr, row = rb + loc;
                const float rs = tab[loc];
                f32x4 v00 = acc[ai][0][m][0], v01 = acc[ai][0][m][1], v10 = acc[ai][1][m][0], v11 = acc[ai][1][m][1];
                if (blk < 2) {
                    const float sc = rs * rsqrtf(rs * rs * ssr[ai][m] * (1.0f / 64.0f) + 1e-6f) * post;
                    v00 = v00 * sc * g00; v01 = v01 * sc * g01; v10 = v10 * sc * g10; v11 = v11 * sc * g11;
                } else { v00 = v00 * rs; v01 = v01 * rs; v10 = v10 * rs; v11 = v11 * rs; }
                u32x4 w0, w1;
                w0.x = pk2(v00[0], v00[1]); w0.y = pk2(v00[2], v00[3]); w0.z = pk2(v01[0], v01[1]); w0.w = pk2(v01[2], v01[3]);
                w1.x = pk2(v10[0], v10[1]); w1.y = pk2(v10[2], v10[3]); w1.z = pk2(v11[0], v11[1]); w1.w = pk2(v11[2], v11[3]);
                *(u32x4*)(dst + (size_t)row * 1024 + head * 64 + 8 * fq) = w0;
                *(u32x4*)(dst + (size_t)row * 1024 + head * 64 + 32 + 8 * fq) = w1;
            }
    }
};

struct Params {
    const float *x, *meta, *norm_mix_g, *norm_mlp_g, *even_w_in, *even_gn_g, *even_conv_w, *even_conv_b, *even_ln_g, *even_ln_b, *even_w_out,
        *odd_w_qkv, *odd_qn_g, *odd_kn_g, *odd_w_o, *mlp_w1, *mlp_w2;
    float* out; unsigned char* ws;
};
typedef const __attribute__((address_space(4))) Params CParams;
__device__ __forceinline__ CParams* kparams() { CParams* kp = (CParams*)__builtin_amdgcn_kernarg_segment_ptr(); asm volatile("" : "+s"(kp)); return kp; }
#define KP (*kparams())

template <int MODE>
__device__ __forceinline__ void p0_transpose_item(const float* W, int K, int N, bf16_t* WT, const float* gain, LAS float* scr, int item, int lane) {
    const int nblk = N / 32, kb = item / nblk, nb = item % nblk, k0 = 64 * kb, n0 = 32 * nb;
    float wv[32];
#pragma unroll
    for (int i = 0; i < 32; ++i) wv[i] = W[(size_t)(k0 + 2 * i + (lane >> 5)) * N + n0 + (lane & 31)];
#pragma unroll
    for (int i = 0; i < 32; ++i) { const int kk = 2 * i + (lane >> 5); float w = wv[i]; if (gain) w *= gain[k0 + kk]; scr[kk * 33 + (lane & 31)] = w; }
    LDS_WAIT();
    const int c = lane & 7;
#pragma unroll
    for (int j = 0; j < 4; ++j) { const int n = (lane >> 3) + 8 * j; const LAS float* s = scr + (8 * c) * 33 + n;
        const int lc = n0 + n; const int prow = MODE == 1 ? l2p_in(lc) : (MODE == 2 ? l2p_qkv(lc) : lc);
        u32x4 o; o.x = pk2(s[0 * 33], s[1 * 33]); o.y = pk2(s[2 * 33], s[3 * 33]); o.z = pk2(s[4 * 33], s[5 * 33]); o.w = pk2(s[6 * 33], s[7 * 33]);
        *(u32x4*)(WT + (size_t)prow * K + k0 + 8 * c) = o; }
    LDS_WAIT();
}

__device__ __forceinline__ void phase0(CParams& P, LAS unsigned char* lds, int tid) {
    const int lane = tid & 63, wave = tid >> 6;
    const int gw = blockIdx.x * 8 + wave, NGW = gridDim.x * 8;
    LAS float* scr = (LAS float*)(lds + wave * 16384);
    unsigned char* ws = P.ws;
    constexpr int I_IN = 16 * 160, I_OUT = 32 * 32, I_W1 = 16 * 128, I_W2 = 64 * 32, I_QKV = 16 * 96, I_O = 16 * 32;
    constexpr int NITEMS = I_IN + I_OUT + 2 * I_W1 + 2 * I_W2 + I_QKV + I_O;
    for (int it = gw; it < NITEMS; it += NGW) {
        int r = it;
        if (r < I_IN) { p0_transpose_item<1>(P.even_w_in, 1024, 5120, (bf16_t*)(ws + WS_WIN), P.norm_mix_g, scr, r, lane); continue; } r -= I_IN;
        if (r < I_OUT) { p0_transpose_item<0>(P.even_w_out, 2048, 1024, (bf16_t*)(ws + WS_WOUT), nullptr, scr, r, lane); continue; } r -= I_OUT;
        if (r < I_W1) { p0_transpose_item<0>(P.mlp_w1, 1024, 4096, (bf16_t*)(ws + WS_W1), P.norm_mlp_g, scr, r, lane); continue; } r -= I_W1;
        if (r < I_W1) { p0_transpose_item<0>(P.mlp_w1 + (size_t)1024 * 4096, 1024, 4096, (bf16_t*)(ws + WS_W1) + (size_t)4096 * 1024, P.norm_mlp_g + 1024, scr, r, lane); continue; } r -= I_W1;
        if (r < I_W2) { p0_transpose_item<0>(P.mlp_w2, 4096, 1024, (bf16_t*)(ws + WS_W2), nullptr, scr, r, lane); continue; } r -= I_W2;
        if (r < I_W2) { p0_transpose_item<0>(P.mlp_w2 + (size_t)1024 * 4096, 4096, 1024, (bf16_t*)(ws + WS_W2) + (size_t)4096 * 1024, nullptr, scr, r, lane); continue; } r -= I_W2;
        if (r < I_QKV) { p0_transpose_item<2>(P.odd_w_qkv, 1024, 3072, (bf16_t*)(ws + WS_WQKV), P.norm_mix_g + 1024, scr, r, lane); continue; } r -= I_QKV;
        p0_transpose_item<0>(P.odd_w_o, 1024, 1024, (bf16_t*)(ws + WS_WO), nullptr, scr, r, lane);
    }
    float* rope = (float*)(ws + WS_ROPE);
    for (int i = blockIdx.x * NTHR + tid; i < PP * 64; i += gridDim.x * NTHR) {
        const int p = i >> 6, d = i & 63;
        const float inv = exp2f(-(float)d * 0.20762050593046014f);
        const float ang = (float)p * inv;
        double t = (double)ang * 0.15915494309189535; t -= floor(t);
        const float tf = (float)t;
        rope[2 * i] = __builtin_amdgcn_cosf(tf); rope[2 * i + 1] = __builtin_amdgcn_sinf(tf);
    }
    bf16_t* hb = (bf16_t*)P.out + (size_t)NB * SEQ * DM;
    float* rs0 = (float*)(ws + WS_SS);
    for (int m0 = 2 * gw; m0 < NB * SEQ; m0 += 2 * NGW) {
        f32x4 v[2][4];
#pragma unroll
        for (int q = 0; q < 2; ++q) { const f32x4* xr = (const f32x4*)(P.x + (size_t)(m0 + q) * DM) + lane;
#pragma unroll
            for (int j = 0; j < 4; ++j) v[q][j] = xr[64 * j]; }
#pragma unroll
        for (int q = 0; q < 2; ++q) {
            const int m = m0 + q, row = rowbase(m >> 8) + (m & 255);
            u32x2* o8 = (u32x2*)(hb + (size_t)m * 1024) + lane;
            float ss = 0.f;
#pragma unroll
            for (int j = 0; j < 4; ++j) { const f32x4 t = v[q][j]; ss += (t.x * t.x + t.y * t.y) + (t.z * t.z + t.w * t.w); u32x2 w; w.x = pk2(t.x, t.y); w.y = pk2(t.z, t.w); o8[64 * j] = w; }
            ss = wave_sum(ss);
            if (lane == 0) rs0[row] = rsqrtf(ss * (1.0f / 1024.0f) + 1e-6f);
        }
    }
    for (int i = gw; i < NB * PADF; i += NGW) {
        const int b = i / PADF, p = i - b * PADF; const size_t row = (size_t)b * PP + p;
        const u32x4 z = (u32x4){0u, 0u, 0u, 0u};
        u32x4* d4 = (u32x4*)(ws + WS_R4 + row * 2048) + lane; d4[0] = z; d4[64] = z;
        u32x4* d1 = (u32x4*)(ws + WS_R1 + row * 2048) + lane; d1[0] = z; d1[64] = z;
        u32x4* d3 = (u32x4*)(ws + WS_R3 + row * 2048) + lane; d3[0] = z; d3[64] = z;
    }
}

template <int NCOL, bool ABF, bool NORM, int UNR = 2>
__device__ __forceinline__ void meta_wave(const void* Aptr, int K, const bf16_t* Wt, const int (&wrow)[NCOL], int w, int lane, float (&out)[2][NCOL], float (&rs)[2]) {
    float q0 = 0.f, q1 = 0.f;
#pragma unroll
    for (int c = 0; c < NCOL; ++c) { out[0][c] = 0.f; out[1][c] = 0.f; }
#pragma unroll UNR
    for (int kc = lane; kc < (K >> 3); kc += 64) {
        float a0[8], a1[8];
        if (ABF) {
            const u32x4 u0 = *(const u32x4*)((const bf16_t*)Aptr + (size_t)(2 * w) * K + 8 * kc), u1 = *(const u32x4*)((const bf16_t*)Aptr + (size_t)(2 * w + 1) * K + 8 * kc);
            a0[0] = bf_lo(u0.x); a0[1] = bf_hi(u0.x); a0[2] = bf_lo(u0.y); a0[3] = bf_hi(u0.y); a0[4] = bf_lo(u0.z); a0[5] = bf_hi(u0.z); a0[6] = bf_lo(u0.w); a0[7] = bf_hi(u0.w);
            a1[0] = bf_lo(u1.x); a1[1] = bf_hi(u1.x); a1[2] = bf_lo(u1.y); a1[3] = bf_hi(u1.y); a1[4] = bf_lo(u1.z); a1[5] = bf_hi(u1.z); a1[6] = bf_lo(u1.w); a1[7] = bf_hi(u1.w);
        } else {
            const f32x4* p0 = (const f32x4*)((const float*)Aptr + (size_t)(2 * w) * K + 8 * kc); const f32x4* p1 = (const f32x4*)((const float*)Aptr + (size_t)(2 * w + 1) * K + 8 * kc);
            const f32x4 x0 = p0[0], x1 = p0[1], y0 = p1[0], y1 = p1[1];
#pragma unroll
            for (int i = 0; i < 4; ++i) { a0[i] = x0[i]; a0[4 + i] = x1[i]; a1[i] = y0[i]; a1[4 + i] = y1[i]; }
        }
        if (NORM) {
#pragma unroll
            for (int i = 0; i < 8; ++i) { q0 += a0[i] * a0[i]; q1 += a1[i] * a1[i]; }
        }
#pragma unroll
        for (int c = 0; c < NCOL; ++c) {
            const u32x4 wv = *(const u32x4*)(Wt + (size_t)wrow[c] * K + 8 * kc);
            const float wf[8] = {bf_lo(wv.x), bf_hi(wv.x), bf_lo(wv.y), bf_hi(wv.y), bf_lo(wv.z), bf_hi(wv.z), bf_lo(wv.w), bf_hi(wv.w)};
#pragma unroll
            for (int i = 0; i < 8; ++i) { out[0][c] += a0[i] * wf[i]; out[1][c] += a1[i] * wf[i]; }
        }
    }
#pragma unroll
    for (int c = 0; c < NCOL; ++c) { out[0][c] = wave_sum(out[0][c]); out[1][c] = wave_sum(out[1][c]); }
    if (NORM) { rs[0] = rsqrtf(wave_sum(q0) / (float)K + 1e-6f); rs[1] = rsqrtf(wave_sum(q1) / (float)K + 1e-6f); } else { rs[0] = 1.f; rs[1] = 1.f; }
}
template <int NN>
__device__ __forceinline__ float pick(LAS float* scr, const float (&a)[NN], int j, int lane) {
    if (lane == 0) {
#pragma unroll
        for (int i = 0; i < NN; ++i) scr[i] = a[i];
    }
    LDS_WAIT();
    const float r = scr[j];
    LDS_WAIT();
    return r;
}
__device__ __forceinline__ bf16_t bf1(float x) { return (bf16_t)(pk2(x, 0.f) & 0xffffu); }
__device__ __forceinline__ void store_meta_rows(bf16_t* buf, int r, int col, float val) {
    const bf16_t bv = bf1(val);
#pragma unroll
    for (int b = 0; b < NB; ++b) buf[((size_t)b * PP + PADF + r) * 1024 + col] = bv;
}
__device__ __forceinline__ void meta_in(CParams& P, LAS unsigned char* lds, int t, int tid) {
    const int lane = tid & 63, w = __builtin_amdgcn_readfirstlane(tid >> 6); int cb1, cb2, kind;
    if (t < 64) { const int pid = t * 8, blk = pid >> 8, head = (pid >> 6) & 3, d = pid & 63; kind = blk; cb1 = blk * 512 + head * 128 + d; cb2 = cb1 + 64; }
    else if (t < 192) { cb1 = 1024 + (t - 64) * 16; cb2 = cb1 + 8; kind = cb1 < 2048 ? 2 : 3; }
    else { kind = 4; cb1 = 3072 + (t - 192) * 8; cb2 = cb1 + 1024; }
    float o[2][16], rsv[2];
    int wrow[16];
#pragma unroll
    for (int c = 0; c < 8; ++c) { wrow[c] = l2p_in(cb1 + c); wrow[8 + c] = l2p_in(cb2 + c); }
    meta_wave<16, false, true>(P.meta, 1024, (const bf16_t*)(P.ws + WS_WIN), wrow, w, lane, o, rsv);
    unsigned char* ws = P.ws;
    const int j = lane & 7;
#pragma unroll
    for (int i = 0; i < 2; ++i) {
        const int r = 2 * w + i, p = PADF + r;
        if (kind <= 1 || kind == 4) {
            float lo8[8], hi8[8];
#pragma unroll
            for (int c = 0; c < 8; ++c) { lo8[c] = o[i][c]; hi8[c] = o[i][8 + c]; }
            const float y1 = pick<8>((LAS float*)(lds + 131072 + w * 1024), lo8, j, lane) * rsv[i], y2 = pick<8>((LAS float*)(lds + 131072 + w * 1024), hi8, j, lane) * rsv[i];
            if (lane < 8) {
                if (kind <= 1) {
                    const int head = (cb1 >> 7) & 3, d = (cb1 & 63) + j;
                    const float* rope = (const float*)(ws + WS_ROPE) + ((size_t)p * 64 + d) * 2;
                    const float c = rope[0], sn = rope[1];
                    const float ip1 = (float)(p + 1), lg = lg2gamma(head);
                    const float fac = kind == 0 ? fexp2(ip1 * lg) : fexp2(-ip1 * lg) * 0.08838834764831845f;
                    store_meta_rows((bf16_t*)(ws + WS_R4), r, l2p_in(cb1 + j), (y1 * c - y2 * sn) * fac);
                    store_meta_rows((bf16_t*)(ws + WS_R4), r, l2p_in(cb2 + j), (y1 * sn + y2 * c) * fac);
                } else {
                    store_meta_rows((bf16_t*)(ws + WS_R3), r, cb1 - 3072 + j, y1 * sigmoidf_(y2));
                }
            }
        } else {
            const float y = pick<16>((LAS float*)(lds + 131072 + w * 1024), o[i], lane & 15, lane) * rsv[i];
            if (lane < 16) {
                if (kind == 2) store_meta_rows((bf16_t*)(ws + WS_R1), r, cb1 - 1024 + lane, y);
                else store_meta_rows((bf16_t*)(ws + WS_R2), r, cb1 - 2048 + lane, y * sigmoidf_(y));
            }
        }
    }
}
__device__ __forceinline__ void meta_out(CParams& P, LAS unsigned char* lds, int t, int tid) {
    const int lane = tid & 63, w = __builtin_amdgcn_readfirstlane(tid >> 6);
    float o[2][4], rsv[2];
    const int wrow[4] = {4 * t, 4 * t + 1, 4 * t + 2, 4 * t + 3};
    meta_wave<4, true, false, 4>((const bf16_t*)(P.ws + WS_R0) + (size_t)PADF * 2048, 2048, (const bf16_t*)(P.ws + WS_WOUT), wrow, w, lane, o, rsv);
    float* hm1 = (float*)(P.ws + WS_HM1);
#pragma unroll
    for (int i = 0; i < 2; ++i) { const int r = 2 * w + i; const float y = pick<4>((LAS float*)(lds + 131072 + w * 1024), o[i], lane & 3, lane); if (lane < 4) hm1[r * 1024 + 4 * t + lane] = P.meta[r * 1024 + 4 * t + lane] + y; }
}
__device__ __forceinline__ void meta_up(CParams& P, LAS unsigned char* lds, int t, int tid) {
    const int lane = tid & 63, w = __builtin_amdgcn_readfirstlane(tid >> 6);
    float o[2][16], rsv[2];
    int wrow[16];
#pragma unroll
    for (int c = 0; c < 16; ++c) wrow[c] = 16 * t + c;
    meta_wave<16, false, true>((const float*)(P.ws + WS_HM1), 1024, (const bf16_t*)(P.ws + WS_W1), wrow, w, lane, o, rsv);
    float* hid = (float*)(P.ws + WS_HIDM);
#pragma unroll
    for (int i = 0; i < 2; ++i) { const int r = 2 * w + i; const float x = fmaxf(pick<16>((LAS float*)(lds + 131072 + w * 1024), o[i], lane & 15, lane) * rsv[i], 0.f); if (lane < 16) hid[r * 4096 + 16 * t + lane] = x * x; }
}
__device__ __forceinline__ void meta_down(CParams& P, LAS unsigned char* lds, int t, int tid) {
    const int lane = tid & 63, w = __builtin_amdgcn_readfirstlane(tid >> 6);
    float o[2][4], rsv[2];
    const int wrow[4] = {4 * t, 4 * t + 1, 4 * t + 2, 4 * t + 3};
    meta_wave<4, false, false, 4>((const float*)(P.ws + WS_HIDM), 4096, (const bf16_t*)(P.ws + WS_W2), wrow, w, lane, o, rsv);
    const float* hm1 = (const float*)(P.ws + WS_HM1);
    float* hm2 = (float*)(P.ws + WS_HM2P);
#pragma unroll
    for (int i = 0; i < 2; ++i) { const int r = 2 * w + i; const float y = pick<4>((LAS float*)(lds + 131072 + w * 1024), o[i], lane & 3, lane); if (lane < 4) hm2[r * 1024 + 4 * t + lane] = hm1[r * 1024 + 4 * t + lane] + y; }
}
constexpr size_t WS_KRAW = WS_HIDM, WS_VRAW = WS_HIDM + 65536, WS_KSS = WS_HIDM + 131072;
__device__ __forceinline__ void meta_kv(CParams& P, LAS unsigned char* lds, int t, int tid) {
    const int lane = tid & 63, w = __builtin_amdgcn_readfirstlane(tid >> 6);
    const int cb = 1024 + 16 * t;
    float o[2][16], rsv[2];
    int wrow[16];
#pragma unroll
    for (int c = 0; c < 16; ++c) wrow[c] = l2p_qkv(cb + c);
    meta_wave<16, false, true>((const float*)(P.ws + WS_HM2P), 1024, (const bf16_t*)(P.ws + WS_WQKV), wrow, w, lane, o, rsv);
    float* raw = (float*)(P.ws + (t < 64 ? WS_KRAW : WS_VRAW));
    float* kss = (float*)(P.ws + WS_KSS);
#pragma unroll
    for (int i = 0; i < 2; ++i) {
        const int r = 2 * w + i; float ss = 0.f;
#pragma unroll
        for (int c = 0; c < 16; ++c) { o[i][c] *= rsv[i]; ss += o[i][c] * o[i][c]; }
        const float y = pick<16>((LAS float*)(lds + 131072 + w * 1024), o[i], lane & 15, lane);
        if (lane < 16) raw[r * 1024 + 16 * (t & 63) + lane] = y;
        if (t < 64 && lane == 0) kss[r * 64 + t] = ss;
    }
}

__device__ __forceinline__ void load_T128(const bf16_t* src, int ld, int ncg, LAS unsigned char* dst, int tid) {
    for (int u = tid; u < 64 * ncg; u += NTHR) {
        const int jp = u & 63, cgi = u >> 6;
        const u32x4 a = *(const u32x4*)(src + (size_t)(2 * jp) * ld + cgi * 8), b = *(const u32x4*)(src + (size_t)(2 * jp + 1) * ld + cgi * 8);
        LAS unsigned* d = (LAS unsigned*)(dst + (cgi * 8) * 272 + jp * 4);
        d[0 * 68] = (a.x & 0xffffu) | (b.x << 16); d[1 * 68] = (a.x >> 16) | (b.x & 0xffff0000u);
        d[2 * 68] = (a.y & 0xffffu) | (b.y << 16); d[3 * 68] = (a.y >> 16) | (b.y & 0xffff0000u);
        d[4 * 68] = (a.z & 0xffffu) | (b.z << 16); d[5 * 68] = (a.z >> 16) | (b.z & 0xffff0000u);
        d[6 * 68] = (a.w & 0xffffu) | (b.w << 16); d[7 * 68] = (a.w >> 16) | (b.w & 0xffff0000u);
    }
}
template <int NU>
__device__ __forceinline__ void tload_issue(u32x4 (&a)[NU], u32x4 (&b)[NU], const bf16_t* src, int ld, int tid) {
#pragma unroll
    for (int i = 0; i < NU; ++i) { const int u = tid + i * NTHR, jp = u & 63, cgi = u >> 6;
        a[i] = *(const u32x4*)(src + (size_t)(2 * jp) * ld + cgi * 8); b[i] = *(const u32x4*)(src + (size_t)(2 * jp + 1) * ld + cgi * 8); }
}
template <int NU>
__device__ __forceinline__ void tload_store(const u32x4 (&a)[NU], const u32x4 (&b)[NU], LAS unsigned char* dst, int tid) {
#pragma unroll
    for (int i = 0; i < NU; ++i) { const int u = tid + i * NTHR, jp = u & 63, cgi = u >> 6;
        LAS unsigned* d = (LAS unsigned*)(dst + (cgi * 8) * 272 + jp * 4);
        d[0 * 68] = (a[i].x & 0xffffu) | (b[i].x << 16); d[1 * 68] = (a[i].x >> 16) | (b[i].x & 0xffff0000u);
        d[2 * 68] = (a[i].y & 0xffffu) | (b[i].y << 16); d[3 * 68] = (a[i].y >> 16) | (b[i].y & 0xffff0000u);
        d[4 * 68] = (a[i].z & 0xffffu) | (b[i].z << 16); d[5 * 68] = (a[i].z >> 16) | (b[i].z & 0xffff0000u);
        d[6 * 68] = (a[i].w & 0xffffu) | (b[i].w << 16); d[7 * 68] = (a[i].w >> 16) | (b[i].w & 0xffff0000u); }
}
constexpr int RET_KS = 0, RET_VT = 34816, RET_RED = 34816 + 69632;

__device__ __forceinline__ void ret_partial_item(CParams& P, LAS unsigned char* lds, int item, int tid) {
    asm volatile("" : "+v"(tid));
    const int lane = tid & 63, w = tid >> 6, l32 = lane & 31, hh = lane >> 5;
    int b, n, h;
    if (item < 128) { b = 0; n = item >> 2; h = item & 3; } else { const int j = item - 128; b = 1 + j / 124; const int r = j - (b - 1) * 124; n = 1 + (r >> 2); h = r & 3; }
    const bf16_t* qk = (const bf16_t*)(P.ws + WS_R4); const bf16_t* v = (const bf16_t*)(P.ws + WS_R1);
    bf16_t* G = (n == 0) ? (bf16_t*)(P.ws + WS_HIDM) + (size_t)h * 32768 : (bf16_t*)P.out + ((size_t)((b * 4 + h) * 32 + n)) * 32768;
    const size_t R0 = (size_t)b * PP + 128 * n;
    {
        u32x4 ka[2], kb[2], va[4], vb[4];
        tload_issue<2>(ka, kb, qk + R0 * 1024 + 512 + h * 128, 1024, tid);
        tload_issue<4>(va, vb, v + R0 * 1024 + h * 256, 1024, tid);
        tload_store<2>(ka, kb, lds + RET_KS, tid);
        tload_store<4>(va, vb, lds + RET_VT, tid);
    }
    __syncthreads();
    const int dt = w & 3, eh = w >> 2;
    f32x16 acc[4];
#pragma unroll
    for (int et = 0; et < 4; ++et)
#pragma unroll
        for (int r = 0; r < 16; ++r) acc[et][r] = 0.f;
#pragma unroll
    for (int s = 0; s < 8; ++s) {
        const bf16x8 a = *(const LAS bf16x8*)(lds + RET_KS + (32 * dt + l32) * 272 + (16 * s + 8 * hh) * 2);
#pragma unroll
        for (int et = 0; et < 4; ++et) {
            const bf16x8 bb = *(const LAS bf16x8*)(lds + RET_VT + (32 * (4 * eh + et) + l32) * 272 + (16 * s + 8 * hh) * 2);
            acc[et] = MFMA32(a, bb, acc[et]);
        }
    }
    __syncthreads();
#pragma unroll
    for (int et = 0; et < 4; ++et)
#pragma unroll
        for (int g = 0; g < 4; ++g) {
            u32x2 o; o.x = pk2(acc[et][4 * g], acc[et][4 * g + 1]); o.y = pk2(acc[et][4 * g + 2], acc[et][4 * g + 3]);
            *(LAS u32x2*)(lds + RET_VT + (32 * (4 * eh + et) + l32) * 272 + (32 * dt + 8 * g + 4 * hh) * 2) = o;
        }
    __syncthreads();
    for (int c = tid; c < 4096; c += NTHR) { const int e = c >> 4, part = c & 15; *(u32x4*)(G + (size_t)c * 8) = *(const LAS u32x4*)(lds + RET_VT + e * 272 + part * 16); }
    __syncthreads();
}

template <int NT>
__device__ __forceinline__ void conv_item(CParams& P, LAS unsigned char* lds, int b, int p0, int tid) {
    const int lane = tid & 63, w = tid >> 6;
    const bf16_t* hdn = (const bf16_t*)(P.ws + WS_R3);
    bf16_t* mix = (bf16_t*)(P.ws + WS_R0);
    const size_t Rb = (size_t)b * PP;
    const unsigned* hd = (const unsigned*)(hdn + (Rb + p0 - 30) * 1024) + tid;
    unsigned xr[NT + 30];
#pragma unroll
    for (int r = 0; r < NT + 30; ++r) xr[r] = hd[r * 512];
    f32x2 W[31];
#pragma unroll
    for (int k = 0; k < 31; ++k) W[k] = *(const f32x2*)(P.even_conv_w + k * 1024 + 2 * tid);
    const f32x2 bias = *(const f32x2*)(P.even_conv_b + 2 * tid);
    LAS float* ys = (LAS float*)lds;
#pragma unroll
    for (int hf = 0; hf < NT / 16; ++hf) {
        f32x2 acc[16];
#pragma unroll
        for (int t = 0; t < 16; ++t) acc[t] = bias;
#pragma unroll
        for (int r = 0; r < 46; ++r) {
            const f32x2 xf = {bf_lo(xr[16 * hf + r]), bf_hi(xr[16 * hf + r])};
#pragma unroll
            for (int t = 0; t < 16; ++t) { const int k = r - t; if (k >= 0 && k <= 30) acc[t] += xf * W[k]; }
        }
#pragma unroll
        for (int t = 0; t < 16; ++t) *(LAS f32x2*)(ys + (16 * hf + t) * 1024 + 2 * tid) = acc[t];
    }
    f32x4 lg[4], lb[4];
#pragma unroll
    for (int j = 0; j < 4; ++j) { lg[j] = *(const f32x4*)(P.even_ln_g + 4 * lane + 256 * j); lb[j] = *(const f32x4*)(P.even_ln_b + 4 * lane + 256 * j); }
    __syncthreads();
    constexpr int TW = NT / 8;
#pragma unroll
    for (int q0 = 0; q0 < TW; q0 += 2) {
        f32x4 y[2][4]; float s[2] = {0.f, 0.f};
#pragma unroll
        for (int q = 0; q < 2; ++q)
#pragma unroll
            for (int j = 0; j < 4; ++j) { y[q][j] = *(const LAS f32x4*)(ys + (TW * w + q0 + q) * 1024 + 4 * lane + 256 * j); s[q] += (y[q][j].x + y[q][j].y) + (y[q][j].z + y[q][j].w); }
#pragma unroll
        for (int o = 1; o < 64; o <<= 1) { s[0] += __shfl_xor(s[0], o); s[1] += __shfl_xor(s[1], o); }
        float qv[2] = {0.f, 0.f};
#pragma unroll
        for (int q = 0; q < 2; ++q) { const float mean = s[q] * (1.0f / 1024.0f);
#pragma unroll
            for (int j = 0; j < 4; ++j) { y[q][j] = y[q][j] - mean; qv[q] += (y[q][j].x * y[q][j].x + y[q][j].y * y[q][j].y) + (y[q][j].z * y[q][j].z + y[q][j].w * y[q][j].w); } }
#pragma unroll
        for (int o = 1; o < 64; o <<= 1) { qv[0] += __shfl_xor(qv[0], o); qv[1] += __shfl_xor(qv[1], o); }
#pragma unroll
        for (int q = 0; q < 2; ++q) {
            const float rstd = rsqrtf(qv[q] * (1.0f / 1024.0f) + 1e-6f);
            const size_t row = Rb + p0 + TW * w + q0 + q;
#pragma unroll
            for (int j = 0; j < 4; ++j) {
                f32x4 o = y[q][j] * rstd * lg[j] + lb[j];
#pragma unroll
                for (int i = 0; i < 4; ++i) o[i] = o[i] * sigmoidf_(o[i]);
                u32x2 wv; wv.x = pk2(o[0], o[1]); wv.y = pk2(o[2], o[3]);
                *(u32x2*)(mix + row * 2048 + 1024 + 4 * lane + 256 * j) = wv;
            }
        }
    }
    __syncthreads();
}

__device__ __forceinline__ void ret_scan(CParams& P, int tid) {
    bf16_t* G = (bf16_t*)P.out;
    for (int c = blockIdx.x * NTHR + tid; c < 32 * 4096; c += gridDim.x * NTHR) {
        const int bh = c >> 12, off = (c & 4095) * 8, h = bh & 3;
        const float lam = fexp2(128.0f * lg2gamma(h));
        bf16_t* ptr = G + (size_t)bh * 32 * 32768 + off;
        float S[8];
#pragma unroll
        for (int k = 0; k < 8; ++k) S[k] = 0.f;
#pragma unroll 8
        for (int n = 0; n < 32; ++n) {
            const u32x4 g = (n == 0) ? *(const u32x4*)((const bf16_t*)(P.ws + WS_HIDM) + (size_t)h * 32768 + off) : *(const u32x4*)(ptr + (size_t)n * 32768);
            S[0] = lam * (S[0] + bf_lo(g.x)); S[1] = lam * (S[1] + bf_hi(g.x)); S[2] = lam * (S[2] + bf_lo(g.y)); S[3] = lam * (S[3] + bf_hi(g.y));
            S[4] = lam * (S[4] + bf_lo(g.z)); S[5] = lam * (S[5] + bf_hi(g.z)); S[6] = lam * (S[6] + bf_lo(g.w)); S[7] = lam * (S[7] + bf_hi(g.w));
            u32x4 o; o.x = pk2(S[0], S[1]); o.y = pk2(S[2], S[3]); o.z = pk2(S[4], S[5]); o.w = pk2(S[6], S[7]);
            *(u32x4*)(ptr + (size_t)n * 32768) = o;
        }
    }
}

__device__ __forceinline__ void ret_out_item(CParams& P, LAS unsigned char* lds, int item, int tid) {
    asm volatile("" : "+v"(tid));
    const int lane = tid & 63, w = tid >> 6, l32 = lane & 31, hh = lane >> 5;
    const int b = item / 132, rem = item - b * 132, n = rem >> 2, h = rem & 3;
    const bf16_t* qk = (const bf16_t*)(P.ws + WS_R4); const bf16_t* v = (const bf16_t*)(P.ws + WS_R1); const bf16_t* gs = (const bf16_t*)(P.ws + WS_R2);
    bf16_t* mix = (bf16_t*)(P.ws + WS_R0);
    const size_t R0 = (size_t)b * PP + 128 * n;
    const int ib = w & 3, eh = w >> 2;
    bf16x8 qf[8];
    {
        u32x4 kt[4], va[4], vb[4];
#pragma unroll
        for (int i = 0; i < 4; ++i) { const int c = tid + i * NTHR; kt[i] = *(const u32x4*)(qk + (R0 + (c >> 4)) * 1024 + 512 + h * 128 + (c & 15) * 8); }
        tload_issue<4>(va, vb, v + R0 * 1024 + h * 256, 1024, tid);
#pragma unroll
        for (int s = 0; s < 8; ++s) qf[s] = *(const bf16x8*)(qk + (R0 + 32 * ib + l32) * 1024 + h * 128 + 16 * s + 8 * hh);
#pragma unroll
        for (int i = 0; i < 4; ++i) { const int c = tid + i * NTHR; *(LAS u32x4*)(lds + RET_KS + (c >> 4) * 272 + (c & 15) * 16) = kt[i]; }
        tload_store<4>(va, vb, lds + RET_VT, tid);
    }
    const bf16_t* prev = (const bf16_t*)P.out + ((size_t)((b * 4 + h) * 32 + (n > 0 ? n - 1 : 0))) * 32768;
    bf16x8 pf[4][4];
    if (n > 0) {
#pragma unroll
        for (int s = 0; s < 4; ++s)
#pragma unroll
            for (int et = 0; et < 4; ++et) pf[s][et] = *(const bf16x8*)(prev + (size_t)(32 * (4 * eh + et) + l32) * 128 + 16 * s + 8 * hh);
    }
    __syncthreads();
    f32x16 O[4];
#pragma unroll
    for (int et = 0; et < 4; ++et)
#pragma unroll
        for (int r = 0; r < 16; ++r) O[et][r] = 0.f;
    if (n > 0) {
#pragma unroll
        for (int s = 0; s < 4; ++s)
#pragma unroll
            for (int et = 0; et < 4; ++et) O[et] = MFMA32(pf[s][et], qf[s], O[et]);
#pragma unroll
        for (int s = 4; s < 8; ++s)
#pragma unroll
            for (int et = 0; et < 4; ++et) {
                const bf16x8 a = *(const bf16x8*)(prev + (size_t)(32 * (4 * eh + et) + l32) * 128 + 16 * s + 8 * hh);
                O[et] = MFMA32(a, qf[s], O[et]);
            }
    }
#pragma unroll 1
    for (int jt = 0; jt <= ib; ++jt) {
        f32x16 x;
#pragma unroll
        for (int r = 0; r < 16; ++r) x[r] = 0.f;
#pragma unroll
        for (int s = 0; s < 8; ++s) {
            const bf16x8 a = *(const LAS bf16x8*)(lds + RET_KS + (32 * jt + l32) * 272 + (16 * s + 8 * hh) * 2);
            x = MFMA32(a, qf[s], x);
        }
        if (jt == ib) {
#pragma unroll
            for (int r = 0; r < 16; ++r) x[r] = (crow(r, hh) > l32) ? 0.f : x[r];
        }
        u32x4 p0, p1;
        p0.x = pk2(x[0], x[1]); p0.y = pk2(x[2], x[3]); p0.z = pk2(x[4], x[5]); p0.w = pk2(x[6], x[7]);
        p1.x = pk2(x[8], x[9]); p1.y = pk2(x[10], x[11]); p1.z = pk2(x[12], x[13]); p1.w = pk2(x[14], x[15]);
        const bf16x8 pb0 = __builtin_bit_cast(bf16x8, p0), pb1 = __builtin_bit_cast(bf16x8, p1);
#pragma unroll
        for (int et = 0; et < 4; ++et) {
            const LAS unsigned char* vp = lds + RET_VT + (32 * (4 * eh + et) + l32) * 272 + (32 * jt + 4 * hh) * 2;
            const s16x4 lo0 = *(const LAS s16x4*)(vp), hi0 = *(const LAS s16x4*)(vp + 16), lo1 = *(const LAS s16x4*)(vp + 32), hi1 = *(const LAS s16x4*)(vp + 48);
            O[et] = MFMA32(__builtin_shufflevector(lo0, hi0, 0, 1, 2, 3, 4, 5, 6, 7), pb0, O[et]);
            O[et] = MFMA32(__builtin_shufflevector(lo1, hi1, 0, 1, 2, 3, 4, 5, 6, 7), pb1, O[et]);
        }
    }
    float sm = 0.f, sq = 0.f;
#pragma unroll
    for (int et = 0; et < 4; ++et)
#pragma unroll
        for (int r = 0; r < 16; ++r) { const float t = O[et][r]; sm += t; sq += t * t; }
    sm += __shfl_xor(sm, 32); sq += __shfl_xor(sq, 32);
    LAS f32x2* red = (LAS f32x2*)(lds + RET_RED);
    if (hh == 0) red[w * 32 + l32] = (f32x2){sm, sq};
    const f32x4 gn = *(const f32x4*)(P.even_gn_g + h * 256 + 4 * lane);
    u32x2 gvr[16];
#pragma unroll
    for (int it = 0; it < 16; ++it) gvr[it] = *(const u32x2*)(gs + (R0 + w * 16 + it) * 1024 + h * 256 + 4 * lane);
    __syncthreads();
    { const f32x2 o = red[(w ^ 4) * 32 + l32]; sm += o.x; sq += o.y; }
    const float mean = sm * (1.0f / 256.0f);
    const float rstd = rsqrtf(fmaxf(sq * (1.0f / 256.0f) - mean * mean, 0.f) + 1e-6f);
#pragma unroll
    for (int et = 0; et < 4; ++et)
#pragma unroll
        for (int g = 0; g < 4; ++g) {
            u32x2 o; o.x = pk2((O[et][4 * g] - mean) * rstd, (O[et][4 * g + 1] - mean) * rstd); o.y = pk2((O[et][4 * g + 2] - mean) * rstd, (O[et][4 * g + 3] - mean) * rstd);
            *(LAS u32x2*)(lds + RET_VT + (32 * ib + l32) * 520 + (32 * (4 * eh + et) + 8 * g + 4 * hh) * 2) = o;
        }
    __syncthreads();
#pragma unroll
    for (int it = 0; it < 16; ++it) {
        const int i = w * 16 + it;
        const u32x2 val = *(const LAS u32x2*)(lds + RET_VT + i * 520 + lane * 8);
        const u32x2 gv = gvr[it];
        u32x2 o; o.x = pk2(bf_lo(val.x) * gn.x * bf_lo(gv.x), bf_hi(val.x) * gn.y * bf_hi(gv.x)); o.y = pk2(bf_lo(val.y) * gn.z * bf_lo(gv.y), bf_hi(val.y) * gn.w * bf_hi(gv.y));
        *(u32x2*)(mix + (R0 + i) * 2048 + h * 256 + 4 * lane) = o;
    }
    __syncthreads();
}

constexpr int AT_KS = 0, AT_VT = 9216, AT_FLAG = 18432, AT_OST = 18688;
template <int MASK>
__device__ __forceinline__ void sb_subtile(f32x16& x, float& C, int hh, int key0, int qidx, u32x4& p0, u32x4& p1) {
    f32x2 e2[2][4], d2[2][4];
#pragma unroll
    for (int gp = 0; gp < 2; ++gp)
#pragma unroll
        for (int j = 0; j < 4; ++j) {
            float ev[2];
#pragma unroll
            for (int c = 0; c < 2; ++c) {
                const int r = 4 * (2 * gp + c) + j;
                float t = fexp2(__builtin_amdgcn_fmed3f(x[r], -126.f, 30.f));
                if (MASK == 1) { const int key = key0 + crow(r, hh); t = (key < qidx) ? t : 0.f; }
                if (MASK == 2) { const int key = key0 + crow(r, hh); t = (key < qidx && key >= PADF) ? t : 0.f; }
                ev[c] = t;
            }
            e2[gp][j] = (f32x2){ev[0], ev[1]};
            d2[gp][j] = e2[gp][j] + 1.0f;
        }
    float pg[4], qg[4], T[4];
#pragma unroll
    for (int gp = 0; gp < 2; ++gp) {
        const f32x2 Q = (d2[gp][3] * d2[gp][2]) * (d2[gp][1] * d2[gp][0]);
        pg[2 * gp] = frcp(Q.x); pg[2 * gp + 1] = frcp(Q.y);
    }
#pragma unroll
    for (int g = 0; g < 4; ++g) qg[g] = __shfl_xor(pg[g], 32);
    T[3] = C; T[2] = T[3] * (pg[3] * qg[3]); T[1] = T[2] * (pg[2] * qg[2]); T[0] = T[1] * (pg[1] * qg[1]);
    C = T[0] * (pg[0] * qg[0]);
    f32x2 w2[2][4];
#pragma unroll
    for (int gp = 0; gp < 2; ++gp) {
        const f32x2 base = hh ? (f32x2){T[2 * gp], T[2 * gp + 1]} : (f32x2){T[2 * gp] * qg[2 * gp], T[2 * gp + 1] * qg[2 * gp + 1]};
        const f32x2 b0 = base * (f32x2){pg[2 * gp], pg[2 * gp + 1]};
        const f32x2 b1 = b0 * d2[gp][0], b2 = b1 * d2[gp][1], b3 = b2 * d2[gp][2];
        w2[gp][0] = e2[gp][0] * b0; w2[gp][1] = e2[gp][1] * b1; w2[gp][2] = e2[gp][2] * b2; w2[gp][3] = e2[gp][3] * b3;
    }
    p0.x = pk2(w2[0][0].x, w2[0][1].x); p0.y = pk2(w2[0][2].x, w2[0][3].x); p0.z = pk2(w2[0][0].y, w2[0][1].y); p0.w = pk2(w2[0][2].y, w2[0][3].y);
    p1.x = pk2(w2[1][0].x, w2[1][1].x); p1.y = pk2(w2[1][2].x, w2[1][3].x); p1.z = pk2(w2[1][0].y, w2[1][1].y); p1.w = pk2(w2[1][2].y, w2[1][3].y);
}

__device__ __forceinline__ void attn_item(CParams& P, LAS unsigned char* lds, int item, int tid) {
    const int lane = tid & 63, w = tid >> 6, l32 = lane & 31, hh = lane >> 5;
    int bh, qb;
    if (item < 1920) { bh = item / 15; qb = 1 + (item - bh * 15); } else if (item < 2048) { bh = item - 1920; qb = 16; } else { bh = item - 2048; qb = 0; }
    const int b = bh >> 4, h = bh & 15;
    const bf16_t* q = (const bf16_t*)(P.ws + WS_R0); const bf16_t* k = (const bf16_t*)(P.ws + WS_R0 + UNIT); const bf16_t* v = (const bf16_t*)(P.ws + WS_R1);
    bf16_t* ao = (bf16_t*)(P.ws + WS_R2);
    const size_t Rb = (size_t)b * PP;
    const int qrow0 = 256 * qb + 32 * w;
    const bool wvalid = qrow0 < PP;
    bf16x8 qf[4];
#pragma unroll
    for (int s = 0; s < 4; ++s) {
        if (wvalid) qf[s] = *(const bf16x8*)(q + (Rb + qrow0 + l32) * 1024 + h * 64 + 16 * s + 8 * hh);
        else qf[s] = (bf16x8){0, 0, 0, 0, 0, 0, 0, 0};
    }
    f32x16 O[2];
#pragma unroll
    for (int dt = 0; dt < 2; ++dt)
#pragma unroll
        for (int r = 0; r < 16; ++r) O[dt][r] = 0.f;
    float C = 1.0f; bool done = !wvalid;
    int T = 4 * qb + 3; if (T > 65) T = 65;
    const bool vrole = tid < 256;
    const int jp = tid & 31, dg = (tid >> 5) & 7;
    const int ku = tid & 255;
    u32x4 ra, rb;
    {
        const size_t kb = Rb + 64 * T;
        if (vrole) { ra = *(const u32x4*)(v + (kb + 2 * jp) * 1024 + h * 64 + dg * 8); rb = *(const u32x4*)(v + (kb + 2 * jp + 1) * 1024 + h * 64 + dg * 8); }
        else { ra = *(const u32x4*)(k + (kb + (ku >> 3)) * 1024 + h * 64 + (ku & 7) * 8); rb = *(const u32x4*)(k + (kb + 32 + (ku >> 3)) * 1024 + h * 64 + (ku & 7) * 8); }
    }
    volatile LAS unsigned* flags = (volatile LAS unsigned*)(lds + AT_FLAG);
#pragma unroll 1
    for (; T >= 1; --T) {
        __syncthreads();
        if (vrole) {
            if (T == 1) {
                if (jp < 24) { ra = (u32x4){0u, 0u, 0u, 0u}; rb = ra; }
                else {
                    const float* vr = (const float*)(P.ws + WS_VRAW) + (size_t)(2 * jp - 48) * 1024 + h * 64 + dg * 8;
                    const f32x4 a0 = *(const f32x4*)vr, a1 = *(const f32x4*)(vr + 4), b0 = *(const f32x4*)(vr + 1024), b1 = *(const f32x4*)(vr + 1028);
                    ra.x = pk2(a0.x, a0.y); ra.y = pk2(a0.z, a0.w); ra.z = pk2(a1.x, a1.y); ra.w = pk2(a1.z, a1.w);
                    rb.x = pk2(b0.x, b0.y); rb.y = pk2(b0.z, b0.w); rb.z = pk2(b1.x, b1.y); rb.w = pk2(b1.z, b1.w);
                }
            }
            LAS unsigned* d = (LAS unsigned*)(lds + AT_VT + (dg * 8) * 144 + jp * 4);
            d[0 * 36] = (ra.x & 0xffffu) | (rb.x << 16); d[1 * 36] = (ra.x >> 16) | (rb.x & 0xffff0000u);
            d[2 * 36] = (ra.y & 0xffffu) | (rb.y << 16); d[3 * 36] = (ra.y >> 16) | (rb.y & 0xffff0000u);
            d[4 * 36] = (ra.z & 0xffffu) | (rb.z << 16); d[5 * 36] = (ra.z >> 16) | (rb.z & 0xffff0000u);
            d[6 * 36] = (ra.w & 0xffffu) | (rb.w << 16); d[7 * 36] = (ra.w >> 16) | (rb.w & 0xffff0000u);
        } else {
            if (T == 1 && (ku >> 3) >= 16) {
                const int r = (ku >> 3) - 16;
                const f32x4 s4 = *(const f32x4*)((const float*)(P.ws + WS_KSS) + r * 64 + 4 * h);
                const float n = rsqrtf(((s4.x + s4.y) + (s4.z + s4.w)) * (1.0f / 64.0f) + 1e-6f);
                const float* kr = (const float*)(P.ws + WS_KRAW) + (size_t)r * 1024 + h * 64 + (ku & 7) * 8;
                const f32x4 a0 = *(const f32x4*)kr * n * *(const f32x4*)(P.odd_kn_g + (ku & 7) * 8), a1 = *(const f32x4*)(kr + 4) * n * *(const f32x4*)(P.odd_kn_g + (ku & 7) * 8 + 4);
                rb.x = pk2(a0.x, a0.y); rb.y = pk2(a0.z, a0.w); rb.z = pk2(a1.x, a1.y); rb.w = pk2(a1.z, a1.w);
            }
            *(LAS u32x4*)(lds + AT_KS + (ku >> 3) * 144 + (ku & 7) * 16) = ra;
            *(LAS u32x4*)(lds + AT_KS + (32 + (ku >> 3)) * 144 + (ku & 7) * 16) = rb;
        }
        if (lane == 0) flags[w] = done ? 1u : 0u;
        __syncthreads();
        const u32x4 f0 = *(const LAS u32x4*)(lds + AT_FLAG), f1 = *(const LAS u32x4*)(lds + AT_FLAG + 16);
        const unsigned alld = (f0.x & f0.y) & (f0.z & f0.w) & (f1.x & f1.y) & (f1.z & f1.w);
        if (alld) break;
        if (T > 1) {
            const size_t kb = Rb + 64 * (T - 1);
            if (vrole) { ra = *(const u32x4*)(v + (kb + 2 * jp) * 1024 + h * 64 + dg * 8); rb = *(const u32x4*)(v + (kb + 2 * jp + 1) * 1024 + h * 64 + dg * 8); }
            else { ra = *(const u32x4*)(k + (kb + (ku >> 3)) * 1024 + h * 64 + (ku & 7) * 8); rb = *(const u32x4*)(k + (kb + 32 + (ku >> 3)) * 1024 + h * 64 + (ku & 7) * 8); }
        }
        if (!done && 64 * T <= qrow0 + 30) {
            const bool needmask = (64 * T + 63 >= qrow0) || (T == 1);
#pragma unroll
            for (int st = 1; st >= 0; --st) {
                if (64 * T + 32 * st >= qrow0 + 31) continue;
                f32x16 x;
#pragma unroll
                for (int r = 0; r < 16; ++r) x[r] = 0.f;
#pragma unroll
                for (int s = 0; s < 4; ++s) {
                    const bf16x8 a = *(const LAS bf16x8*)(lds + AT_KS + (32 * st + l32) * 144 + (16 * s + 8 * hh) * 2);
                    x = MFMA32(a, qf[s], x);
                }
                u32x4 p0, p1;
                if (T == 1) sb_subtile<2>(x, C, hh, 64 * T + 32 * st, qrow0 + l32, p0, p1);
                else if (needmask) sb_subtile<1>(x, C, hh, 64 * T + 32 * st, qrow0 + l32, p0, p1);
                else sb_subtile<0>(x, C, hh, 0, 0, p0, p1);
                const bf16x8 pb0 = __builtin_bit_cast(bf16x8, p0), pb1 = __builtin_bit_cast(bf16x8, p1);
#pragma unroll
                for (int dt = 0; dt < 2; ++dt) {
                    const LAS unsigned char* vp = lds + AT_VT + (32 * dt + l32) * 144 + (32 * st + 4 * hh) * 2;
                    const s16x4 lo0 = *(const LAS s16x4*)(vp), hi0 = *(const LAS s16x4*)(vp + 16), lo1 = *(const LAS s16x4*)(vp + 32), hi1 = *(const LAS s16x4*)(vp + 48);
                    O[dt] = MFMA32(__builtin_shufflevector(lo0, hi0, 0, 1, 2, 3, 4, 5, 6, 7), pb0, O[dt]);
                    O[dt] = MFMA32(__builtin_shufflevector(lo1, hi1, 0, 1, 2, 3, 4, 5, 6, 7), pb1, O[dt]);
                }
                if (__ballot(C >= 1e-37f) == 0ull) { done = true; break; }
            }
        }
    }
    LAS unsigned char* ost = lds + AT_OST + w * 4352;
#pragma unroll
    for (int dt = 0; dt < 2; ++dt)
#pragma unroll
        for (int g = 0; g < 4; ++g) {
            u32x2 o; o.x = pk2(O[dt][4 * g], O[dt][4 * g + 1]); o.y = pk2(O[dt][4 * g + 2], O[dt][4 * g + 3]);
            *(LAS u32x2*)(ost + l32 * 136 + (32 * dt + 8 * g + 4 * hh) * 2) = o;
        }
    LDS_WAIT();
    if (wvalid) {
#pragma unroll
        for (int it = 0; it < 8; ++it) {
            const int row = 4 * it + (lane >> 4), part = lane & 15;
            const u32x2 val = *(const LAS u32x2*)(ost + row * 136 + part * 8);
            *(u32x2*)(ao + (Rb + qrow0 + row) * 1024 + h * 64 + part * 4) = val;
        }
    }
    LDS_WAIT();
}

constexpr size_t WS_BAR = WS_HM2P + (size_t)16 * 1024 * 4;
#define XB_TMO      128
#define XB_XCNT(j)  (256  + 64 * (j))
#define XB_XSUB(j)  (1280 + 64 * (j))
#define XB_XGEN(j)  (2304 + 64 * (j))
#define XB_TOP      3328
#define XB_TOPGEN   3392
#define XCD_BAR_WORDS 3456
#define XB_SPIN_CAP (1u << 18)

__device__ __forceinline__ unsigned xb_ld(unsigned* p)              { return __hip_atomic_load(p, __ATOMIC_RELAXED, __HIP_MEMORY_SCOPE_AGENT); }
__device__ __forceinline__ unsigned xb_add(unsigned* p, unsigned v) { return __hip_atomic_fetch_add(p, v, __ATOMIC_RELAXED, __HIP_MEMORY_SCOPE_AGENT); }
__device__ __forceinline__ unsigned xb_xcc_id() { return (unsigned)__builtin_amdgcn_s_getreg((3 << 11) | 20) & 0xFu; }
#define XB_SPIN(cond, bar) do { unsigned _sp = 0; while (cond) { __builtin_amdgcn_s_sleep(1); \
    if ((++_sp & 255u) == 0u) { if (xb_ld(&(bar)[XB_TMO])) break; if (_sp > XB_SPIN_CAP) { atomicAdd(&(bar)[XB_TMO], 1u); break; } } } } while (0)

struct XcdBarrier {
    unsigned* bar; unsigned x;
    volatile LAS unsigned* st;
};

__device__ __forceinline__ XcdBarrier xcd_barrier_post(unsigned* bar, volatile LAS unsigned* st) {
    XcdBarrier b; b.bar = bar; b.x = xb_xcc_id(); b.st = st;
    if (threadIdx.x == 0) (void)xb_add(&bar[XB_XCNT(b.x)], 1u);
    return b;
}
__device__ __forceinline__ void xcd_barrier_complete(unsigned* bar, unsigned x, unsigned& nloc, unsigned& nx) {
    const unsigned G = gridDim.x * gridDim.y * gridDim.z;
    unsigned sum, cnt, mine, sp = 0u;
    for (;;) {
        sum = 0u; cnt = 0u; mine = 0u;
#pragma unroll
        for (unsigned j = 0; j < 16; ++j) { const unsigned c = xb_ld(&bar[XB_XCNT(j)]); sum += c; cnt += (c > 0u) ? 1u : 0u; mine = (j == x) ? c : mine; }
        if (sum == G) break;
        __builtin_amdgcn_s_sleep(1);
        if ((++sp & 255u) == 0u) { if (xb_ld(&bar[XB_TMO])) break; if (sp > XB_SPIN_CAP) { atomicAdd(&bar[XB_TMO], 1u); break; } }
    }
    nloc = mine > 0u ? mine : 1u; nx = cnt > 0u ? cnt : 1u;
}

__device__ __forceinline__ void xcd_barrier(const XcdBarrier& b) {
    asm volatile("s_waitcnt vmcnt(0)" ::: "memory");
    __syncthreads();
    if (threadIdx.x == 0) {
        unsigned* bar = b.bar;
        __builtin_amdgcn_s_waitcnt(0);
        unsigned nloc = b.st[0], nx = b.st[1];
        if (nloc == 0u) { xcd_barrier_complete(bar, b.x, nloc, nx); b.st[0] = nloc; b.st[1] = nx; }
        const unsigned old = xb_add(&bar[XB_XSUB(b.x)], 1u);
        const unsigned gen = old / nloc;
        if (old + 1u == (gen + 1u) * nloc) {
            __builtin_amdgcn_fence(__ATOMIC_RELEASE, "agent");
            asm volatile("s_waitcnt vmcnt(0)" ::: "memory");
            const unsigned og = xb_add(&bar[XB_TOP], 1u);
            const unsigned tg = og / nx;
            if (og + 1u == (tg + 1u) * nx) xb_add(&bar[XB_TOPGEN], 1u);
            else XB_SPIN(xb_ld(&bar[XB_TOPGEN]) == tg, bar);
            __builtin_amdgcn_fence(__ATOMIC_ACQUIRE, "agent");
            xb_add(&bar[XB_XGEN(b.x)], 1u);
            asm volatile("s_waitcnt vmcnt(0)" ::: "memory");
        } else {
            XB_SPIN(xb_ld(&bar[XB_XGEN(b.x)]) == gen, bar);
            __builtin_amdgcn_fence(__ATOMIC_ACQUIRE, "agent");
            asm volatile("s_waitcnt vmcnt(0)" ::: "memory");
        }
    }
    __syncthreads();
}

#define GEMM_COMPACT_A 0
#define GEMM_PHASE(EPI, Aptr, Bptr, N_, K_, E_) do { pg8::Gemm g_{(const pg8::bf16_t*)(Aptr), (const pg8::bf16_t*)(Bptr), NB * SEQ, (N_), (K_), GEMM_COMPACT_A}; pg8::StaticOrder S_; S_.init(NB * SEQ, (N_), (int)gridDim.x, (int)blockIdx.x); \
    pg8::gemm_phase<EPI, pg8::StaticOrder, true, true>(lds, g_, S_, E_); } while (0)
#define META_TASKS(FN, NT) do { RETID(); for (int t_ = blockIdx.x; t_ < (NT); t_ += gridDim.x) FN(KP, lds, t_, tid); asm volatile("s_waitcnt vmcnt(0)" ::: "memory"); __syncthreads(); } while (0)

__global__ void __launch_bounds__(NTHR) mega_fwd(Params Punused) {
    extern __shared__ __attribute__((aligned(16))) unsigned char lds_raw[];
    LAS unsigned char* lds = (LAS unsigned char*)lds_raw;
    cg::grid_group grid = cg::this_grid();
    int tid = threadIdx.x;
#define RETID() do { tid = threadIdx.x; asm volatile("" : "+v"(tid)); } while (0)
#define ws (KP.ws)
#define ss1 ((float*)(ws + WS_SS) + (size_t)RP * 16)
#define ss2 ((float*)(ws + WS_SS) + (size_t)RP * 32)
#define ss3 ((float*)(ws + WS_SS) + (size_t)RP * 48)
    volatile LAS unsigned* bst = (volatile LAS unsigned*)(lds + 139264);
    if (tid < 2) bst[tid] = 0u;
#define GBAR() xcd_barrier(xbar)
    RETID();
    if (blockIdx.x == 0) for (int i = tid; i < XCD_BAR_WORDS; i += NTHR) ((volatile unsigned*)(ws + WS_BAR))[i] = 0u;
    phase0(KP, lds, tid);
    grid.sync();
    const XcdBarrier xbar = xcd_barrier_post((unsigned*)(ws + WS_BAR), bst);
    META_TASKS(meta_in, 320);
    { EpiIn E{(const float*)(ws + WS_SS), (bf16_t*)(ws + WS_R4), (bf16_t*)(ws + WS_R1), (bf16_t*)(ws + WS_R2), (bf16_t*)(ws + WS_R3)};
#undef GEMM_COMPACT_A
#define GEMM_COMPACT_A 1
      GEMM_PHASE(EpiIn, (bf16_t*)KP.out + (size_t)NB * SEQ * DM, ws + WS_WIN, 5120, 1024, E); }
#undef GEMM_COMPACT_A
#define GEMM_COMPACT_A 0
    GBAR();
    RETID();
    for (int it = blockIdx.x; it < 996 + 1025 + 4; it += gridDim.x) {
        if (it < 996) ret_partial_item(KP, lds, it, tid);
        else if (it == 996) conv_item<16>(KP, lds, 0, PADF, tid);
        else if (it < 996 + 1025) { const int ci = it - 997; conv_item<32>(KP, lds, ci >> 7, 128 + 32 * (ci & 127), tid); }
        else ret_out_item(KP, lds, it - (996 + 1025), tid);
    }
    GBAR();
    RETID();
    ret_scan(KP, tid);
    GBAR();
    RETID();
    for (int it = blockIdx.x; it < NB * 32 * 4; it += gridDim.x) ret_out_item(KP, lds, (it >> 7) * 132 + 4 + (it & 127), tid);
    GBAR();
    META_TASKS(meta_out, 256);
    { typedef EpiRes<2, false> EpiR0; EpiR0 E{(const float*)((bf16_t*)KP.out + (size_t)NB * SEQ * DM), nullptr, (bf16_t*)(ws + WS_R4), ss1};
      GEMM_PHASE(EpiR0, ws + WS_R0, ws + WS_WOUT, 1024, 2048, E); }
    GBAR();
    META_TASKS(meta_up, 256);
    { EpiUp E{ss1, (bf16_t*)(ws + WS_R0), (LAS float*)(lds + RS_TAB_OFF)}; GEMM_PHASE(EpiUp, ws + WS_R4, ws + WS_W1, 4096, 1024, E); }
    GBAR();
    META_TASKS(meta_down, 256);
    { typedef EpiRes<1, false> EpiR1; EpiR1 E{nullptr, nullptr, (bf16_t*)(ws + WS_R4), ss2};
      GEMM_PHASE(EpiR1, ws + WS_R0, ws + WS_W2, 1024, 4096, E); }
    GBAR();
    META_TASKS(meta_kv, 128);
    { EpiQkv E{ss2, KP.odd_qn_g, KP.odd_kn_g, (bf16_t*)(ws + WS_R0), (LAS float*)(lds + RS_TAB_OFF)};
      GEMM_PHASE(EpiQkv, ws + WS_R4, ws + WS_WQKV, 3072, 1024, E); }
    GBAR();
    RETID();
    for (int it = blockIdx.x; it < NB * 16 * 17; it += gridDim.x) attn_item(KP, lds, it, tid);
    GBAR();
    { typedef EpiRes<1, false> EpiR1; EpiR1 E{nullptr, nullptr, (bf16_t*)(ws + WS_R4), ss3};
      GEMM_PHASE(EpiR1, ws + WS_R2, ws + WS_WO, 1024, 1024, E); }
    GBAR();
    { EpiUp E{ss3, (bf16_t*)(ws + WS_R0), (LAS float*)(lds + RS_TAB_OFF)}; GEMM_PHASE(EpiUp, ws + WS_R4, ws + WS_W1 + (size_t)4096 * 1024 * 2, 4096, 1024, E); }
    GBAR();
    { typedef EpiRes<1, true> EpiR2; EpiR2 E{nullptr, KP.out, (bf16_t*)(ws + WS_R4), nullptr};
      GEMM_PHASE(EpiR2, ws + WS_R0, ws + WS_W2 + (size_t)4096 * 1024 * 2, 1024, 4096, E); }
#undef ws
#undef ss1
#undef ss2
#undef ss3
}

extern "C" void kernel_launch(void* const* d_in, const int* in_sizes, int n_in, void* d_out, int out_size, void* d_ws, size_t ws_size, hipStream_t stream) {
    static int grid_blocks = 0;
    if (grid_blocks == 0) {
        if (n_in != 17 || ws_size < WS_END) { fprintf(stderr, "kernel_launch: unexpected inputs (n_in %d, ws %zu, need %zu)\n", n_in, ws_size, (size_t)WS_END); grid_blocks = -1; return; }
        int dev = 0, cus = 0, per_cu = 0;
        (void)hipGetDevice(&dev);
        (void)hipDeviceGetAttribute(&cus, hipDeviceAttributeMultiprocessorCount, dev);
        if (hipFuncSetAttribute((const void*)mega_fwd, hipFuncAttributeMaxDynamicSharedMemorySize, LDS_BYTES) != hipSuccess) fprintf(stderr, "kernel_launch: hipFuncSetAttribute failed\n");
        if (hipOccupancyMaxActiveBlocksPerMultiprocessor(&per_cu, (const void*)mega_fwd, NTHR, LDS_BYTES) != hipSuccess || per_cu < 1) { fprintf(stderr, "kernel_launch: occupancy query gave %d; using 1\n", per_cu); per_cu = 1; }
        (void)hipGetLastError();
        if (cus <= 0) cus = 256;
        grid_blocks = cus * per_cu;
    }
    if (grid_blocks < 0) return;
    Params p{};
    const float** pp = (const float**)&p;
    for (int i = 0; i < 17; ++i) pp[i] = (const float*)d_in[i];
    p.out = (float*)d_out; p.ws = (unsigned char*)d_ws;
    void* args[] = {&p};
    hipError_t e = hipLaunchCooperativeKernel((const void*)mega_fwd, dim3(grid_blocks), dim3(NTHR), args, LDS_BYTES, stream);
    if (e != hipSuccess) fprintf(stderr, "cooperative launch failed: %s (grid %d)\n", hipGetErrorString(e), grid_blocks);
}
```

```cpp
#include <hip/hip_runtime.h>
#include <hip/hip_cooperative_groups.h>
#include <cstdio>
#include <cstdint>
namespace cg = cooperative_groups;
__host__ __device__ __forceinline__ int rowbase(int pm) { return (pm >> 4) * 4224 + 128 + (pm & 15) * 256; }
namespace pg8 {
#define PG8_LAS __attribute__((address_space(3)))
typedef unsigned short bf16_t;
typedef short bf16x8 __attribute__((ext_vector_type(8)));
typedef float f32x4 __attribute__((ext_vector_type(4)));
typedef unsigned u32x4 __attribute__((ext_vector_type(4)));
constexpr int BM = 256, BK = 64, HALF = 128, HTB = HALF * BK * 2  , STAGE_BYTES = 8 * HTB, NXCD = 8, WGM = 8;

__host__ __device__ __forceinline__ int lds_byte(int r, int c) { const int st = (r >> 4) * 2 + (c >> 5), rr = r & 15, cc = c & 31, ob = rr * 64 + cc * 2; return st * 1024 + (ob ^ (((ob >> 9) & 1) << 5)); }
__host__ __device__ __forceinline__ void stage_rc(int b, int& R, int& C) { const int st = b / 1024, sb = b % 1024, swz = sb ^ (((sb >> 9) & 1) << 5); R = (st >> 1) * 16 + swz / 64; C = (st & 1) * 32 + (swz % 64) / 2; }
__host__ __device__ __forceinline__ int perm32(int rho) { const int n = rho >> 4, i = rho & 15; return 8 * (i >> 2) + 4 * n + (i & 3); }

struct Unit { int pm, pn; };
struct Gemm { const bf16_t* A; const bf16_t* Bt; int M, N, K; int compactA; };

struct StaticOrder {
    int nM, nN, nwg, G, c;
    __host__ __device__ void init(int M, int N, int G_, int c_) { nM = M / BM; nN = N / BM; nwg = nM * nN; G = G_; c = c_; }
    __host__ __device__ bool next(int i, Unit& u) const {
        const long L = (long)i * G + c; if (L >= nwg) return false;
        int wgid = (int)L; { const int q = nwg / NXCD, r = nwg % NXCD, xcd = wgid % NXCD, off = wgid / NXCD; wgid = (xcd < r ? xcd * (q + 1) : r * (q + 1) + (xcd - r) * q) + off; }
        const int nig = WGM * nN, gid = wgid / nig, fm = gid * WGM, gsz = (nM - fm) < WGM ? (nM - fm) : WGM;
        u.pm = fm + ((wgid % nig) % gsz); u.pn = (wgid % nig) / gsz; return true;
    }
    __device__ __forceinline__ void a_ready(const Unit&) const {}
    __device__ __forceinline__ void done(const Unit&) const {}
};

template <class Epi, class Sched, bool ALIGN_EPI = false, bool SP2 = false>
__device__ __forceinline__ void gemm_phase(PG8_LAS unsigned char* lds, const Gemm g, const Sched& S, const Epi& E) {
    int tid_l = threadIdx.x; asm volatile("" : "+v"(tid_l));
    const int tid = tid_l, wid = __builtin_amdgcn_readfirstlane(tid >> 6), lane = tid & 63, wr = wid >> 2, wc = wid & 3, fr = lane & 15, fq = lane >> 4;
    const int K = g.K, nt = K / BK;
    unsigned voffA[2], voffB[2];
#pragma unroll
    for (int i = 0; i < 2; ++i) { int R, C; stage_rc(tid * 16 + i * 8192, R, C); const int Rb = Epi::PERM ? ((R & ~31) + perm32(R & 31)) : R;
        voffA[i] = (unsigned)(R * K + C) * 2u; voffB[i] = (unsigned)(Rb * K + C) * 2u; }
    const size_t kstep = (size_t)(BK * 2);
    const int ks = ((int)(blockIdx.x & 7) * (nt >> 3)) & ~1;
#define PG8_KOFF(j) ((size_t)((((j) + ks) & (nt - 1))) * kstep)
    const size_t hstep = (size_t)HALF * K * 2;
    const size_t tstep = 2 * hstep;
    const unsigned ldsw = (unsigned)wid * 1024u;
    const int aoff = lds_byte(wr * 64 + fr, fq * 8), boff = lds_byte(wc * 32 + fr, fq * 8);
#define PG8_SA(b, h) (((b) * 2 + (h)) * HTB)
#define PG8_SB(b, h) ((4 + (b) * 2 + (h)) * HTB)
#define PG8_STAGE(bufoff, gbase, voff) do { _Pragma("unroll") for (int _i = 0; _i < 2; ++_i) \
        __builtin_amdgcn_global_load_lds((const unsigned*)((const char*)(gbase) + (voff)[_i]), (PG8_LAS unsigned*)(lds + (bufoff) + ldsw + _i * 8192), 16, 0, 0); } while (0)
#define PG8_LDA(dst, b, h) do { _Pragma("unroll") for (int m = 0; m < 4; ++m) _Pragma("unroll") for (int k = 0; k < 2; ++k) dst[m][k] = *(const PG8_LAS bf16x8*)(lds + PG8_SA(b, h) + aoff + m * 2048 + k * 1024); } while (0)
#define PG8_LDB(dst, b, h) do { _Pragma("unroll") for (int n = 0; n < 2; ++n) _Pragma("unroll") for (int k = 0; k < 2; ++k) dst[n][k] = *(const PG8_LAS bf16x8*)(lds + PG8_SB(b, h) + boff + n * 2048 + k * 1024); } while (0)
#define PG8_MMA(ai, bj, At, Bt) do { __builtin_amdgcn_s_setprio(1); _Pragma("unroll") for (int m = 0; m < 4; ++m) _Pragma("unroll") for (int n = 0; n < 2; ++n) _Pragma("unroll") for (int k = 0; k < 2; ++k) \
        acc[ai][bj][m][n] = __builtin_amdgcn_mfma_f32_16x16x32_bf16(Bt[n][k], At[m][k], acc[ai][bj][m][n], 0, 0, 0); __builtin_amdgcn_s_setprio(0); } while (0)
#define PG8_WAIT_V(n) asm volatile("s_waitcnt vmcnt(" #n ")" ::: "memory")
#define PG8_WAIT_L(n) asm volatile("s_waitcnt lgkmcnt(" #n ")" ::: "memory")
#define PG8_BAR __builtin_amdgcn_s_barrier()
#define PG8_SCHED __builtin_amdgcn_sched_barrier(0)
    Unit cur, nxt; int ui = 0;
    if (!S.next(0, cur)) return;
    f32x4 acc[2][2][4][2];
#pragma unroll
    for (int a = 0; a < 2; ++a)
#pragma unroll
        for (int b = 0; b < 2; ++b)
#pragma unroll
            for (int m = 0; m < 4; ++m)
#pragma unroll
                for (int n = 0; n < 2; ++n) acc[a][b][m][n] = (f32x4){0.f, 0.f, 0.f, 0.f};
    bf16x8 At[4][2], B0[2][2], B1[2][2];
    const char* cA = (const char*)g.A + (size_t)(g.compactA ? cur.pm * 256 : rowbase(cur.pm)) * (size_t)(K * 2); const char* cB = (const char*)g.Bt + (size_t)cur.pn * tstep;
    S.a_ready(cur);
    if constexpr (SP2) {
        PG8_STAGE(PG8_SB(0, 0), cB + PG8_KOFF(0), voffB); PG8_STAGE(PG8_SB(0, 1), cB + hstep + PG8_KOFF(0), voffB); PG8_STAGE(PG8_SA(0, 0), cA + PG8_KOFF(0), voffA); PG8_STAGE(PG8_SA(0, 1), cA + hstep + PG8_KOFF(0), voffA);
        if (wr == 1) PG8_BAR;
        PG8_WAIT_V(2); PG8_BAR;
        PG8_STAGE(PG8_SB(1, 0), cB + PG8_KOFF(1), voffB); PG8_STAGE(PG8_SA(1, 0), cA + PG8_KOFF(1), voffA); PG8_STAGE(PG8_SB(1, 1), cB + hstep + PG8_KOFF(1), voffB);
        PG8_WAIT_V(6); PG8_BAR;
    } else {
        PG8_STAGE(PG8_SB(0, 0), cB + PG8_KOFF(0), voffB); PG8_STAGE(PG8_SA(0, 0), cA + PG8_KOFF(0), voffA); PG8_STAGE(PG8_SB(0, 1), cB + hstep + PG8_KOFF(0), voffB); PG8_STAGE(PG8_SA(0, 1), cA + hstep + PG8_KOFF(0), voffA);
        if (wr == 1) PG8_BAR;
        PG8_WAIT_V(4); PG8_BAR;
        PG8_STAGE(PG8_SB(1, 0), cB + PG8_KOFF(1), voffB); PG8_STAGE(PG8_SA(1, 0), cA + PG8_KOFF(1), voffA); PG8_STAGE(PG8_SB(1, 1), cB + hstep + PG8_KOFF(1), voffB);
        PG8_WAIT_V(6); PG8_BAR;
    }
    for (;;) {
        const bool has_next = S.next(ui + 1, nxt);
        const char* nA = has_next ? (const char*)g.A + (size_t)(g.compactA ? nxt.pm * 256 : rowbase(nxt.pm)) * (size_t)(K * 2) : cA; const char* nB = has_next ? (const char*)g.Bt + (size_t)nxt.pn * tstep : cB;
        for (int t = 0; t < nt; t += 2) {
            const bool last = (t == nt - 2);
            const char* a1 = cA + PG8_KOFF(t + 1);
            const char* a2 = last ? nA + PG8_KOFF(0) : cA + PG8_KOFF(t + 2); const char* b2 = last ? nB + PG8_KOFF(0) : cB + PG8_KOFF(t + 2);
            const char* a3 = last ? nA + PG8_KOFF(1) : cA + PG8_KOFF(t + 3); const char* b3 = last ? nB + PG8_KOFF(1) : cB + PG8_KOFF(t + 3);
            if (last && has_next) S.a_ready(nxt);
            if constexpr (SP2) {
            PG8_LDB(B0, 0, 0); PG8_LDB(B1, 0, 1); PG8_SCHED; PG8_LDA(At, 0, 0); PG8_STAGE(PG8_SA(1, 1), a1 + hstep, voffA);
            PG8_WAIT_V(8); PG8_WAIT_L(0); PG8_BAR; PG8_MMA(0, 0, At, B0); PG8_MMA(0, 1, At, B1); PG8_BAR; PG8_SCHED;
            PG8_LDA(At, 0, 1); PG8_STAGE(PG8_SB(0, 0), b2, voffB); PG8_STAGE(PG8_SB(0, 1), b2 + hstep, voffB); PG8_STAGE(PG8_SA(0, 0), a2, voffA);
            PG8_WAIT_V(8); PG8_WAIT_L(0); PG8_BAR; PG8_MMA(1, 0, At, B0); PG8_MMA(1, 1, At, B1); PG8_BAR; PG8_SCHED;
            PG8_LDB(B0, 1, 0); PG8_LDB(B1, 1, 1); PG8_SCHED; PG8_LDA(At, 1, 0); PG8_STAGE(PG8_SA(0, 1), a2 + hstep, voffA);
            PG8_WAIT_V(8); PG8_WAIT_L(0); PG8_BAR; PG8_MMA(0, 0, At, B0); PG8_MMA(0, 1, At, B1); PG8_BAR; PG8_SCHED;
            PG8_LDA(At, 1, 1); PG8_STAGE(PG8_SB(1, 0), b3, voffB); PG8_STAGE(PG8_SB(1, 1), b3 + hstep, voffB); PG8_STAGE(PG8_SA(1, 0), a3, voffA);
            PG8_WAIT_V(8); PG8_WAIT_L(0); PG8_BAR; PG8_MMA(1, 0, At, B0); PG8_MMA(1, 1, At, B1); PG8_BAR; PG8_SCHED;
            } else {
            PG8_LDB(B0, 0, 0); PG8_SCHED; PG8_LDA(At, 0, 0); PG8_STAGE(PG8_SA(1, 1), a1 + hstep, voffA);
            PG8_WAIT_L(8); PG8_BAR; PG8_WAIT_L(0); PG8_MMA(0, 0, At, B0); PG8_BAR; PG8_SCHED;
            PG8_LDB(B1, 0, 1); PG8_STAGE(PG8_SB(0, 0), b2, voffB);
            PG8_BAR; PG8_WAIT_L(0); PG8_MMA(0, 1, At, B1); PG8_BAR;
            PG8_LDA(At, 0, 1); PG8_STAGE(PG8_SA(0, 0), a2, voffA);
            PG8_BAR; PG8_WAIT_L(0); PG8_MMA(1, 0, At, B0); PG8_BAR; PG8_SCHED;
            PG8_STAGE(PG8_SB(0, 1), b2 + hstep, voffB);
            PG8_WAIT_V(6); PG8_BAR; PG8_MMA(1, 1, At, B1); PG8_BAR;
            PG8_LDB(B0, 1, 0); PG8_SCHED; PG8_LDA(At, 1, 0); PG8_STAGE(PG8_SA(0, 1), a2 + hstep, voffA);
            PG8_WAIT_L(8); PG8_BAR; PG8_WAIT_L(0); PG8_MMA(0, 0, At, B0); PG8_BAR; PG8_SCHED;
            PG8_LDB(B1, 1, 1); PG8_STAGE(PG8_SB(1, 0), b3, voffB);
            PG8_BAR; PG8_WAIT_L(0); PG8_MMA(0, 1, At, B1); PG8_BAR;
            PG8_LDA(At, 1, 1); PG8_STAGE(PG8_SA(1, 0), a3, voffA);
            PG8_BAR; PG8_WAIT_L(0); PG8_MMA(1, 0, At, B0); PG8_BAR; PG8_SCHED;
            PG8_STAGE(PG8_SB(1, 1), b3 + hstep, voffB);
            PG8_WAIT_V(6); PG8_BAR; PG8_MMA(1, 1, At, B1); PG8_BAR;
            }
        }
        if constexpr (ALIGN_EPI) { if (wr == 0) PG8_BAR; }
        if constexpr (!Epi::AFTER_DRAIN) { E(acc, cur, wr, wc, fr, fq); S.done(cur); }
        if (!has_next) break;
#pragma unroll
        for (int a = 0; a < 2; ++a)
#pragma unroll
            for (int b = 0; b < 2; ++b)
#pragma unroll
                for (int m = 0; m < 4; ++m)
#pragma unroll
                    for (int n = 0; n < 2; ++n) acc[a][b][m][n] = (f32x4){0.f, 0.f, 0.f, 0.f};
        cur = nxt; cA = nA; cB = nB; ++ui;
        if constexpr (ALIGN_EPI) { if (wr == 1) PG8_BAR; }
    }
    PG8_WAIT_V(0);
    if constexpr (!ALIGN_EPI) { if (wr == 0) PG8_BAR; }
    PG8_BAR;
    if constexpr (Epi::AFTER_DRAIN) { E.fused(acc, cur, wr, wc, fr, fq, lds, wid, lane); S.done(cur); }
#undef PG8_KOFF
#undef PG8_SA
#undef PG8_SB
#undef PG8_STAGE
#undef PG8_LDA
#undef PG8_LDB
#undef PG8_MMA
#undef PG8_WAIT_V
#undef PG8_WAIT_L
#undef PG8_BAR
#undef PG8_SCHED
}
}

#define LAS __attribute__((address_space(3)))
typedef unsigned short bf16_t;
typedef short bf16x8 __attribute__((ext_vector_type(8)));
typedef short s16x4 __attribute__((ext_vector_type(4)));
typedef float f32x2 __attribute__((ext_vector_type(2)));
typedef float f32x4 __attribute__((ext_vector_type(4)));
typedef float f32x16 __attribute__((ext_vector_type(16)));
typedef unsigned u32x2 __attribute__((ext_vector_type(2)));
typedef unsigned u32x4 __attribute__((ext_vector_type(4)));
typedef __bf16 bf16x2v __attribute__((ext_vector_type(2)));

constexpr int DM = 1024, NB = 8, SEQ = 4096, NMETA = 16, PADF = 112, PP = 4224, RP = NB * PP, DFF = 4096;
constexpr int NTHR = 512;
constexpr int LDS_BYTES = 147456;
constexpr size_t UNIT = (size_t)RP * 1024 * 2;
constexpr size_t WS_R0 = 0, WS_R1 = 2 * UNIT, WS_R2 = 3 * UNIT, WS_R3 = 4 * UNIT, WS_R4 = 5 * UNIT;
constexpr size_t WS_WIN = 6 * UNIT;
constexpr size_t WS_WOUT = WS_WIN + (size_t)5120 * 1024 * 2;
constexpr size_t WS_W1 = WS_WOUT + (size_t)1024 * 2048 * 2;
constexpr size_t WS_W2 = WS_W1 + 2 * (size_t)4096 * 1024 * 2;
constexpr size_t WS_WQKV = WS_W2 + 2 * (size_t)4096 * 1024 * 2;
constexpr size_t WS_WO = WS_WQKV + (size_t)3072 * 1024 * 2;
constexpr size_t WS_ROPE = WS_WO + (size_t)1024 * 1024 * 2;
constexpr size_t WS_SS = WS_ROPE + (size_t)PP * 64 * 8;
constexpr size_t SS_BYTES = (size_t)RP * 16 * 4;
constexpr size_t WS_METAH = WS_SS + 4 * SS_BYTES;
constexpr size_t WS_HM1 = WS_METAH;
constexpr size_t WS_HIDM = WS_HM1 + (size_t)16 * 1024 * 4;
constexpr size_t WS_HM2P = WS_HIDM + (size_t)16 * 4096 * 4;
constexpr size_t WS_END = WS_HM2P + (size_t)4 * 16 * 1024 * 4 + 16384;

__device__ __forceinline__ unsigned pk2(float a, float b) { f32x2 v = {a, b}; bf16x2v r = __builtin_convertvector(v, bf16x2v); return __builtin_bit_cast(unsigned, r); }
__device__ __forceinline__ float bf_lo(unsigned u) { return __uint_as_float(u << 16); }
__device__ __forceinline__ float bf_hi(unsigned u) { return __uint_as_float(u & 0xffff0000u); }
__device__ __forceinline__ float wave_sum(float v) {
#pragma unroll
    for (int o = 1; o < 64; o <<= 1) v += __shfl_xor(v, o);
    return v;
}
__device__ __forceinline__ float rs_of(const float* ssp, int row) {
    const f32x4* s = (const f32x4*)(ssp + (size_t)row * 16);
    const f32x4 a = (s[0] + s[1]) + (s[2] + s[3]);
    return rsqrtf(((a.x + a.y) + (a.z + a.w)) * (1.0f / 1024.0f) + 1e-6f);
}
__device__ __forceinline__ float lg2gamma(int h) { return h == 0 ? -0.04580368961312479f : h == 1 ? -0.02272007650008353f : h == 2 ? -0.011315313227834146f : -0.005646563141142063f; }
__device__ __forceinline__ float fexp2(float x) { return __builtin_amdgcn_exp2f(x); }
__device__ __forceinline__ float frcp(float x) { return __builtin_amdgcn_rcpf(x); }
__device__ __forceinline__ float sigmoidf_(float x) { return frcp(1.0f + fexp2(-1.4426950408889634f * x)); }
__device__ __forceinline__ int crow(int r, int h) { return (r & 3) + 8 * (r >> 2) + 4 * h; }
#define MFMA32(a, b, c) __builtin_amdgcn_mfma_f32_32x32x16_bf16((a), (b), (c), 0, 0, 0)
#define LDS_WAIT() asm volatile("s_waitcnt lgkmcnt(0)" ::: "memory")

__device__ __forceinline__ int l2p_in(int c) {
    if (c < 1024) { const int blk = c >> 9, cc = c & 511, head = cc >> 7, dd = cc & 127, n = dd >> 6, rem = dd & 63, wc = rem >> 4, fq = (rem >> 2) & 3, i = rem & 3;
        return blk * 512 + (head >> 1) * 256 + (head & 1) * 128 + wc * 32 + fq * 8 + n * 4 + i; }
    if (c < 3072) return c;
    const int cu = c - 3072, n = cu >> 10, ch = cu & 1023, pu = ch >> 7, r = ch & 127, bj = r >> 6, r2 = r & 63, wc = r2 >> 4, fq = (r2 >> 2) & 3, i = r2 & 3;
    return 3072 + pu * 256 + bj * 128 + wc * 32 + fq * 8 + n * 4 + i;
}
__device__ __forceinline__ int l2p_qkv(int c) {
    const int blk = c >> 10, cc = c & 1023, head = cc >> 6, d = cc & 63, pnp = head >> 2, wc = head & 3, bj = d >> 5, fq = (d >> 3) & 3, n = (d >> 2) & 1, i = d & 3;
    return blk * 1024 + pnp * 256 + bj * 128 + wc * 32 + fq * 8 + n * 4 + i;
}

typedef f32x4 AccT[2][2][4][2];

constexpr int RS_TAB_OFF = 140288;
struct RsIssue { f32x4 a0, a1; int row, half; };
__device__ __forceinline__ RsIssue rs_tab_issue(const float* ssp, int rb, int wr, int wc, int fr, int fq) {
    RsIssue r; const int t = (wr * 4 + wc) * 64 + fq * 16 + fr; r.row = t >> 1; r.half = t & 1;
    const f32x4* sp = (const f32x4*)(ssp + (size_t)(rb + r.row) * 16 + r.half * 8);
    r.a0 = sp[0]; r.a1 = sp[1]; return r;
}
__device__ __forceinline__ void rs_tab_finish(const RsIssue& r, LAS float* tab) {
    const f32x4 a = r.a0 + r.a1;
    float sum = (a.x + a.y) + (a.z + a.w);
    sum += __shfl_xor(sum, 1);
    if (!r.half) tab[r.row] = rsqrtf(sum * (1.0f / 1024.0f) + 1e-6f);
    asm volatile("s_waitcnt lgkmcnt(0)" ::: "memory"); __builtin_amdgcn_s_barrier(); asm volatile("" ::: "memory");
}

struct EpiIn {
    static constexpr bool PERM = true, AFTER_DRAIN = false;
    const float* rsv; bf16_t *qk, *v, *gs, *hdn;
    __device__ __forceinline__ void operator()(const AccT& acc, const pg8::Unit& u, int wr, int wc, int fr, int fq) const {
        const int pn = u.pn, rb = rowbase(u.pm), pb = 128 + (u.pm & 15) * 256;
        float rsr[2][4];
#pragma unroll
        for (int ai = 0; ai < 2; ++ai)
#pragma unroll
            for (int m = 0; m < 4; ++m) rsr[ai][m] = rsv[rb + ai * 128 + wr * 64 + m * 16 + fr];
        float invf[4];
#pragma unroll
        for (int i = 0; i < 4; ++i) invf[i] = exp2f(-(float)(16 * wc + 4 * fq + i) * 0.20762050593046014f);
#pragma unroll
        for (int ai = 0; ai < 2; ++ai)
#pragma unroll
            for (int m = 0; m < 4; ++m) {
                const int loc = ai * 128 + wr * 64 + m * 16 + fr;
                const int row = rb + loc, p = pb + loc;
                const float rs = rsr[ai][m];
                if (pn < 4) {
                    float cs[4], sn[4];
#pragma unroll
                    for (int i = 0; i < 4; ++i) {
                        const float ang = (float)p * invf[i];
                        const float nrev = rintf(ang * 0.15915493667125702f);
                        float r = fmaf(ang, 0.15915493667125702f, -nrev); r = fmaf(ang, 6.4206382432985265e-09f, r);
                        cs[i] = __builtin_amdgcn_cosf(r); sn[i] = __builtin_amdgcn_sinf(r);
                    }
                    const float ip1 = (float)((p & 127) + 1);
#pragma unroll
                    for (int bj = 0; bj < 2; ++bj) {
                        const int head = 2 * (pn & 1) + bj;
                        const float lg = lg2gamma(head);
                        const float fac = (pn < 2) ? fexp2(ip1 * lg) : fexp2(-ip1 * lg) * 0.08838834764831845f;
                        const f32x4 x1 = acc[ai][bj][m][0] * rs, x2 = acc[ai][bj][m][1] * rs;
                        float y1[4], y2[4];
#pragma unroll
                        for (int i = 0; i < 4; ++i) { y1[i] = (x1[i] * cs[i] - x2[i] * sn[i]) * fac; y2[i] = (x1[i] * sn[i] + x2[i] * cs[i]) * fac; }
                        u32x4 w; w.x = pk2(y1[0], y1[1]); w.y = pk2(y1[2], y1[3]); w.z = pk2(y2[0], y2[1]); w.w = pk2(y2[2], y2[3]);
                        *(u32x4*)(qk + (size_t)row * 1024 + 256 * pn + 128 * bj + 32 * wc + 8 * fq) = w;
                    }
                } else if (pn < 8) {
#pragma unroll
                    for (int bj = 0; bj < 2; ++bj) {
                        const f32x4 a = acc[ai][bj][m][0] * rs, b = acc[ai][bj][m][1] * rs;
                        u32x4 w; w.x = pk2(a[0], a[1]); w.y = pk2(a[2], a[3]); w.z = pk2(b[0], b[1]); w.w = pk2(b[2], b[3]);
                        *(u32x4*)(v + (size_t)row * 1024 + 256 * (pn - 4) + 128 * bj + 32 * wc + 8 * fq) = w;
                    }
                } else if (pn < 12) {
#pragma unroll
                    for (int bj = 0; bj < 2; ++bj) {
                        f32x4 a = acc[ai][bj][m][0] * rs, b = acc[ai][bj][m][1] * rs;
#pragma unroll
                        for (int i = 0; i < 4; ++i) { a[i] = a[i] * sigmoidf_(a[i]); b[i] = b[i] * sigmoidf_(b[i]); }
                        u32x4 w; w.x = pk2(a[0], a[1]); w.y = pk2(a[2], a[3]); w.z = pk2(b[0], b[1]); w.w = pk2(b[2], b[3]);
                        *(u32x4*)(gs + (size_t)row * 1024 + 256 * (pn - 8) + 128 * bj + 32 * wc + 8 * fq) = w;
                    }
                } else {
#pragma unroll
                    for (int bj = 0; bj < 2; ++bj) {
                        const f32x4 a = acc[ai][bj][m][0] * rs, g = acc[ai][bj][m][1] * rs;
                        float o[4];
#pragma unroll
                        for (int i = 0; i < 4; ++i) o[i] = a[i] * sigmoidf_(g[i]);
                        u32x2 w; w.x = pk2(o[0], o[1]); w.y = pk2(o[2], o[3]);
                        *(u32x2*)(hdn + (size_t)row * 1024 + 128 * (pn - 12) + 64 * bj + 16 * wc + 4 * fq) = w;
                    }
                }
            }
    }
};

template <int BASE  , bool OUT_F32>
struct EpiRes {
    static constexpr bool PERM = true, AFTER_DRAIN = false;
    const float* bx; float* ox; bf16_t* hb; float* ssp;
    __device__ __forceinline__ void operator()(const AccT& acc, const pg8::Unit& u, int wr, int wc, int fr, int fq) const {
        const int col0 = u.pn * 256 + wc * 32 + 8 * fq, rb = rowbase(u.pm);
        if (BASE == 0) {
#pragma unroll
            for (int ai = 0; ai < 2; ++ai) {
                f32x4 base[4][2][2];
#pragma unroll
                for (int m = 0; m < 4; ++m) { const size_t off = (size_t)(u.pm * 256 + ai * 128 + wr * 64 + m * 16 + fr) * DM;
#pragma unroll
                    for (int bj = 0; bj < 2; ++bj) { base[m][bj][0] = *(const f32x4*)(bx + off + col0 + 128 * bj); base[m][bj][1] = *(const f32x4*)(bx + off + col0 + 128 * bj + 4); } }
#pragma unroll
                for (int m = 0; m < 4; ++m) {
                    const int row = rb + ai * 128 + wr * 64 + m * 16 + fr;
                    float ss = 0.f;
#pragma unroll
                    for (int bj = 0; bj < 2; ++bj) {
                        const f32x4 h0 = base[m][bj][0] + acc[ai][bj][m][0], h1 = base[m][bj][1] + acc[ai][bj][m][1];
                        ss += (h0[0] * h0[0] + h0[1] * h0[1]) + (h0[2] * h0[2] + h0[3] * h0[3]) + (h1[0] * h1[0] + h1[1] * h1[1]) + (h1[2] * h1[2] + h1[3] * h1[3]);
                        u32x4 w; w.x = pk2(h0[0], h0[1]); w.y = pk2(h0[2], h0[3]); w.z = pk2(h1[0], h1[1]); w.w = pk2(h1[2], h1[3]);
                        *(u32x4*)(hb + (size_t)row * 1024 + col0 + 128 * bj) = w;
                    }
                    ss += __shfl_xor(ss, 16); ss += __shfl_xor(ss, 32);
                    if (fq == 0) ssp[(size_t)row * 16 + u.pn * 4 + wc] = ss;
                }
            }
        } else {
            u32x4 base[2][4][2];
#pragma unroll
            for (int ai = 0; ai < 2; ++ai)
#pragma unroll
                for (int m = 0; m < 4; ++m) { const int row = rb + ai * 128 + wr * 64 + m * 16 + fr;
                    const bf16_t* bsrc = (BASE == 2) ? (const bf16_t*)bx + (size_t)(u.pm * 256 + ai * 128 + wr * 64 + m * 16 + fr) * 1024 : hb + (size_t)row * 1024;
#pragma unroll
                    for (int bj = 0; bj < 2; ++bj) base[ai][m][bj] = *(const u32x4*)(bsrc + col0 + 128 * bj); }
#pragma unroll
            for (int ai = 0; ai < 2; ++ai)
#pragma unroll
                for (int m = 0; m < 4; ++m) {
                    const int loc = ai * 128 + wr * 64 + m * 16 + fr, row = rb + loc;
                    const size_t off = (size_t)(u.pm * 256 + loc) * DM;
                    float ss = 0.f;
#pragma unroll
                    for (int bj = 0; bj < 2; ++bj) {
                        const u32x4 bv = base[ai][m][bj];
                        const f32x4 h0 = (f32x4){bf_lo(bv.x), bf_hi(bv.x), bf_lo(bv.y), bf_hi(bv.y)} + acc[ai][bj][m][0];
                        const f32x4 h1 = (f32x4){bf_lo(bv.z), bf_hi(bv.z), bf_lo(bv.w), bf_hi(bv.w)} + acc[ai][bj][m][1];
                        if (OUT_F32) {
                            *(f32x4*)(ox + off + col0 + 128 * bj) = h0;
                            *(f32x4*)(ox + off + col0 + 128 * bj + 4) = h1;
                        } else {
                            ss += (h0[0] * h0[0] + h0[1] * h0[1]) + (h0[2] * h0[2] + h0[3] * h0[3]) + (h1[0] * h1[0] + h1[1] * h1[1]) + (h1[2] * h1[2] + h1[3] * h1[3]);
                            u32x4 w; w.x = pk2(h0[0], h0[1]); w.y = pk2(h0[2], h0[3]); w.z = pk2(h1[0], h1[1]); w.w = pk2(h1[2], h1[3]);
                            *(u32x4*)(hb + (size_t)row * 1024 + col0 + 128 * bj) = w;
                        }
                    }
                    if (!OUT_F32) {
                        ss += __shfl_xor(ss, 16); ss += __shfl_xor(ss, 32);
                        if (fq == 0) ssp[(size_t)row * 16 + u.pn * 4 + wc] = ss;
                    }
                }
        }
    }
};

struct EpiUp {
    static constexpr bool PERM = true, AFTER_DRAIN = false;
    const float* ssp; bf16_t* hid; LAS float* tab;
    __device__ __forceinline__ void operator()(const AccT& acc_, const pg8::Unit& u, int wr, int wc, int fr, int fq) const {
        AccT& acc = const_cast<AccT&>(acc_);
        const int col0 = u.pn * 256 + wc * 32 + 8 * fq, rb = rowbase(u.pm);
        const RsIssue ri = rs_tab_issue(ssp, rb, wr, wc, fr, fq);
#pragma unroll
        for (int ai = 0; ai < 2; ++ai)
#pragma unroll
            for (int bj = 0; bj < 2; ++bj)
#pragma unroll
                for (int m = 0; m < 4; ++m)
#pragma unroll
                    for (int n = 0; n < 2; ++n) { f32x4 t = acc[ai][bj][m][n];
#pragma unroll
                        for (int i = 0; i < 4; ++i) t[i] = fmaxf(t[i], 0.f);
                        acc[ai][bj][m][n] = t * t; }
        rs_tab_finish(ri, tab);
#pragma unroll
        for (int ai = 0; ai < 2; ++ai)
#pragma unroll
            for (int m = 0; m < 4; ++m) {
                const int loc = ai * 128 + wr * 64 + m * 16 + fr, row = rb + loc;
                const float rs = tab[loc], rs2 = rs * rs;
#pragma unroll
                for (int bj = 0; bj < 2; ++bj) {
                    const f32x4 a = acc[ai][bj][m][0] * rs2, b = acc[ai][bj][m][1] * rs2;
                    u32x4 w; w.x = pk2(a[0], a[1]); w.y = pk2(a[2], a[3]); w.z = pk2(b[0], b[1]); w.w = pk2(b[2], b[3]);
                    *(u32x4*)(hid + (size_t)row * DFF + col0 + 128 * bj) = w;
                }
            }
    }
};

struct EpiQkv {
    static constexpr bool PERM = true, AFTER_DRAIN = false;
    const float* ssp; const float* qg; const float* kg; bf16_t* qkv; LAS float* tab;
    __device__ __forceinline__ void operator()(const AccT& acc, const pg8::Unit& u, int wr, int wc, int fr, int fq) const {
        const int blk = u.pn >> 2, head = 4 * (u.pn & 3) + wc, rb = rowbase(u.pm);
        bf16_t* dst = qkv + (size_t)blk * (UNIT / 2);
        const float* gg = blk == 0 ? qg : kg;
        const f32x4 g00 = *(const f32x4*)(gg + 8 * fq), g01 = *(const f32x4*)(gg + 8 * fq + 4), g10 = *(const f32x4*)(gg + 32 + 8 * fq), g11 = *(const f32x4*)(gg + 32 + 8 * fq + 4);
        const RsIssue ri = rs_tab_issue(ssp, rb, wr, wc, fr, fq);
        float ssr[2][4];
#pragma unroll
        for (int ai = 0; ai < 2; ++ai)
#pragma unroll
            for (int m = 0; m < 4; ++m) {
                const f32x4 t = acc[ai][0][m][0] * acc[ai][0][m][0] + acc[ai][0][m][1] * acc[ai][0][m][1] + acc[ai][1][m][0] * acc[ai][1][m][0] + acc[ai][1][m][1] * acc[ai][1][m][1];
                float ss = (t[0] + t[1]) + (t[2] + t[3]);
                ss += __shfl_xor(ss, 16); ss += __shfl_xor(ss, 32);
                ssr[ai][m] = ss;
            }
        rs_tab_finish(ri, tab);
        const float post = blk == 0 ? 0.18033688011112042f : 1.0f;
#pragma unroll
        for (int ai = 0; ai < 2; ++ai)
#pragma unroll
            for (int m = 0; m < 4; ++m) {
                const int loc = ai * 128 + wr * 64 + m * 16 + fr, row = rb + loc;
                const float rs = tab[loc];
                f32x4 v00 = acc[ai][0][m][0], v01 = acc[ai][0][m][1], v10 = acc[ai][1][m][0], v11 = acc[ai][1][m][1];
                if (blk < 2) {
                    const float sc = rs * rsqrtf(rs * rs * ssr[ai][m] * (1.0f / 64.0f) + 1e-6f) * post;
                    v00 = v00 * sc * g00; v01 = v01 * sc * g01; v10 = v10 * sc * g10; v11 = v11 * sc * g11;
                } else { v00 = v00 * rs; v01 = v01 * rs; v10 = v10 * rs; v11 = v11 * rs; }
                u32x4 w0, w1;
                w0.x = pk2(v00[0], v00[1]); w0.y = pk2(v00[2], v00[3]); w0.z = pk2(v01[0], v01[1]); w0.w = pk2(v01[2], v01[3]);
                w1.x = pk2(v10[0], v10[1]); w1.y = pk2(v10[2], v10[3]); w1.z = pk2(v11[0], v11[1]); w1.w = pk2(v11[2], v11[3]);
                *(u32x4*)(dst + (size_t)row * 1024 + head * 64 + 8 * fq) = w0;
                *(u32x4*)(dst + (size_t)row * 1024 + head * 64 + 32 + 8 * fq) = w1;
            }
    }
};

struct Params {
    const float *x, *meta, *norm_mix_g, *norm_mlp_g, *even_w_in, *even_gn_g, *even_conv_w, *even_conv_b, *even_ln_g, *even_ln_b, *even_w_out,
        *odd_w_qkv, *odd_qn_g, *odd_kn_g, *odd_w_o, *mlp_w1, *mlp_w2;
    float* out; unsigned char* ws;
};
typedef const __attribute__((address_space(4))) Params CParams;
__device__ __forceinline__ CParams* kparams() { CParams* kp = (CParams*)__builtin_amdgcn_kernarg_segment_ptr(); asm volatile("" : "+s"(kp)); return kp; }
#define KP (*kparams())

template <int MODE>
__device__ __forceinline__ void p0_transpose_item(const float* W, int K, int N, bf16_t* WT, const float* gain, LAS float* scr, int item, int lane) {
    const int nblk = N / 32, kb = item / nblk, nb = item % nblk, k0 = 64 * kb, n0 = 32 * nb;
    float wv[32];
#pragma unroll
    for (int i = 0; i < 32; ++i) wv[i] = W[(size_t)(k0 + 2 * i + (lane >> 5)) * N + n0 + (lane & 31)];
#pragma unroll
    for (int i = 0; i < 32; ++i) { const int kk = 2 * i + (lane >> 5); float w = wv[i]; if (gain) w *= gain[k0 + kk]; scr[kk * 33 + (lane & 31)] = w; }
    LDS_WAIT();
    const int c = lane & 7;
#pragma unroll
    for (int j = 0; j < 4; ++j) { const int n = (lane >> 3) + 8 * j; const LAS float* s = scr + (8 * c) * 33 + n;
        const int lc = n0 + n; const int prow = MODE == 1 ? l2p_in(lc) : (MODE == 2 ? l2p_qkv(lc) : lc);
        u32x4 o; o.x = pk2(s[0 * 33], s[1 * 33]); o.y = pk2(s[2 * 33], s[3 * 33]); o.z = pk2(s[4 * 33], s[5 * 33]); o.w = pk2(s[6 * 33], s[7 * 33]);
        *(u32x4*)(WT + (size_t)prow * K + k0 + 8 * c) = o; }
    LDS_WAIT();
}

__device__ __forceinline__ void phase0(CParams& P, LAS unsigned char* lds, int tid) {
    const int lane = tid & 63, wave = tid >> 6;
    const int gw = blockIdx.x * 8 + wave, NGW = gridDim.x * 8;
    LAS float* scr = (LAS float*)(lds + wave * 16384);
    unsigned char* ws = P.ws;
    constexpr int I_IN = 16 * 160, I_OUT = 32 * 32, I_W1 = 16 * 128, I_W2 = 64 * 32, I_QKV = 16 * 96, I_O = 16 * 32;
    constexpr int NITEMS = I_IN + I_OUT + 2 * I_W1 + 2 * I_W2 + I_QKV + I_O;
    for (int it = gw; it < NITEMS; it += NGW) {
        int r = it;
        if (r < I_IN) { p0_transpose_item<1>(P.even_w_in, 1024, 5120, (bf16_t*)(ws + WS_WIN), P.norm_mix_g, scr, r, lane); continue; } r -= I_IN;
        if (r < I_OUT) { p0_transpose_item<0>(P.even_w_out, 2048, 1024, (bf16_t*)(ws + WS_WOUT), nullptr, scr, r, lane); continue; } r -= I_OUT;
        if (r < I_W1) { p0_transpose_item<0>(P.mlp_w1, 1024, 4096, (bf16_t*)(ws + WS_W1), P.norm_mlp_g, scr, r, lane); continue; } r -= I_W1;
        if (r < I_W1) { p0_transpose_item<0>(P.mlp_w1 + (size_t)1024 * 4096, 1024, 4096, (bf16_t*)(ws + WS_W1) + (size_t)4096 * 1024, P.norm_mlp_g + 1024, scr, r, lane); continue; } r -= I_W1;
        if (r < I_W2) { p0_transpose_item<0>(P.mlp_w2, 4096, 1024, (bf16_t*)(ws + WS_W2), nullptr, scr, r, lane); continue; } r -= I_W2;
        if (r < I_W2) { p0_transpose_item<0>(P.mlp_w2 + (size_t)1024 * 4096, 4096, 1024, (bf16_t*)(ws + WS_W2) + (size_t)4096 * 1024, nullptr, scr, r, lane); continue; } r -= I_W2;
        if (r < I_QKV) { p0_transpose_item<2>(P.odd_w_qkv, 1024, 3072, (bf16_t*)(ws + WS_WQKV), P.norm_mix_g + 1024, scr, r, lane); continue; } r -= I_QKV;
        p0_transpose_item<0>(P.odd_w_o, 1024, 1024, (bf16_t*)(ws + WS_WO), nullptr, scr, r, lane);
    }
    float* rope = (float*)(ws + WS_ROPE);
    for (int i = blockIdx.x * NTHR + tid; i < PP * 64; i += gridDim.x * NTHR) {
        const int p = i >> 6, d = i & 63;
        const float inv = exp2f(-(float)d * 0.20762050593046014f);
        const float ang = (float)p * inv;
        double t = (double)ang * 0.15915494309189535; t -= floor(t);
        const float tf = (float)t;
        rope[2 * i] = __builtin_amdgcn_cosf(tf); rope[2 * i + 1] = __builtin_amdgcn_sinf(tf);
    }
    bf16_t* hb = (bf16_t*)P.out + (size_t)NB * SEQ * DM;
    float* rs0 = (float*)(ws + WS_SS);
    for (int m0 = 2 * gw; m0 < NB * SEQ; m0 += 2 * NGW) {
        f32x4 v[2][4];
#pragma unroll
        for (int q = 0; q < 2; ++q) { const f32x4* xr = (const f32x4*)(P.x + (size_t)(m0 + q) * DM) + lane;
#pragma unroll
            for (int j = 0; j < 4; ++j) v[q][j] = xr[64 * j]; }
#pragma unroll
        for (int q = 0; q < 2; ++q) {
            const int m = m0 + q, row = rowbase(m >> 8) + (m & 255);
            u32x2* o8 = (u32x2*)(hb + (size_t)m * 1024) + lane;
            float ss = 0.f;
#pragma unroll
            for (int j = 0; j < 4; ++j) { const f32x4 t = v[q][j]; ss += (t.x * t.x + t.y * t.y) + (t.z * t.z + t.w * t.w); u32x2 w; w.x = pk2(t.x, t.y); w.y = pk2(t.z, t.w); o8[64 * j] = w; }
            ss = wave_sum(ss);
            if (lane == 0) rs0[row] = rsqrtf(ss * (1.0f / 1024.0f) + 1e-6f);
        }
    }
    for (int i = gw; i < NB * PADF; i += NGW) {
        const int b = i / PADF, p = i - b * PADF; const size_t row = (size_t)b * PP + p;
        const u32x4 z = (u32x4){0u, 0u, 0u, 0u};
        u32x4* d4 = (u32x4*)(ws + WS_R4 + row * 2048) + lane; d4[0] = z; d4[64] = z;
        u32x4* d1 = (u32x4*)(ws + WS_R1 + row * 2048) + lane; d1[0] = z; d1[64] = z;
        u32x4* d3 = (u32x4*)(ws + WS_R3 + row * 2048) + lane; d3[0] = z; d3[64] = z;
    }
}

template <int NCOL, bool ABF, bool NORM, int UNR = 2>
__device__ __forceinline__ void meta_wave(const void* Aptr, int K, const bf16_t* Wt, const int (&wrow)[NCOL], int w, int lane, float (&out)[2][NCOL], float (&rs)[2]) {
    float q0 = 0.f, q1 = 0.f;
#pragma unroll
    for (int c = 0; c < NCOL; ++c) { out[0][c] = 0.f; out[1][c] = 0.f; }
#pragma unroll UNR
    for (int kc = lane; kc < (K >> 3); kc += 64) {
        float a0[8], a1[8];
        if (ABF) {
            const u32x4 u0 = *(const u32x4*)((const bf16_t*)Aptr + (size_t)(2 * w) * K + 8 * kc), u1 = *(const u32x4*)((const bf16_t*)Aptr + (size_t)(2 * w + 1) * K + 8 * kc);
            a0[0] = bf_lo(u0.x); a0[1] = bf_hi(u0.x); a0[2] = bf_lo(u0.y); a0[3] = bf_hi(u0.y); a0[4] = bf_lo(u0.z); a0[5] = bf_hi(u0.z); a0[6] = bf_lo(u0.w); a0[7] = bf_hi(u0.w);
            a1[0] = bf_lo(u1.x); a1[1] = bf_hi(u1.x); a1[2] = bf_lo(u1.y); a1[3] = bf_hi(u1.y); a1[4] = bf_lo(u1.z); a1[5] = bf_hi(u1.z); a1[6] = bf_lo(u1.w); a1[7] = bf_hi(u1.w);
        } else {
            const f32x4* p0 = (const f32x4*)((const float*)Aptr + (size_t)(2 * w) * K + 8 * kc); const f32x4* p1 = (const f32x4*)((const float*)Aptr + (size_t)(2 * w + 1) * K + 8 * kc);
            const f32x4 x0 = p0[0], x1 = p0[1], y0 = p1[0], y1 = p1[1];
#pragma unroll
            for (int i = 0; i < 4; ++i) { a0[i] = x0[i]; a0[4 + i] = x1[i]; a1[i] = y0[i]; a1[4 + i] = y1[i]; }
        }
        if (NORM) {
#pragma unroll
            for (int i = 0; i < 8; ++i) { q0 += a0[i] * a0[i]; q1 += a1[i] * a1[i]; }
        }
#pragma unroll
        for (int c = 0; c < NCOL; ++c) {
            const u32x4 wv = *(const u32x4*)(Wt + (size_t)wrow[c] * K + 8 * kc);
            const float wf[8] = {bf_lo(wv.x), bf_hi(wv.x), bf_lo(wv.y), bf_hi(wv.y), bf_lo(wv.z), bf_hi(wv.z), bf_lo(wv.w), bf_hi(wv.w)};
#pragma unroll
            for (int i = 0; i < 8; ++i) { out[0][c] += a0[i] * wf[i]; out[1][c] += a1[i] * wf[i]; }
        }
    }
#pragma unroll
    for (int c = 0; c < NCOL; ++c) { out[0][c] = wave_sum(out[0][c]); out[1][c] = wave_sum(out[1][c]); }
    if (NORM) { rs[0] = rsqrtf(wave_sum(q0) / (float)K + 1e-6f); rs[1] = rsqrtf(wave_sum(q1) / (float)K + 1e-6f); } else { rs[0] = 1.f; rs[1] = 1.f; }
}
template <int NN>
__device__ __forceinline__ float pick(LAS float* scr, const float (&a)[NN], int j, int lane) {
    if (lane == 0) {
#pragma unroll
        for (int i = 0; i < NN; ++i) scr[i] = a[i];
    }
    LDS_WAIT();
    const float r = scr[j];
    LDS_WAIT();
    return r;
}
__device__ __forceinline__ bf16_t bf1(float x) { return (bf16_t)(pk2(x, 0.f) & 0xffffu); }
__device__ __forceinline__ void store_meta_rows(bf16_t* buf, int r, int col, float val) {
    const bf16_t bv = bf1(val);
#pragma unroll
    for (int b = 0; b < NB; ++b) buf[((size_t)b * PP + PADF + r) * 1024 + col] = bv;
}
__device__ __forceinline__ void meta_in(CParams& P, LAS unsigned char* lds, int t, int tid) {
    const int lane = tid & 63, w = __builtin_amdgcn_readfirstlane(tid >> 6); int cb1, cb2, kind;
    if (t < 64) { const int pid = t * 8, blk = pid >> 8, head = (pid >> 6) & 3, d = pid & 63; kind = blk; cb1 = blk * 512 + head * 128 + d; cb2 = cb1 + 64; }
    else if (t < 192) { cb1 = 1024 + (t - 64) * 16; cb2 = cb1 + 8; kind = cb1 < 2048 ? 2 : 3; }
    else { kind = 4; cb1 = 3072 + (t - 192) * 8; cb2 = cb1 + 1024; }
    float o[2][16], rsv[2];
    int wrow[16];
#pragma unroll
    for (int c = 0; c < 8; ++c) { wrow[c] = l2p_in(cb1 + c); wrow[8 + c] = l2p_in(cb2 + c); }
    meta_wave<16, false, true>(P.meta, 1024, (const bf16_t*)(P.ws + WS_WIN), wrow, w, lane, o, rsv);
    unsigned char* ws = P.ws;
    const int j = lane & 7;
#pragma unroll
    for (int i = 0; i < 2; ++i) {
        const int r = 2 * w + i, p = PADF + r;
        if (kind <= 1 || kind == 4) {
            float lo8[8], hi8[8];
#pragma unroll
            for (int c = 0; c < 8; ++c) { lo8[c] = o[i][c]; hi8[c] = o[i][8 + c]; }
            const float y1 = pick<8>((LAS float*)(lds + 131072 + w * 1024), lo8, j, lane) * rsv[i], y2 = pick<8>((LAS float*)(lds + 131072 + w * 1024), hi8, j, lane) * rsv[i];
            if (lane < 8) {
                if (kind <= 1) {
                    const int head = (cb1 >> 7) & 3, d = (cb1 & 63) + j;
                    const float* rope = (const float*)(ws + WS_ROPE) + ((size_t)p * 64 + d) * 2;
                    const float c = rope[0], sn = rope[1];
                    const float ip1 = (float)(p + 1), lg = lg2gamma(head);
                    const float fac = kind == 0 ? fexp2(ip1 * lg) : fexp2(-ip1 * lg) * 0.08838834764831845f;
                    store_meta_rows((bf16_t*)(ws + WS_R4), r, l2p_in(cb1 + j), (y1 * c - y2 * sn) * fac);
                    store_meta_rows((bf16_t*)(ws + WS_R4), r, l2p_in(cb2 + j), (y1 * sn + y2 * c) * fac);
                } else {
                    store_meta_rows((bf16_t*)(ws + WS_R3), r, cb1 - 3072 + j, y1 * sigmoidf_(y2));
                }
            }
        } else {
            const float y = pick<16>((LAS float*)(lds + 131072 + w * 1024), o[i], lane & 15, lane) * rsv[i];
            if (lane < 16) {
                if (kind == 2) store_meta_rows((bf16_t*)(ws + WS_R1), r, cb1 - 1024 + lane, y);
                else store_meta_rows((bf16_t*)(ws + WS_R2), r, cb1 - 2048 + lane, y * sigmoidf_(y));
            }
        }
    }
}
__device__ __forceinline__ void meta_out(CParams& P, LAS unsigned char* lds, int t, int tid) {
    const int lane = tid & 63, w = __builtin_amdgcn_readfirstlane(tid >> 6);
    float o[2][4], rsv[2];
    const int wrow[4] = {4 * t, 4 * t + 1, 4 * t + 2, 4 * t + 3};
    meta_wave<4, true, false, 4>((const bf16_t*)(P.ws + WS_R0) + (size_t)PADF * 2048, 2048, (const bf16_t*)(P.ws + WS_WOUT), wrow, w, lane, o, rsv);
    float* hm1 = (float*)(P.ws + WS_HM1);
#pragma unroll
    for (int i = 0; i < 2; ++i) { const int r = 2 * w + i; const float y = pick<4>((LAS float*)(lds + 131072 + w * 1024), o[i], lane & 3, lane); if (lane < 4) hm1[r * 1024 + 4 * t + lane] = P.meta[r * 1024 + 4 * t + lane] + y; }
}
__device__ __forceinline__ void meta_up(CParams& P, LAS unsigned char* lds, int t, int tid) {
    const int lane = tid & 63, w = __builtin_amdgcn_readfirstlane(tid >> 6);
    float o[2][16], rsv[2];
    int wrow[16];
#pragma unroll
    for (int c = 0; c < 16; ++c) wrow[c] = 16 * t + c;
    meta_wave<16, false, true>((const float*)(P.ws + WS_HM1), 1024, (const bf16_t*)(P.ws + WS_W1), wrow, w, lane, o, rsv);
    float* hid = (float*)(P.ws + WS_HIDM);
#pragma unroll
    for (int i = 0; i < 2; ++i) { const int r = 2 * w + i; const float x = fmaxf(pick<16>((LAS float*)(lds + 131072 + w * 1024), o[i], lane & 15, lane) * rsv[i], 0.f); if (lane < 16) hid[r * 4096 + 16 * t + lane] = x * x; }
}
__device__ __forceinline__ void meta_down(CParams& P, LAS unsigned char* lds, int t, int tid) {
    const int lane = tid & 63, w = __builtin_amdgcn_readfirstlane(tid >> 6);
    float o[2][4], rsv[2];
    const int wrow[4] = {4 * t, 4 * t + 1, 4 * t + 2, 4 * t + 3};
    meta_wave<4, false, false, 4>((const float*)(P.ws + WS_HIDM), 4096, (const bf16_t*)(P.ws + WS_W2), wrow, w, lane, o, rsv);
    const float* hm1 = (const float*)(P.ws + WS_HM1);
    float* hm2 = (float*)(P.ws + WS_HM2P);
#pragma unroll
    for (int i = 0; i < 2; ++i) { const int r = 2 * w + i; const float y = pick<4>((LAS float*)(lds + 131072 + w * 1024), o[i], lane & 3, lane); if (lane < 4) hm2[r * 1024 + 4 * t + lane] = hm1[r * 1024 + 4 * t + lane] + y; }
}
constexpr size_t WS_KRAW = WS_HIDM, WS_VRAW = WS_HIDM + 65536, WS_KSS = WS_HIDM + 131072;
__device__ __forceinline__ void meta_kv(CParams& P, LAS unsigned char* lds, int t, int tid) {
    const int lane = tid & 63, w = __builtin_amdgcn_readfirstlane(tid >> 6);
    const int cb = 1024 + 16 * t;
    float o[2][16], rsv[2];
    int wrow[16];
#pragma unroll
    for (int c = 0; c < 16; ++c) wrow[c] = l2p_qkv(cb + c);
    meta_wave<16, false, true>((const float*)(P.ws + WS_HM2P), 1024, (const bf16_t*)(P.ws + WS_WQKV), wrow, w, lane, o, rsv);
    float* raw = (float*)(P.ws + (t < 64 ? WS_KRAW : WS_VRAW));
    float* kss = (float*)(P.ws + WS_KSS);
#pragma unroll
    for (int i = 0; i < 2; ++i) {
        const int r = 2 * w + i; float ss = 0.f;
#pragma unroll
        for (int c = 0; c < 16; ++c) { o[i][c] *= rsv[i]; ss += o[i][c] * o[i][c]; }
        const float y = pick<16>((LAS float*)(lds + 131072 + w * 1024), o[i], lane & 15, lane);
        if (lane < 16) raw[r * 1024 + 16 * (t & 63) + lane] = y;
        if (t < 64 && lane == 0) kss[r * 64 + t] = ss;
    }
}

__device__ __forceinline__ void load_T128(const bf16_t* src, int ld, int ncg, LAS unsigned char* dst, int tid) {
    for (int u = tid; u < 64 * ncg; u += NTHR) {
        const int jp = u & 63, cgi = u >> 6;
        const u32x4 a = *(const u32x4*)(src + (size_t)(2 * jp) * ld + cgi * 8), b = *(const u32x4*)(src + (size_t)(2 * jp + 1) * ld + cgi * 8);
        LAS unsigned* d = (LAS unsigned*)(dst + (cgi * 8) * 272 + jp * 4);
        d[0 * 68] = (a.x & 0xffffu) | (b.x << 16); d[1 * 68] = (a.x >> 16) | (b.x & 0xffff0000u);
        d[2 * 68] = (a.y & 0xffffu) | (b.y << 16); d[3 * 68] = (a.y >> 16) | (b.y & 0xffff0000u);
        d[4 * 68] = (a.z & 0xffffu) | (b.z << 16); d[5 * 68] = (a.z >> 16) | (b.z & 0xffff0000u);
        d[6 * 68] = (a.w & 0xffffu) | (b.w << 16); d[7 * 68] = (a.w >> 16) | (b.w & 0xffff0000u);
    }
}
template <int NU>
__device__ __forceinline__ void tload_issue(u32x4 (&a)[NU], u32x4 (&b)[NU], const bf16_t* src, int ld, int tid) {
#pragma unroll
    for (int i = 0; i < NU; ++i) { const int u = tid + i * NTHR, jp = u & 63, cgi = u >> 6;
        a[i] = *(const u32x4*)(src + (size_t)(2 * jp) * ld + cgi * 8); b[i] = *(const u32x4*)(src + (size_t)(2 * jp + 1) * ld + cgi * 8); }
}
template <int NU>
__device__ __forceinline__ void tload_store(const u32x4 (&a)[NU], const u32x4 (&b)[NU], LAS unsigned char* dst, int tid) {
#pragma unroll
    for (int i = 0; i < NU; ++i) { const int u = tid + i * NTHR, jp = u & 63, cgi = u >> 6;
        LAS unsigned* d = (LAS unsigned*)(dst + (cgi * 8) * 272 + jp * 4);
        d[0 * 68] = (a[i].x & 0xffffu) | (b[i].x << 16); d[1 * 68] = (a[i].x >> 16) | (b[i].x & 0xffff0000u);
        d[2 * 68] = (a[i].y & 0xffffu) | (b[i].y << 16); d[3 * 68] = (a[i].y >> 16) | (b[i].y & 0xffff0000u);
        d[4 * 68] = (a[i].z & 0xffffu) | (b[i].z << 16); d[5 * 68] = (a[i].z >> 16) | (b[i].z & 0xffff0000u);
        d[6 * 68] = (a[i].w & 0xffffu) | (b[i].w << 16); d[7 * 68] = (a[i].w >> 16) | (b[i].w & 0xffff0000u); }
}
constexpr int RET_KS = 0, RET_VT = 34816, RET_RED = 34816 + 69632;

__device__ __forceinline__ void ret_partial_item(CParams& P, LAS unsigned char* lds, int item, int tid) {
    asm volatile("" : "+v"(tid));
    const int lane = tid & 63, w = tid >> 6, l32 = lane & 31, hh = lane >> 5;
    int b, n, h;
    if (item < 128) { b = 0; n = item >> 2; h = item & 3; } else { const int j = item - 128; b = 1 + j / 124; const int r = j - (b - 1) * 124; n = 1 + (r >> 2); h = r & 3; }
    const bf16_t* qk = (const bf16_t*)(P.ws + WS_R4); const bf16_t* v = (const bf16_t*)(P.ws + WS_R1);
    bf16_t* G = (n == 0) ? (bf16_t*)(P.ws + WS_HIDM) + (size_t)h * 32768 : (bf16_t*)P.out + ((size_t)((b * 4 + h) * 32 + n)) * 32768;
    const size_t R0 = (size_t)b * PP + 128 * n;
    {
        u32x4 ka[2], kb[2], va[4], vb[4];
        tload_issue<2>(ka, kb, qk + R0 * 1024 + 512 + h * 128, 1024, tid);
        tload_issue<4>(va, vb, v + R0 * 1024 + h * 256, 1024, tid);
        tload_store<2>(ka, kb, lds + RET_KS, tid);
        tload_store<4>(va, vb, lds + RET_VT, tid);
    }
    __syncthreads();
    const int dt = w & 3, eh = w >> 2;
    f32x16 acc[4];
#pragma unroll
    for (int et = 0; et < 4; ++et)
#pragma unroll
        for (int r = 0; r < 16; ++r) acc[et][r] = 0.f;
#pragma unroll
    for (int s = 0; s < 8; ++s) {
        const bf16x8 a = *(const LAS bf16x8*)(lds + RET_KS + (32 * dt + l32) * 272 + (16 * s + 8 * hh) * 2);
#pragma unroll
        for (int et = 0; et < 4; ++et) {
            const bf16x8 bb = *(const LAS bf16x8*)(lds + RET_VT + (32 * (4 * eh + et) + l32) * 272 + (16 * s + 8 * hh) * 2);
            acc[et] = MFMA32(a, bb, acc[et]);
        }
    }
    __syncthreads();
#pragma unroll
    for (int et = 0; et < 4; ++et)
#pragma unroll
        for (int g = 0; g < 4; ++g) {
            u32x2 o; o.x = pk2(acc[et][4 * g], acc[et][4 * g + 1]); o.y = pk2(acc[et][4 * g + 2], acc[et][4 * g + 3]);
            *(LAS u32x2*)(lds + RET_VT + (32 * (4 * eh + et) + l32) * 272 + (32 * dt + 8 * g + 4 * hh) * 2) = o;
        }
    __syncthreads();
    for (int c = tid; c < 4096; c += NTHR) { const int e = c >> 4, part = c & 15; *(u32x4*)(G + (size_t)c * 8) = *(const LAS u32x4*)(lds + RET_VT + e * 272 + part * 16); }
    __syncthreads();
}

template <int NT>
__device__ __forceinline__ void conv_item(CParams& P, LAS unsigned char* lds, int b, int p0, int tid) {
    const int lane = tid & 63, w = tid >> 6;
    const bf16_t* hdn = (const bf16_t*)(P.ws + WS_R3);
    bf16_t* mix = (bf16_t*)(P.ws + WS_R0);
    const size_t Rb = (size_t)b * PP;
    const unsigned* hd = (const unsigned*)(hdn + (Rb + p0 - 30) * 1024) + tid;
    unsigned xr[NT + 30];
#pragma unroll
    for (int r = 0; r < NT + 30; ++r) xr[r] = hd[r * 512];
    f32x2 W[31];
#pragma unroll
    for (int k = 0; k < 31; ++k) W[k] = *(const f32x2*)(P.even_conv_w + k * 1024 + 2 * tid);
    const f32x2 bias = *(const f32x2*)(P.even_conv_b + 2 * tid);
    LAS float* ys = (LAS float*)lds;
#pragma unroll
    for (int hf = 0; hf < NT / 16; ++hf) {
        f32x2 acc[16];
#pragma unroll
        for (int t = 0; t < 16; ++t) acc[t] = bias;
#pragma unroll
        for (int r = 0; r < 46; ++r) {
            const f32x2 xf = {bf_lo(xr[16 * hf + r]), bf_hi(xr[16 * hf + r])};
#pragma unroll
            for (int t = 0; t < 16; ++t) { const int k = r - t; if (k >= 0 && k <= 30) acc[t] += xf * W[k]; }
        }
#pragma unroll
        for (int t = 0; t < 16; ++t) *(LAS f32x2*)(ys + (16 * hf + t) * 1024 + 2 * tid) = acc[t];
    }
    f32x4 lg[4], lb[4];
#pragma unroll
    for (int j = 0; j < 4; ++j) { lg[j] = *(const f32x4*)(P.even_ln_g + 4 * lane + 256 * j); lb[j] = *(const f32x4*)(P.even_ln_b + 4 * lane + 256 * j); }
    __syncthreads();
    constexpr int TW = NT / 8;
#pragma unroll
    for (int q0 = 0; q0 < TW; q0 += 2) {
        f32x4 y[2][4]; float s[2] = {0.f, 0.f};
#pragma unroll
        for (int q = 0; q < 2; ++q)
#pragma unroll
            for (int j = 0; j < 4; ++j) { y[q][j] = *(const LAS f32x4*)(ys + (TW * w + q0 + q) * 1024 + 4 * lane + 256 * j); s[q] += (y[q][j].x + y[q][j].y) + (y[q][j].z + y[q][j].w); }
#pragma unroll
        for (int o = 1; o < 64; o <<= 1) { s[0] += __shfl_xor(s[0], o); s[1] += __shfl_xor(s[1], o); }
        float qv[2] = {0.f, 0.f};
#pragma unroll
        for (int q = 0; q < 2; ++q) { const float mean = s[q] * (1.0f / 1024.0f);
#pragma unroll
            for (int j = 0; j < 4; ++j) { y[q][j] = y[q][j] - mean; qv[q] += (y[q][j].x * y[q][j].x + y[q][j].y * y[q][j].y) + (y[q][j].z * y[q][j].z + y[q][j].w * y[q][j].w); } }
#pragma unroll
        for (int o = 1; o < 64; o <<= 1) { qv[0] += __shfl_xor(qv[0], o); qv[1] += __shfl_xor(qv[1], o); }
#pragma unroll
        for (int q = 0; q < 2; ++q) {
            const float rstd = rsqrtf(qv[q] * (1.0f / 1024.0f) + 1e-6f);
            const size_t row = Rb + p0 + TW * w + q0 + q;
#pragma unroll
            for (int j = 0; j < 4; ++j) {
                f32x4 o = y[q][j] * rstd * lg[j] + lb[j];
#pragma unroll
                for (int i = 0; i < 4; ++i) o[i] = o[i] * sigmoidf_(o[i]);
                u32x2 wv; wv.x = pk2(o[0], o[1]); wv.y = pk2(o[2], o[3]);
                *(u32x2*)(mix + row * 2048 + 1024 + 4 * lane + 256 * j) = wv;
            }
        }
    }
    __syncthreads();
}

__device__ __forceinline__ void ret_scan(CParams& P, int tid) {
    bf16_t* G = (bf16_t*)P.out;
    for (int c = blockIdx.x * NTHR + tid; c < 32 * 4096; c += gridDim.x * NTHR) {
        const int bh = c >> 12, off = (c & 4095) * 8, h = bh & 3;
        const float lam = fexp2(128.0f * lg2gamma(h));
        bf16_t* ptr = G + (size_t)bh * 32 * 32768 + off;
        float S[8];
#pragma unroll
        for (int k = 0; k < 8; ++k) S[k] = 0.f;
#pragma unroll 8
        for (int n = 0; n < 32; ++n) {
            const u32x4 g = (n == 0) ? *(const u32x4*)((const bf16_t*)(P.ws + WS_HIDM) + (size_t)h * 32768 + off) : *(const u32x4*)(ptr + (size_t)n * 32768);
            S[0] = lam * (S[0] + bf_lo(g.x)); S[1] = lam * (S[1] + bf_hi(g.x)); S[2] = lam * (S[2] + bf_lo(g.y)); S[3] = lam * (S[3] + bf_hi(g.y));
            S[4] = lam * (S[4] + bf_lo(g.z)); S[5] = lam * (S[5] + bf_hi(g.z)); S[6] = lam * (S[6] + bf_lo(g.w)); S[7] = lam * (S[7] + bf_hi(g.w));
            u32x4 o; o.x = pk2(S[0], S[1]); o.y = pk2(S[2], S[3]); o.z = pk2(S[4], S[5]); o.w = pk2(S[6], S[7]);
            *(u32x4*)(ptr + (size_t)n * 32768) = o;
        }
    }
}

__device__ __forceinline__ void ret_out_item(CParams& P, LAS unsigned char* lds, int item, int tid) {
    asm volatile("" : "+v"(tid));
    const int lane = tid & 63, w = tid >> 6, l32 = lane & 31, hh = lane >> 5;
    const int b = item / 132, rem = item - b * 132, n = rem >> 2, h = rem & 3;
    const bf16_t* qk = (const bf16_t*)(P.ws + WS_R4); const bf16_t* v = (const bf16_t*)(P.ws + WS_R1); const bf16_t* gs = (const bf16_t*)(P.ws + WS_R2);
    bf16_t* mix = (bf16_t*)(P.ws + WS_R0);
    const size_t R0 = (size_t)b * PP + 128 * n;
    const int ib = w & 3, eh = w >> 2;
    bf16x8 qf[8];
    {
        u32x4 kt[4], va[4], vb[4];
#pragma unroll
        for (int i = 0; i < 4; ++i) { const int c = tid + i * NTHR; kt[i] = *(const u32x4*)(qk + (R0 + (c >> 4)) * 1024 + 512 + h * 128 + (c & 15) * 8); }
        tload_issue<4>(va, vb, v + R0 * 1024 + h * 256, 1024, tid);
#pragma unroll
        for (int s = 0; s < 8; ++s) qf[s] = *(const bf16x8*)(qk + (R0 + 32 * ib + l32) * 1024 + h * 128 + 16 * s + 8 * hh);
#pragma unroll
        for (int i = 0; i < 4; ++i) { const int c = tid + i * NTHR; *(LAS u32x4*)(lds + RET_KS + (c >> 4) * 272 + (c & 15) * 16) = kt[i]; }
        tload_store<4>(va, vb, lds + RET_VT, tid);
    }
    const bf16_t* prev = (const bf16_t*)P.out + ((size_t)((b * 4 + h) * 32 + (n > 0 ? n - 1 : 0))) * 32768;
    bf16x8 pf[4][4];
    if (n > 0) {
#pragma unroll
        for (int s = 0; s < 4; ++s)
#pragma unroll
            for (int et = 0; et < 4; ++et) pf[s][et] = *(const bf16x8*)(prev + (size_t)(32 * (4 * eh + et) + l32) * 128 + 16 * s + 8 * hh);
    }
    __syncthreads();
    f32x16 O[4];
#pragma unroll
    for (int et = 0; et < 4; ++et)
#pragma unroll
        for (int r = 0; r < 16; ++r) O[et][r] = 0.f;
    if (n > 0) {
#pragma unroll
        for (int s = 0; s < 4; ++s)
#pragma unroll
            for (int et = 0; et < 4; ++et) O[et] = MFMA32(pf[s][et], qf[s], O[et]);
#pragma unroll
        for (int s = 4; s < 8; ++s)
#pragma unroll
            for (int et = 0; et < 4; ++et) {
                const bf16x8 a = *(const bf16x8*)(prev + (size_t)(32 * (4 * eh + et) + l32) * 128 + 16 * s + 8 * hh);
                O[et] = MFMA32(a, qf[s], O[et]);
            }
    }
#pragma unroll 1
    for (int jt = 0; jt <= ib; ++jt) {
        f32x16 x;
#pragma unroll
        for (int r = 0; r < 16; ++r) x[r] = 0.f;
#pragma unroll
        for (int s = 0; s < 8; ++s) {
            const bf16x8 a = *(const LAS bf16x8*)(lds + RET_KS + (32 * jt + l32) * 272 + (16 * s + 8 * hh) * 2);
            x = MFMA32(a, qf[s], x);
        }
        if (jt == ib) {
#pragma unroll
            for (int r = 0; r < 16; ++r) x[r] = (crow(r, hh) > l32) ? 0.f : x[r];
        }
        u32x4 p0, p1;
        p0.x = pk2(x[0], x[1]); p0.y = pk2(x[2], x[3]); p0.z = pk2(x[4], x[5]); p0.w = pk2(x[6], x[7]);
        p1.x = pk2(x[8], x[9]); p1.y = pk2(x[10], x[11]); p1.z = pk2(x[12], x[13]); p1.w = pk2(x[14], x[15]);
        const bf16x8 pb0 = __builtin_bit_cast(bf16x8, p0), pb1 = __builtin_bit_cast(bf16x8, p1);
#pragma unroll
        for (int et = 0; et < 4; ++et) {
            const LAS unsigned char* vp = lds + RET_VT + (32 * (4 * eh + et) + l32) * 272 + (32 * jt + 4 * hh) * 2;
            const s16x4 lo0 = *(const LAS s16x4*)(vp), hi0 = *(const LAS s16x4*)(vp + 16), lo1 = *(const LAS s16x4*)(vp + 32), hi1 = *(const LAS s16x4*)(vp + 48);
            O[et] = MFMA32(__builtin_shufflevector(lo0, hi0, 0, 1, 2, 3, 4, 5, 6, 7), pb0, O[et]);
            O[et] = MFMA32(__builtin_shufflevector(lo1, hi1, 0, 1, 2, 3, 4, 5, 6, 7), pb1, O[et]);
        }
    }
    float sm = 0.f, sq = 0.f;
#pragma unroll
    for (int et = 0; et < 4; ++et)
#pragma unroll
        for (int r = 0; r < 16; ++r) { const float t = O[et][r]; sm += t; sq += t * t; }
    sm += __shfl_xor(sm, 32); sq += __shfl_xor(sq, 32);
    LAS f32x2* red = (LAS f32x2*)(lds + RET_RED);
    if (hh == 0) red[w * 32 + l32] = (f32x2){sm, sq};
    const f32x4 gn = *(const f32x4*)(P.even_gn_g + h * 256 + 4 * lane);
    u32x2 gvr[16];
#pragma unroll
    for (int it = 0; it < 16; ++it) gvr[it] = *(const u32x2*)(gs + (R0 + w * 16 + it) * 1024 + h * 256 + 4 * lane);
    __syncthreads();
    { const f32x2 o = red[(w ^ 4) * 32 + l32]; sm += o.x; sq += o.y; }
    const float mean = sm * (1.0f / 256.0f);
    const float rstd = rsqrtf(fmaxf(sq * (1.0f / 256.0f) - mean * mean, 0.f) + 1e-6f);
#pragma unroll
    for (int et = 0; et < 4; ++et)
#pragma unroll
        for (int g = 0; g < 4; ++g) {
            u32x2 o; o.x = pk2((O[et][4 * g] - mean) * rstd, (O[et][4 * g + 1] - mean) * rstd); o.y = pk2((O[et][4 * g + 2] - mean) * rstd, (O[et][4 * g + 3] - mean) * rstd);
            *(LAS u32x2*)(lds + RET_VT + (32 * ib + l32) * 520 + (32 * (4 * eh + et) + 8 * g + 4 * hh) * 2) = o;
        }
    __syncthreads();
#pragma unroll
    for (int it = 0; it < 16; ++it) {
        const int i = w * 16 + it;
        const u32x2 val = *(const LAS u32x2*)(lds + RET_VT + i * 520 + lane * 8);
        const u32x2 gv = gvr[it];
        u32x2 o; o.x = pk2(bf_lo(val.x) * gn.x * bf_lo(gv.x), bf_hi(val.x) * gn.y * bf_hi(gv.x)); o.y = pk2(bf_lo(val.y) * gn.z * bf_lo(gv.y), bf_hi(val.y) * gn.w * bf_hi(gv.y));
        *(u32x2*)(mix + (R0 + i) * 2048 + h * 256 + 4 * lane) = o;
    }
    __syncthreads();
}

constexpr int AT_KS = 0, AT_VT = 9216, AT_FLAG = 18432, AT_OST = 18688;
template <int MASK>
__device__ __forceinline__ void sb_subtile(f32x16& x, float& C, int hh, int key0, int qidx, u32x4& p0, u32x4& p1) {
    f32x2 e2[2][4], d2[2][4];
#pragma unroll
    for (int gp = 0; gp < 2; ++gp)
#pragma unroll
        for (int j = 0; j < 4; ++j) {
            float ev[2];
#pragma unroll
            for (int c = 0; c < 2; ++c) {
                const int r = 4 * (2 * gp + c) + j;
                float t = fexp2(__builtin_amdgcn_fmed3f(x[r], -126.f, 30.f));
                if (MASK == 1) { const int key = key0 + crow(r, hh); t = (key < qidx) ? t : 0.f; }
                if (MASK == 2) { const int key = key0 + crow(r, hh); t = (key < qidx && key >= PADF) ? t : 0.f; }
                ev[c] = t;
            }
            e2[gp][j] = (f32x2){ev[0], ev[1]};
            d2[gp][j] = e2[gp][j] + 1.0f;
        }
    float pg[4], qg[4], T[4];
#pragma unroll
    for (int gp = 0; gp < 2; ++gp) {
        const f32x2 Q = (d2[gp][3] * d2[gp][2]) * (d2[gp][1] * d2[gp][0]);
        pg[2 * gp] = frcp(Q.x); pg[2 * gp + 1] = frcp(Q.y);
    }
#pragma unroll
    for (int g = 0; g < 4; ++g) qg[g] = __shfl_xor(pg[g], 32);
    T[3] = C; T[2] = T[3] * (pg[3] * qg[3]); T[1] = T[2] * (pg[2] * qg[2]); T[0] = T[1] * (pg[1] * qg[1]);
    C = T[0] * (pg[0] * qg[0]);
    f32x2 w2[2][4];
#pragma unroll
    for (int gp = 0; gp < 2; ++gp) {
        const f32x2 base = hh ? (f32x2){T[2 * gp], T[2 * gp + 1]} : (f32x2){T[2 * gp] * qg[2 * gp], T[2 * gp + 1] * qg[2 * gp + 1]};
        const f32x2 b0 = base * (f32x2){pg[2 * gp], pg[2 * gp + 1]};
        const f32x2 b1 = b0 * d2[gp][0], b2 = b1 * d2[gp][1], b3 = b2 * d2[gp][2];
        w2[gp][0] = e2[gp][0] * b0; w2[gp][1] = e2[gp][1] * b1; w2[gp][2] = e2[gp][2] * b2; w2[gp][3] = e2[gp][3] * b3;
    }
    p0.x = pk2(w2[0][0].x, w2[0][1].x); p0.y = pk2(w2[0][2].x, w2[0][3].x); p0.z = pk2(w2[0][0].y, w2[0][1].y); p0.w = pk2(w2[0][2].y, w2[0][3].y);
    p1.x = pk2(w2[1][0].x, w2[1][1].x); p1.y = pk2(w2[1][2].x, w2[1][3].x); p1.z = pk2(w2[1][0].y, w2[1][1].y); p1.w = pk2(w2[1][2].y, w2[1][3].y);
}

__device__ __forceinline__ void attn_item(CParams& P, LAS unsigned char* lds, int item, int tid) {
    const int lane = tid & 63, w = tid >> 6, l32 = lane & 31, hh = lane >> 5;
    int bh, qb;
    if (item < 1920) { bh = item / 15; qb = 1 + (item - bh * 15); } else if (item < 2048) { bh = item - 1920; qb = 16; } else { bh = item - 2048; qb = 0; }
    const int b = bh >> 4, h = bh & 15;
    const bf16_t* q = (const bf16_t*)(P.ws + WS_R0); const bf16_t* k = (const bf16_t*)(P.ws + WS_R0 + UNIT); const bf16_t* v = (const bf16_t*)(P.ws + WS_R1);
    bf16_t* ao = (bf16_t*)(P.ws + WS_R2);
    const size_t Rb = (size_t)b * PP;
    const int qrow0 = 256 * qb + 32 * w;
    const bool wvalid = qrow0 < PP;
    bf16x8 qf[4];
#pragma unroll
    for (int s = 0; s < 4; ++s) {
        if (wvalid) qf[s] = *(const bf16x8*)(q + (Rb + qrow0 + l32) * 1024 + h * 64 + 16 * s + 8 * hh);
        else qf[s] = (bf16x8){0, 0, 0, 0, 0, 0, 0, 0};
    }
    f32x16 O[2];
#pragma unroll
    for (int dt = 0; dt < 2; ++dt)
#pragma unroll
        for (int r = 0; r < 16; ++r) O[dt][r] = 0.f;
    float C = 1.0f; bool done = !wvalid;
    int T = 4 * qb + 3; if (T > 65) T = 65;
    const bool vrole = tid < 256;
    const int jp = tid & 31, dg = (tid >> 5) & 7;
    const int ku = tid & 255;
    u32x4 ra, rb;
    {
        const size_t kb = Rb + 64 * T;
        if (vrole) { ra = *(const u32x4*)(v + (kb + 2 * jp) * 1024 + h * 64 + dg * 8); rb = *(const u32x4*)(v + (kb + 2 * jp + 1) * 1024 + h * 64 + dg * 8); }
        else { ra = *(const u32x4*)(k + (kb + (ku >> 3)) * 1024 + h * 64 + (ku & 7) * 8); rb = *(const u32x4*)(k + (kb + 32 + (ku >> 3)) * 1024 + h * 64 + (ku & 7) * 8); }
    }
    volatile LAS unsigned* flags = (volatile LAS unsigned*)(lds + AT_FLAG);
#pragma unroll 1
    for (; T >= 1; --T) {
        __syncthreads();
        if (vrole) {
            if (T == 1) {
                if (jp < 24) { ra = (u32x4){0u, 0u, 0u, 0u}; rb = ra; }
                else {
                    const float* vr = (const float*)(P.ws + WS_VRAW) + (size_t)(2 * jp - 48) * 1024 + h * 64 + dg * 8;
                    const f32x4 a0 = *(const f32x4*)vr, a1 = *(const f32x4*)(vr + 4), b0 = *(const f32x4*)(vr + 1024), b1 = *(const f32x4*)(vr + 1028);
                    ra.x = pk2(a0.x, a0.y); ra.y = pk2(a0.z, a0.w); ra.z = pk2(a1.x, a1.y); ra.w = pk2(a1.z, a1.w);
                    rb.x = pk2(b0.x, b0.y); rb.y = pk2(b0.z, b0.w); rb.z = pk2(b1.x, b1.y); rb.w = pk2(b1.z, b1.w);
                }
            }
            LAS unsigned* d = (LAS unsigned*)(lds + AT_VT + (dg * 8) * 144 + jp * 4);
            d[0 * 36] = (ra.x & 0xffffu) | (rb.x << 16); d[1 * 36] = (ra.x >> 16) | (rb.x & 0xffff0000u);
            d[2 * 36] = (ra.y & 0xffffu) | (rb.y << 16); d[3 * 36] = (ra.y >> 16) | (rb.y & 0xffff0000u);
            d[4 * 36] = (ra.z & 0xffffu) | (rb.z << 16); d[5 * 36] = (ra.z >> 16) | (rb.z & 0xffff0000u);
            d[6 * 36] = (ra.w & 0xffffu) | (rb.w << 16); d[7 * 36] = (ra.w >> 16) | (rb.w & 0xffff0000u);
        } else {
            if (T == 1 && (ku >> 3) >= 16) {
                const int r = (ku >> 3) - 16;
                const f32x4 s4 = *(const f32x4*)((const float*)(P.ws + WS_KSS) + r * 64 + 4 * h);
                const float n = rsqrtf(((s4.x + s4.y) + (s4.z + s4.w)) * (1.0f / 64.0f) + 1e-6f);
                const float* kr = (const float*)(P.ws + WS_KRAW) + (size_t)r * 1024 + h * 64 + (ku & 7) * 8;
                const f32x4 a0 = *(const f32x4*)kr * n * *(const f32x4*)(P.odd_kn_g + (ku & 7) * 8), a1 = *(const f32x4*)(kr + 4) * n * *(const f32x4*)(P.odd_kn_g + (ku & 7) * 8 + 4);
                rb.x = pk2(a0.x, a0.y); rb.y = pk2(a0.z, a0.w); rb.z = pk2(a1.x, a1.y); rb.w = pk2(a1.z, a1.w);
            }
            *(LAS u32x4*)(lds + AT_KS + (ku >> 3) * 144 + (ku & 7) * 16) = ra;
            *(LAS u32x4*)(lds + AT_KS + (32 + (ku >> 3)) * 144 + (ku & 7) * 16) = rb;
        }
        if (lane == 0) flags[w] = done ? 1u : 0u;
        __syncthreads();
        const u32x4 f0 = *(const LAS u32x4*)(lds + AT_FLAG), f1 = *(const LAS u32x4*)(lds + AT_FLAG + 16);
        const unsigned alld = (f0.x & f0.y) & (f0.z & f0.w) & (f1.x & f1.y) & (f1.z & f1.w);
        if (alld) break;
        if (T > 1) {
            const size_t kb = Rb + 64 * (T - 1);
            if (vrole) { ra = *(const u32x4*)(v + (kb + 2 * jp) * 1024 + h * 64 + dg * 8); rb = *(const u32x4*)(v + (kb + 2 * jp + 1) * 1024 + h * 64 + dg * 8); }
            else { ra = *(const u32x4*)(k + (kb + (ku >> 3)) * 1024 + h * 64 + (ku & 7) * 8); rb = *(const u32x4*)(k + (kb + 32 + (ku >> 3)) * 1024 + h * 64 + (ku & 7) * 8); }
        }
        if (!done && 64 * T <= qrow0 + 30) {
            const bool needmask = (64 * T + 63 >= qrow0) || (T == 1);
#pragma unroll
            for (int st = 1; st >= 0; --st) {
                if (64 * T + 32 * st >= qrow0 + 31) continue;
                f32x16 x;
#pragma unroll
                for (int r = 0; r < 16; ++r) x[r] = 0.f;
#pragma unroll
                for (int s = 0; s < 4; ++s) {
                    const bf16x8 a = *(const LAS bf16x8*)(lds + AT_KS + (32 * st + l32) * 144 + (16 * s + 8 * hh) * 2);
                    x = MFMA32(a, qf[s], x);
                }
                u32x4 p0, p1;
                if (T == 1) sb_subtile<2>(x, C, hh, 64 * T + 32 * st, qrow0 + l32, p0, p1);
                else if (needmask) sb_subtile<1>(x, C, hh, 64 * T + 32 * st, qrow0 + l32, p0, p1);
                else sb_subtile<0>(x, C, hh, 0, 0, p0, p1);
                const bf16x8 pb0 = __builtin_bit_cast(bf16x8, p0), pb1 = __builtin_bit_cast(bf16x8, p1);
#pragma unroll
                for (int dt = 0; dt < 2; ++dt) {
                    const LAS unsigned char* vp = lds + AT_VT + (32 * dt + l32) * 144 + (32 * st + 4 * hh) * 2;
                    const s16x4 lo0 = *(const LAS s16x4*)(vp), hi0 = *(const LAS s16x4*)(vp + 16), lo1 = *(const LAS s16x4*)(vp + 32), hi1 = *(const LAS s16x4*)(vp + 48);
                    O[dt] = MFMA32(__builtin_shufflevector(lo0, hi0, 0, 1, 2, 3, 4, 5, 6, 7), pb0, O[dt]);
                    O[dt] = MFMA32(__builtin_shufflevector(lo1, hi1, 0, 1, 2, 3, 4, 5, 6, 7), pb1, O[dt]);
                }
                if (__ballot(C >= 1e-37f) == 0ull) { done = true; break; }
            }
        }
    }
    LAS unsigned char* ost = lds + AT_OST + w * 4352;
#pragma unroll
    for (int dt = 0; dt < 2; ++dt)
#pragma unroll
        for (int g = 0; g < 4; ++g) {
            u32x2 o; o.x = pk2(O[dt][4 * g], O[dt][4 * g + 1]); o.y = pk2(O[dt][4 * g + 2], O[dt][4 * g + 3]);
            *(LAS u32x2*)(ost + l32 * 136 + (32 * dt + 8 * g + 4 * hh) * 2) = o;
        }
    LDS_WAIT();
    if (wvalid) {
#pragma unroll
        for (int it = 0; it < 8; ++it) {
            const int row = 4 * it + (lane >> 4), part = lane & 15;
            const u32x2 val = *(const LAS u32x2*)(ost + row * 136 + part * 8);
            *(u32x2*)(ao + (Rb + qrow0 + row) * 1024 + h * 64 + part * 4) = val;
        }
    }
    LDS_WAIT();
}

constexpr size_t WS_BAR = WS_HM2P + (size_t)16 * 1024 * 4;
#define XB_TMO      128
#define XB_XCNT(j)  (256  + 64 * (j))
#define XB_XSUB(j)  (1280 + 64 * (j))
#define XB_XGEN(j)  (2304 + 64 * (j))
#define XB_TOP      3328
#define XB_TOPGEN   3392
#define XCD_BAR_WORDS 3456
#define XB_SPIN_CAP (1u << 18)

__device__ __forceinline__ unsigned xb_ld(unsigned* p)              { return __hip_atomic_load(p, __ATOMIC_RELAXED, __HIP_MEMORY_SCOPE_AGENT); }
__device__ __forceinline__ unsigned xb_add(unsigned* p, unsigned v) { return __hip_atomic_fetch_add(p, v, __ATOMIC_RELAXED, __HIP_MEMORY_SCOPE_AGENT); }
__device__ __forceinline__ unsigned xb_xcc_id() { return (unsigned)__builtin_amdgcn_s_getreg((3 << 11) | 20) & 0xFu; }
#define XB_SPIN(cond, bar) do { unsigned _sp = 0; while (cond) { __builtin_amdgcn_s_sleep(1); \
    if ((++_sp & 255u) == 0u) { if (xb_ld(&(bar)[XB_TMO])) break; if (_sp > XB_SPIN_CAP) { atomicAdd(&(bar)[XB_TMO], 1u); break; } } } } while (0)

struct XcdBarrier {
    unsigned* bar; unsigned x;
    volatile LAS unsigned* st;
};

__device__ __forceinline__ XcdBarrier xcd_barrier_post(unsigned* bar, volatile LAS unsigned* st) {
    XcdBarrier b; b.bar = bar; b.x = xb_xcc_id(); b.st = st;
    if (threadIdx.x == 0) (void)xb_add(&bar[XB_XCNT(b.x)], 1u);
    return b;
}
__device__ __forceinline__ void xcd_barrier_complete(unsigned* bar, unsigned x, unsigned& nloc, unsigned& nx) {
    const unsigned G = gridDim.x * gridDim.y * gridDim.z;
    unsigned sum, cnt, mine, sp = 0u;
    for (;;) {
        sum = 0u; cnt = 0u; mine = 0u;
#pragma unroll
        for (unsigned j = 0; j < 16; ++j) { const unsigned c = xb_ld(&bar[XB_XCNT(j)]); sum += c; cnt += (c > 0u) ? 1u : 0u; mine = (j == x) ? c : mine; }
        if (sum == G) break;
        __builtin_amdgcn_s_sleep(1);
        if ((++sp & 255u) == 0u) { if (xb_ld(&bar[XB_TMO])) break; if (sp > XB_SPIN_CAP) { atomicAdd(&bar[XB_TMO], 1u); break; } }
    }
    nloc = mine > 0u ? mine : 1u; nx = cnt > 0u ? cnt : 1u;
}

__device__ __forceinline__ void xcd_barrier(const XcdBarrier& b) {
    asm volatile("s_waitcnt vmcnt(0)" ::: "memory");
    __syncthreads();
    if (threadIdx.x == 0) {
        unsigned* bar = b.bar;
        __builtin_amdgcn_s_waitcnt(0);
        unsigned nloc = b.st[0], nx = b.st[1];
        if (nloc == 0u) { xcd_barrier_complete(bar, b.x, nloc, nx); b.st[0] = nloc; b.st[1] = nx; }
        const unsigned old = xb_add(&bar[XB_XSUB(b.x)], 1u);
        const unsigned gen = old / nloc;
        if (old + 1u == (gen + 1u) * nloc) {
            __builtin_amdgcn_fence(__ATOMIC_RELEASE, "agent");
            asm volatile("s_waitcnt vmcnt(0)" ::: "memory");
            const unsigned og = xb_add(&bar[XB_TOP], 1u);
            const unsigned tg = og / nx;
            if (og + 1u == (tg + 1u) * nx) xb_add(&bar[XB_TOPGEN], 1u);
            else XB_SPIN(xb_ld(&bar[XB_TOPGEN]) == tg, bar);
            __builtin_amdgcn_fence(__ATOMIC_ACQUIRE, "agent");
            xb_add(&bar[XB_XGEN(b.x)], 1u);
            asm volatile("s_waitcnt vmcnt(0)" ::: "memory");
        } else {
            XB_SPIN(xb_ld(&bar[XB_XGEN(b.x)]) == gen, bar);
            __builtin_amdgcn_fence(__ATOMIC_ACQUIRE, "agent");
            asm volatile("s_waitcnt vmcnt(0)" ::: "memory");
        }
    }
    __syncthreads();
}

#define GEMM_COMPACT_A 0
#define GEMM_PHASE(EPI, Aptr, Bptr, N_, K_, E_) do { pg8::Gemm g_{(const pg8::bf16_t*)(Aptr), (const pg8::bf16_t*)(Bptr), NB * SEQ, (N_), (K_), GEMM_COMPACT_A}; pg8::StaticOrder S_; S_.init(NB * SEQ, (N_), (int)gridDim.x, (int)blockIdx.x); \
    pg8::gemm_phase<EPI, pg8::StaticOrder, true, true>(lds, g_, S_, E_); } while (0)
#define META_TASKS(FN, NT) do { RETID(); for (int t_ = blockIdx.x; t_ < (NT); t_ += gridDim.x) FN(KP, lds, t_, tid); asm volatile("s_waitcnt vmcnt(0)" ::: "memory"); __syncthreads(); } while (0)

__global__ void __launch_bounds__(NTHR) mega_fwd(Params Punused) {
    extern __shared__ __attribute__((aligned(16))) unsigned char lds_raw[];
    LAS unsigned char* lds = (LAS unsigned char*)lds_raw;
    cg::grid_group grid = cg::this_grid();
    int tid = threadIdx.x;
#define RETID() do { tid = threadIdx.x; asm volatile("" : "+v"(tid)); } while (0)
#define ws (KP.ws)
#define ss1 ((float*)(ws + WS_SS) + (size_t)RP * 16)
#define ss2 ((float*)(ws + WS_SS) + (size_t)RP * 32)
#define ss3 ((float*)(ws + WS_SS) + (size_t)RP * 48)
    volatile LAS unsigned* bst = (volatile LAS unsigned*)(lds + 139264);
    if (tid < 2) bst[tid] = 0u;
#define GBAR() xcd_barrier(xbar)
    RETID();
    if (blockIdx.x == 0) for (int i = tid; i < XCD_BAR_WORDS; i += NTHR) ((volatile unsigned*)(ws + WS_BAR))[i] = 0u;
    phase0(KP, lds, tid);
    grid.sync();
    const XcdBarrier xbar = xcd_barrier_post((unsigned*)(ws + WS_BAR), bst);
    META_TASKS(meta_in, 320);
    { EpiIn E{(const float*)(ws + WS_SS), (bf16_t*)(ws + WS_R4), (bf16_t*)(ws + WS_R1), (bf16_t*)(ws + WS_R2), (bf16_t*)(ws + WS_R3)};
#undef GEMM_COMPACT_A
#define GEMM_COMPACT_A 1
      GEMM_PHASE(EpiIn, (bf16_t*)KP.out + (size_t)NB * SEQ * DM, ws + WS_WIN, 5120, 1024, E); }
#undef GEMM_COMPACT_A
#define GEMM_COMPACT_A 0
    GBAR();
    RETID();
    for (int it = blockIdx.x; it < 996 + 1025 + 4; it += gridDim.x) {
        if (it < 996) ret_partial_item(KP, lds, it, tid);
        else if (it == 996) conv_item<16>(KP, lds, 0, PADF, tid);
        else if (it < 996 + 1025) { const int ci = it - 997; conv_item<32>(KP, lds, ci >> 7, 128 + 32 * (ci & 127), tid); }
        else ret_out_item(KP, lds, it - (996 + 1025), tid);
    }
    GBAR();
    RETID();
    ret_scan(KP, tid);
    GBAR();
    RETID();
    for (int it = blockIdx.x; it < NB * 32 * 4; it += gridDim.x) ret_out_item(KP, lds, (it >> 7) * 132 + 4 + (it & 127), tid);
    GBAR();
    META_TASKS(meta_out, 256);
    { typedef EpiRes<2, false> EpiR0; EpiR0 E{(const float*)((bf16_t*)KP.out + (size_t)NB * SEQ * DM), nullptr, (bf16_t*)(ws + WS_R4), ss1};
      GEMM_PHASE(EpiR0, ws + WS_R0, ws + WS_WOUT, 1024, 2048, E); }
    GBAR();
    META_TASKS(meta_up, 256);
    { EpiUp E{ss1, (bf16_t*)(ws + WS_R0), (LAS float*)(lds + RS_TAB_OFF)}; GEMM_PHASE(EpiUp, ws + WS_R4, ws + WS_W1, 4096, 1024, E); }
    GBAR();
    META_TASKS(meta_down, 256);
    { typedef EpiRes<1, false> EpiR1; EpiR1 E{nullptr, nullptr, (bf16_t*)(ws + WS_R4), ss2};
      GEMM_PHASE(EpiR1, ws + WS_R0, ws + WS_W2, 1024, 4096, E); }
    GBAR();
    META_TASKS(meta_kv, 128);
    { EpiQkv E{ss2, KP.odd_qn_g, KP.odd_kn_g, (bf16_t*)(ws + WS_R0), (LAS float*)(lds + RS_TAB_OFF)};
      GEMM_PHASE(EpiQkv, ws + WS_R4, ws + WS_WQKV, 3072, 1024, E); }
    GBAR();
    RETID();
    for (int it = blockIdx.x; it < NB * 16 * 17; it += gridDim.x) attn_item(KP, lds, it, tid);
    GBAR();
    { typedef EpiRes<1, false> EpiR1; EpiR1 E{nullptr, nullptr, (bf16_t*)(ws + WS_R4), ss3};
      GEMM_PHASE(EpiR1, ws + WS_R2, ws + WS_WO, 1024, 1024, E); }
    GBAR();
    { EpiUp E{ss3, (bf16_t*)(ws + WS_R0), (LAS float*)(lds + RS_TAB_OFF)}; GEMM_PHASE(EpiUp, ws + WS_R4, ws + WS_W1 + (size_t)4096 * 1024 * 2, 4096, 1024, E); }
    GBAR();
    { typedef EpiRes<1, true> EpiR2; EpiR2 E{nullptr, KP.out, (bf16_t*)(ws + WS_R4), nullptr};
      GEMM_PHASE(EpiR2, ws + WS_R0, ws + WS_W2 + (size_t)4096 * 1024 * 2, 1024, 4096, E); }
#undef ws
#undef ss1
#undef ss2
#undef ss3
}

extern "C" void kernel_launch(void* const* d_in, const int* in_sizes, int n_in, void* d_out, int out_size, void* d_ws, size_t ws_size, hipStream_t stream) {
    static int grid_blocks = 0;
    if (grid_blocks == 0) {
        if (n_in != 17 || ws_size < WS_END) { fprintf(stderr, "kernel_launch: unexpected inputs (n_in %d, ws %zu, need %zu)\n", n_in, ws_size, (size_t)WS_END); grid_blocks = -1; return; }
        int dev = 0, cus = 0, per_cu = 0;
        (void)hipGetDevice(&dev);
        (void)hipDeviceGetAttribute(&cus, hipDeviceAttributeMultiprocessorCount, dev);
        if (hipFuncSetAttribute((const void*)mega_fwd, hipFuncAttributeMaxDynamicSharedMemorySize, LDS_BYTES) != hipSuccess) fprintf(stderr, "kernel_launch: hipFuncSetAttribute failed\n");
        if (hipOccupancyMaxActiveBlocksPerMultiprocessor(&per_cu, (const void*)mega_fwd, NTHR, LDS_BYTES) != hipSuccess || per_cu < 1) { fprintf(stderr, "kernel_launch: occupancy query gave %d; using 1\n", per_cu); per_cu = 1; }
        (void)hipGetLastError();
        if (cus <= 0) cus = 256;
        grid_blocks = cus * per_cu;
    }
    if (grid_blocks < 0) return;
    Params p{};
    const float** pp = (const float**)&p;
    for (int i = 0; i < 17; ++i) pp[i] = (const float*)d_in[i];
    p.out = (float*)d_out; p.ws = (unsigned char*)d_ws;
    void* args[] = {&p};
    hipError_t e = hipLaunchCooperativeKernel((const void*)mega_fwd, dim3(grid_blocks), dim3(NTHR), args, LDS_BYTES, stream);
    if (e != hipSuccess) fprintf(stderr, "cooperative launch failed: %s (grid %d)\n", hipGetErrorString(e), grid_blocks);
}
```
